# Optimizing an MI355X kernel written in HIP

```python
import math
import jax, jax.numpy as jnp
from jax import lax
import numpy as np

D_MODEL = 1024
BATCH = 16
SEQ = 2048
DEPTH = 2

HEAD_DIM = 64
ATTN_WIDTH = D_MODEL // 2
ATTN_HEADS = ATTN_WIDTH // HEAD_DIM
DILATED_CONFIGS = ((128, 1), (512, 4), (2048, 16))
ROPE_THETA = 500000.0
ROPE_DIM = HEAD_DIM // 4
GMLP_WIDTH = D_MODEL // 4
GMLP_GROUPS = 4
GMLP_GROUP_DIM = GMLP_WIDTH // GMLP_GROUPS
GMLP_CHUNK = 128
POOL_WIDTH = D_MODEL - ATTN_WIDTH - GMLP_WIDTH
POOL_WINDOWS = (2, 4, 8, 16)
POOL_GROUPS = len(POOL_WINDOWS)
POOL_GROUP_DIM = POOL_WIDTH // POOL_GROUPS
IN_COLS = 3 * ATTN_WIDTH + 2 * GMLP_WIDTH + POOL_WIDTH

N_EXPERTS = 16
N_EXPERT_GROUPS = 4
EXPERTS_PER_GROUP = N_EXPERTS // N_EXPERT_GROUPS
TOP_K = 2
EXPERT_FF = D_MODEL // 2
MOE_BLOCK = 128

DEEPNORM_ALPHA = float((2 * DEPTH) ** 0.25)
DEEPNORM_BETA = float((8 * DEPTH) ** -0.25)
LN_EPS = 1e-5
NEG_INF = -1e30

kernel_name = "hybrid_dilated_gmlp_pool_groupmoe_deepnorm"


def _layernorm(x, g, b):
    xf = x.astype(jnp.float32)
    mu = xf.mean(-1, keepdims=True)
    var = jnp.square(xf - mu).mean(-1, keepdims=True)
    y = (xf - mu) * lax.rsqrt(var + LN_EPS) * g.astype(jnp.float32) + b.astype(jnp.float32)
    return y.astype(x.dtype)


def _partial_rope(x, positions):
    half = ROPE_DIM // 2
    inv_freq = jnp.power(jnp.float32(ROPE_THETA), -jnp.arange(half, dtype=jnp.float32) / half)
    ang = positions.astype(jnp.float32)[:, None] * inv_freq[None, :]
    cos = jnp.cos(ang)[None, :, None, :]
    sin = jnp.sin(ang)[None, :, None, :]
    xr = x[..., :ROPE_DIM].astype(jnp.float32)
    x1, x2 = xr[..., :half], xr[..., half:]
    rot = jnp.concatenate([x1 * cos - x2 * sin, x2 * cos + x1 * sin], axis=-1).astype(x.dtype)
    return jnp.concatenate([rot, x[..., ROPE_DIM:]], axis=-1)


def _banded_window_attention(q, k, v, half):
    lead = q.shape[:-2]
    L, dh = q.shape[-2], q.shape[-1]
    nlead = len(lead)
    blk = half
    nb = -(-L // blk)
    lp = nb * blk
    qb = jnp.pad(q, [(0, 0)] * nlead + [(0, lp - L), (0, 0)]).reshape(*lead, nb, blk, dh)
    kv_pad = [(0, 0)] * nlead + [(blk, lp - L + blk), (0, 0)]

    def band(t):
        tb = jnp.pad(t, kv_pad).reshape(*lead, nb + 2, blk, dh)
        return jnp.concatenate([tb[..., :-2, :, :], tb[..., 1:-1, :, :], tb[..., 2:, :, :]], axis=-2)

    kw = band(k)
    vw = band(v)
    s = jnp.einsum('...nqd,...nkd->...nqk', qb, kw,
                   preferred_element_type=jnp.float32) * (HEAD_DIM ** -0.5)
    a = jnp.arange(blk)[:, None]
    c = jnp.arange(3 * blk)[None, :]
    n = jnp.arange(nb)[:, None, None]
    offset = c - blk - a
    key_idx = (n - 1) * blk + c
    mask = (jnp.abs(offset) <= half) & (key_idx >= 0) & (key_idx < L)
    s = jnp.where(mask, s, NEG_INF)
    m = s.max(-1, keepdims=True)
    p = jnp.exp(s - m)
    l = p.sum(-1, keepdims=True)
    o = jnp.einsum('...nqk,...nkd->...nqd', p.astype(v.dtype), vw,
                   preferred_element_type=jnp.float32) / l
    lse = (m + jnp.log(l))[..., 0]
    o = o.reshape(*lead, lp, dh)[..., :L, :]
    lse = lse.reshape(*lead, lp)[..., :L]
    return o, lse


def _dilated_attention(q, k, v):
    B, H, S, dh = q.shape
    outs, lses = [], []
    for window, dil in DILATED_CONFIGS:
        half = window // (2 * dil)

        def to_residue(t):
            return t.reshape(B, H, S // dil, dil, dh).swapaxes(2, 3)

        o, lse = _banded_window_attention(to_residue(q), to_residue(k), to_residue(v), half)
        outs.append(o.swapaxes(2, 3).reshape(B, H, S, dh))
        lses.append(lse.swapaxes(2, 3).reshape(B, H, S))
    wts = jax.nn.softmax(jnp.stack(lses, axis=0), axis=0)
    out = jnp.einsum('cbhs,cbhsd->bhsd', wts, jnp.stack(outs, axis=0))
    return out.astype(q.dtype)


def _gmlp_mixer(u, v, ln_g, ln_b, w_s, b_s):
    B, S, G, dg = u.shape
    u = jax.nn.gelu(u)
    v = _layernorm(jax.nn.gelu(v), ln_g, ln_b)
    vc = v.reshape(B, S // GMLP_CHUNK, GMLP_CHUNK, G, dg)
    sv = jnp.einsum('gpq,bcqgd->bcpgd', w_s, vc) + b_s.T[None, None, :, :, None]
    return u * sv.reshape(B, S, G, dg)


def _pool_mixer(z, w_pool, scale):
    B, S, G, dg = z.shape
    zf = z.astype(jnp.float32)
    cs = jnp.concatenate([jnp.zeros((B, 1, G, dg), jnp.float32), jnp.cumsum(zf, axis=1)], axis=1)
    pos = jnp.arange(S)
    pooled = []
    for g, w in enumerate(POOL_WINDOWS):
        left = w // 2
        right = w - 1 - left
        lo = jnp.clip(pos - left, 0, S)
        hi = jnp.clip(pos + right + 1, 0, S)
        cnt = (hi - lo).astype(jnp.float32)[None, :, None]
        csg = cs[:, :, g]
        mean = (jnp.take(csg, hi, axis=1) - jnp.take(csg, lo, axis=1)) / cnt
        pooled.append(mean - zf[:, :, g])
    pooled = jnp.stack(pooled, axis=2).astype(z.dtype)
    y = jnp.einsum('bsgi,gio->bsgo', pooled, w_pool)
    return y * scale.reshape(G, dg)


def _mixing_sublayer(x, w_in, w_out, gmlp_ln_g, gmlp_ln_b, gmlp_w_s, gmlp_b_s, pool_w, pool_scale):
    B, S, _ = x.shape
    proj = x @ w_in
    o1 = ATTN_WIDTH
    o2 = 2 * ATTN_WIDTH
    o3 = 3 * ATTN_WIDTH
    o4 = o3 + GMLP_WIDTH
    o5 = o4 + GMLP_WIDTH
    positions = jnp.arange(S)
    q = _partial_rope(proj[..., :o1].reshape(B, S, ATTN_HEADS, HEAD_DIM), positions)
    k = _partial_rope(proj[..., o1:o2].reshape(B, S, ATTN_HEADS, HEAD_DIM), positions)
    v = proj[..., o2:o3].reshape(B, S, ATTN_HEADS, HEAD_DIM)
    attn = _dilated_attention(q.transpose(0, 2, 1, 3), k.transpose(0, 2, 1, 3), v.transpose(0, 2, 1, 3))
    attn = attn.transpose(0, 2, 1, 3).reshape(B, S, ATTN_WIDTH)
    u = proj[..., o3:o4].reshape(B, S, GMLP_GROUPS, GMLP_GROUP_DIM)
    vg = proj[..., o4:o5].reshape(B, S, GMLP_GROUPS, GMLP_GROUP_DIM)
    gm = _gmlp_mixer(u, vg, gmlp_ln_g, gmlp_ln_b, gmlp_w_s, gmlp_b_s).reshape(B, S, GMLP_WIDTH)
    pz = proj[..., o5:].reshape(B, S, POOL_GROUPS, POOL_GROUP_DIM)
    pl = _pool_mixer(pz, pool_w, pool_scale).reshape(B, S, POOL_WIDTH)
    return jnp.concatenate([attn, gm, pl], axis=-1) @ w_out


def _route(x_flat, router_w, router_bias):
    T = x_flat.shape[0]
    scores = jax.nn.sigmoid((x_flat @ router_w).astype(jnp.float32))
    biased = (scores + router_bias.astype(jnp.float32)).reshape(T, N_EXPERT_GROUPS, EXPERTS_PER_GROUP)
    group_score = lax.top_k(biased, TOP_K)[0].sum(-1)
    gsel = jnp.argmax(group_score, axis=-1)
    in_group = biased[jnp.arange(T), gsel]
    _, local = lax.top_k(in_group, TOP_K)
    experts = gsel[:, None] * EXPERTS_PER_GROUP + local
    sel = jnp.take_along_axis(scores, experts, axis=1)
    gates = sel / sel.sum(-1, keepdims=True)
    return experts, gates


def _moe(x, router_w, router_bias, w_gate, w_up, w_down):
    B, S, D = x.shape
    T = B * S
    A = T * TOP_K
    xf = x.reshape(T, D)
    experts, gates = _route(xf, router_w, router_bias)
    e_flat = experts.reshape(A)
    tok_flat = jnp.broadcast_to(jnp.arange(T)[:, None], (T, TOP_K)).reshape(A)
    g_flat = gates.reshape(A)
    order = jnp.argsort(e_flat)
    e_sorted = e_flat[order]
    tok_sorted = tok_flat[order]
    g_sorted = g_flat[order]
    counts = jnp.zeros((N_EXPERTS,), jnp.int32).at[e_flat].add(1)
    padded = ((counts + MOE_BLOCK - 1) // MOE_BLOCK) * MOE_BLOCK
    start = jnp.cumsum(counts) - counts
    pend = jnp.cumsum(padded)
    pstart = pend - padded
    dest = pstart[e_sorted] + (jnp.arange(A) - start[e_sorted])
    P = A + N_EXPERTS * MOE_BLOCK
    n_blocks = P // MOE_BLOCK
    buf = jnp.zeros((P, D), x.dtype).at[dest].set(xf[tok_sorted])
    blk_expert = jnp.minimum(
        jnp.searchsorted(pend, jnp.arange(n_blocks) * MOE_BLOCK, side='right'), N_EXPERTS - 1)

    def expert_block(args):
        xb, e = args
        h = jax.nn.silu(xb @ w_gate[e]) * (xb @ w_up[e])
        return h @ w_down[e]

    y_buf = lax.map(expert_block, (buf.reshape(n_blocks, MOE_BLOCK, D), blk_expert))
    y_sorted = y_buf.reshape(P, D)[dest] * g_sorted[:, None].astype(x.dtype)
    out = jnp.zeros((T, D), x.dtype).at[tok_sorted].add(y_sorted)
    return out.reshape(B, S, D)


def setup_inputs(seed: int = 0) -> dict:
    key = jax.random.key(seed)
    ks = jax.random.split(key, 20)
    f32 = jnp.float32
    nrm = lambda k, shape, s: jax.random.normal(k, shape, f32) * s
    return {
        "x": nrm(ks[0], (BATCH, SEQ, D_MODEL), 1.0),
        "w_in": nrm(ks[1], (DEPTH, D_MODEL, IN_COLS), D_MODEL ** -0.5),
        "w_out": nrm(ks[2], (DEPTH, D_MODEL, D_MODEL), DEEPNORM_BETA * D_MODEL ** -0.5),
        "gmlp_ln_g": 1.0 + nrm(ks[3], (DEPTH, GMLP_GROUPS, GMLP_GROUP_DIM), 0.02),
        "gmlp_ln_b": nrm(ks[4], (DEPTH, GMLP_GROUPS, GMLP_GROUP_DIM), 0.02),
        "gmlp_w_s": nrm(ks[5], (DEPTH, GMLP_GROUPS, GMLP_CHUNK, GMLP_CHUNK), GMLP_CHUNK ** -0.5),
        "gmlp_b_s": 1.0 + nrm(ks[6], (DEPTH, GMLP_GROUPS, GMLP_CHUNK), 0.02),
        "pool_w": nrm(ks[7], (DEPTH, POOL_GROUPS, POOL_GROUP_DIM, POOL_GROUP_DIM), POOL_GROUP_DIM ** -0.5),
        "pool_scale": 1.0 + nrm(ks[8], (DEPTH, POOL_WIDTH), 0.02),
        "ln1_g": 1.0 + nrm(ks[9], (DEPTH, D_MODEL), 0.02),
        "ln1_b": nrm(ks[10], (DEPTH, D_MODEL), 0.02),
        "router_w": nrm(ks[11], (D_MODEL, N_EXPERTS), D_MODEL ** -0.5),
        "router_bias": nrm(ks[12], (N_EXPERTS,), 0.01),
        "w_gate": nrm(ks[13], (DEPTH, N_EXPERTS, D_MODEL, EXPERT_FF), D_MODEL ** -0.5),
        "w_up": nrm(ks[14], (DEPTH, N_EXPERTS, D_MODEL, EXPERT_FF), D_MODEL ** -0.5),
        "w_down": nrm(ks[15], (DEPTH, N_EXPERTS, EXPERT_FF, D_MODEL), DEEPNORM_BETA * EXPERT_FF ** -0.5),
        "ln2_g": 1.0 + nrm(ks[16], (DEPTH, D_MODEL), 0.02),
        "ln2_b": nrm(ks[17], (DEPTH, D_MODEL), 0.02),
    }


def reference(x, w_in, w_out, gmlp_ln_g, gmlp_ln_b, gmlp_w_s, gmlp_b_s, pool_w, pool_scale,
              ln1_g, ln1_b, router_w, router_bias, w_gate, w_up, w_down, ln2_g, ln2_b):
    for l in range(DEPTH):
        h = _mixing_sublayer(x, w_in[l], w_out[l], gmlp_ln_g[l], gmlp_ln_b[l], gmlp_w_s[l],
                             gmlp_b_s[l], pool_w[l], pool_scale[l])
        x = _layernorm(DEEPNORM_ALPHA * x + h, ln1_g[l], ln1_b[l])
        h = _moe(x, router_w, router_bias, w_gate[l], w_up[l], w_down[l])
        x = _layernorm(DEEPNORM_ALPHA * x + h, ln2_g[l], ln2_b[l])
    return x
```

```cpp
#include <hip/hip_runtime.h>
namespace nv {
constexpr int D = 1024, S = 2048, NB = 16, NCOL = 2304, NE = 16, FF = 512;
constexpr float ALPHA = 1.4142135623730951f;
constexpr float LN_EPS = 1e-5f;

__global__ void __launch_bounds__(256) gemm(const float* __restrict__ A, const float* __restrict__ Bm, float* __restrict__ C, int M, int N, int K) {
    __shared__ float As[16][68];
    __shared__ float Bs[16][68];
    const int tx = threadIdx.x & 15, ty = threadIdx.x >> 4;
    const int m0 = blockIdx.y * 64, n0 = blockIdx.x * 64;
    float acc[4][4] = {};
    for (int k0 = 0; k0 < K; k0 += 16) {
        for (int i = threadIdx.x; i < 64 * 16; i += 256) {
            const int r = i >> 4, c = i & 15;
            As[c][r] = A[(size_t)(m0 + r) * K + k0 + c];
        }
        for (int i = threadIdx.x; i < 16 * 64; i += 256) {
            const int r = i >> 6, c = i & 63;
            Bs[r][c] = Bm[(size_t)(k0 + r) * N + n0 + c];
        }
        __syncthreads();
#pragma unroll
        for (int k = 0; k < 16; ++k) {
            float a[4], b[4];
#pragma unroll
            for (int i = 0; i < 4; ++i) { a[i] = As[k][ty * 4 + i]; b[i] = Bs[k][tx * 4 + i]; }
#pragma unroll
            for (int i = 0; i < 4; ++i)
#pragma unroll
                for (int j = 0; j < 4; ++j) acc[i][j] += a[i] * b[j];
        }
        __syncthreads();
    }
#pragma unroll
    for (int i = 0; i < 4; ++i)
#pragma unroll
        for (int j = 0; j < 4; ++j) C[(size_t)(m0 + ty * 4 + i) * N + n0 + tx * 4 + j] = acc[i][j];
}

__device__ __forceinline__ float wsum(float v) {
#pragma unroll
    for (int o = 32; o >= 1; o >>= 1) v += __shfl_xor(v, o);
    return v;
}
__device__ __forceinline__ float wmax(float v) {
#pragma unroll
    for (int o = 32; o >= 1; o >>= 1) v = fmaxf(v, __shfl_xor(v, o));
    return v;
}
__device__ __forceinline__ float gelu_tanh(float x) {
    const float y = 0.7978845608028654f * (x + 0.044715f * x * x * x);
    return 0.5f * x * (1.0f + tanhf(y));
}

__global__ void rope(float* proj) {
    const int idx = blockIdx.x * blockDim.x + threadIdx.x;
    if (idx >= S * 2 * 8 * 8) return;
    const int i = idx & 7, h = (idx >> 3) & 7, qk = (idx >> 6) & 1, pos = idx >> 7;
    const float inv = powf(500000.0f, -(float)i / 8.0f);
    const float ang = (float)pos * inv;
    const float c = cosf(ang), s = sinf(ang);
    float* p = proj + (size_t)pos * NCOL + qk * 512 + h * 64;
    const float x1 = p[i], x2 = p[i + 8];
    p[i] = x1 * c - x2 * s;
    p[i + 8] = x2 * c + x1 * s;
}

__global__ void __launch_bounds__(64) attn(const float* __restrict__ proj, float* __restrict__ cc) {
    const int pos = blockIdx.x, h = blockIdx.y, lane = threadIdx.x;
    __shared__ float qs[64];
    __shared__ float ps[192];
    qs[lane] = proj[(size_t)pos * NCOL + h * 64 + lane];
    __syncthreads();
    float oc[3], lse[3];
    const int dils[3] = {1, 4, 16};
    for (int c = 0; c < 3; ++c) {
        const int dil = dils[c];
        float mx = -1e30f;
        for (int it = 0; it < 3; ++it) {
            const int idx = it * 64 + lane;
            const int kp = pos + (idx - 64) * dil;
            const bool valid = idx < 129 && kp >= 0 && kp < S;
            float s = -1e30f;
            if (valid) {
                const float* kr = proj + (size_t)kp * NCOL + 512 + h * 64;
                float a = 0.f;
                for (int d = 0; d < 64; ++d) a += qs[d] * kr[d];
                s = a * 0.125f;
            }
            ps[idx] = s;
            mx = fmaxf(mx, s);
        }
        mx = wmax(mx);
        __syncthreads();
        float l = 0.f;
        for (int it = 0; it < 3; ++it) {
            const int idx = it * 64 + lane;
            const float p = (ps[idx] > -1e29f) ? expf(ps[idx] - mx) : 0.f;
            l += p;
            ps[idx] = p;
        }
        l = wsum(l);
        __syncthreads();
        float o = 0.f;
        for (int idx = 0; idx < 129; ++idx) {
            const float p = ps[idx];
            if (p != 0.f) {
                const int kp = pos + (idx - 64) * dil;
                o += p * proj[(size_t)kp * NCOL + 1024 + h * 64 + lane];
            }
        }
        oc[c] = o / l;
        lse[c] = mx + logf(l);
        __syncthreads();
    }
    const float m = fmaxf(lse[0], fmaxf(lse[1], lse[2]));
    const float w0 = expf(lse[0] - m), w1 = expf(lse[1] - m), w2 = expf(lse[2] - m);
    cc[(size_t)pos * 1024 + h * 64 + lane] = (w0 * oc[0] + w1 * oc[1] + w2 * oc[2]) / (w0 + w1 + w2);
}

__global__ void __launch_bounds__(64) gmlp_prep(float* proj, const float* __restrict__ lg, const float* __restrict__ lb) {
    const int pos = blockIdx.x, g = blockIdx.y, lane = threadIdx.x;
    float* pu = proj + (size_t)pos * NCOL + 1536 + g * 64;
    float* pv = proj + (size_t)pos * NCOL + 1792 + g * 64;
    pu[lane] = gelu_tanh(pu[lane]);
    const float v = gelu_tanh(pv[lane]);
    const float mu = wsum(v) * (1.0f / 64.0f);
    const float dv = v - mu;
    const float var = wsum(dv * dv) * (1.0f / 64.0f);
    pv[lane] = dv * rsqrtf(var + LN_EPS) * lg[g * 64 + lane] + lb[g * 64 + lane];
}
__global__ void __launch_bounds__(256) gmlp_mix(const float* __restrict__ proj, const float* __restrict__ ws, const float* __restrict__ bs, float* __restrict__ cc) {
    const int p = blockIdx.x, t = threadIdx.x, g = t >> 6, d = t & 63;
    const int c0 = (p >> 7) << 7, pl = p & 127;
    const float* wr = ws + ((size_t)g * 128 + pl) * 128;
    float a = 0.f;
    for (int q = 0; q < 128; ++q) a += wr[q] * proj[(size_t)(c0 + q) * NCOL + 1792 + g * 64 + d];
    cc[(size_t)p * 1024 + 512 + g * 64 + d] = proj[(size_t)p * NCOL + 1536 + g * 64 + d] * (a + bs[g * 128 + pl]);
}
__global__ void __launch_bounds__(256) pool1(const float* __restrict__ proj, float* __restrict__ pooled) {
    const int pos = blockIdx.x, t = threadIdx.x, g = t >> 6;
    const int w = 2 << g, left = w / 2, right = w - 1 - left;
    int lo = pos - left; if (lo < 0) lo = 0;
    int hi = pos + right + 1; if (hi > S) hi = S;
    float s = 0.f;
    for (int q = lo; q < hi; ++q) s += proj[(size_t)q * NCOL + 2048 + t];
    pooled[(size_t)pos * 256 + t] = s / (float)(hi - lo) - proj[(size_t)pos * NCOL + 2048 + t];
}
__global__ void __launch_bounds__(256) pool2(const float* __restrict__ pooled, const float* __restrict__ pw, const float* __restrict__ scale, float* __restrict__ cc) {
    const int pos = blockIdx.x, t = threadIdx.x, g = t >> 6, o = t & 63;
    float a = 0.f;
    for (int i = 0; i < 64; ++i) a += pooled[(size_t)pos * 256 + g * 64 + i] * pw[((size_t)g * 64 + i) * 64 + o];
    cc[(size_t)pos * 1024 + 768 + t] = a * scale[t];
}
__global__ void __launch_bounds__(64) ln_res(const float* __restrict__ xin, const float* __restrict__ h, const float* __restrict__ g, const float* __restrict__ b, float* __restrict__ xout) {
    const int row = blockIdx.x, lane = threadIdx.x;
    float v[16]; float s = 0.f;
#pragma unroll
    for (int j = 0; j < 16; ++j) { const int c = lane + 64 * j; v[j] = ALPHA * xin[(size_t)row * D + c] + h[(size_t)row * D + c]; s += v[j]; }
    const float mu = wsum(s) * (1.0f / D);
    float q = 0.f;
#pragma unroll
    for (int j = 0; j < 16; ++j) { v[j] -= mu; q += v[j] * v[j]; }
    const float rstd = rsqrtf(wsum(q) * (1.0f / D) + LN_EPS);
#pragma unroll
    for (int j = 0; j < 16; ++j) { const int c = lane + 64 * j; xout[(size_t)row * D + c] = v[j] * rstd * g[c] + b[c]; }
}
__device__ __forceinline__ void route16(const float* logit, const float* __restrict__ rbias, int& e0, int& e1, float& g0, float& g1) {
    float sc[16], bi[16];
#pragma unroll
    for (int e = 0; e < 16; ++e) { sc[e] = 1.0f / (1.0f + expf(-logit[e])); bi[e] = sc[e] + rbias[e]; }
    int gsel = 0; float best = -1e30f;
#pragma unroll
    for (int g = 0; g < 4; ++g) {
        float m1 = -1e30f, m2 = -1e30f;
#pragma unroll
        for (int j = 0; j < 4; ++j) { const float v = bi[g * 4 + j]; if (v > m1) { m2 = m1; m1 = v; } else if (v > m2) m2 = v; }
        const float gs = m1 + m2;
        if (gs > best) { best = gs; gsel = g; }
    }
    int i1 = 0; float m1 = -1e30f;
#pragma unroll
    for (int j = 0; j < 4; ++j) { float v = -1e30f;
#pragma unroll
        for (int g = 0; g < 4; ++g) v = (g == gsel) ? bi[g * 4 + j] : v;
        if (v > m1) { m1 = v; i1 = j; } }
    int i2 = 0; float m2 = -1e30f;
#pragma unroll
    for (int j = 0; j < 4; ++j) { float v = -1e30f;
#pragma unroll
        for (int g = 0; g < 4; ++g) v = (g == gsel) ? bi[g * 4 + j] : v;
        if (j != i1 && v > m2) { m2 = v; i2 = j; } }
    e0 = gsel * 4 + i1; e1 = gsel * 4 + i2;
    float s0 = 0.f, s1 = 0.f;
#pragma unroll
    for (int e = 0; e < 16; ++e) { s0 = (e == e0) ? sc[e] : s0; s1 = (e == e1) ? sc[e] : s1; }
    g0 = s0 / (s0 + s1); g1 = s1 / (s0 + s1);
}
__global__ void __launch_bounds__(64) route(const float* __restrict__ x1, const float* __restrict__ rw, const float* __restrict__ rbias, int* __restrict__ eo, float* __restrict__ go) {
    const int row = blockIdx.x, lane = threadIdx.x;
    float acc[16];
#pragma unroll
    for (int e = 0; e < 16; ++e) acc[e] = 0.f;
    for (int j = 0; j < 16; ++j) {
        const int k = lane + 64 * j;
        const float xv = x1[(size_t)row * D + k];
#pragma unroll
        for (int e = 0; e < 16; ++e) acc[e] += xv * rw[(size_t)k * 16 + e];
    }
#pragma unroll
    for (int e = 0; e < 16; ++e) acc[e] = wsum(acc[e]);
    int e0, e1; float g0, g1;
    route16(acc, rbias, e0, e1, g0, g1);
    if (lane == 0) { eo[row * 2] = e0; eo[row * 2 + 1] = e1; go[row * 2] = g0; go[row * 2 + 1] = g1; }
}
__global__ void __launch_bounds__(256) moe(const float* __restrict__ x1, const int* __restrict__ eo, const float* __restrict__ go,
                                           const float* __restrict__ wg, const float* __restrict__ wu, const float* __restrict__ wd, float* __restrict__ out) {
    const int row = blockIdx.x, t = threadIdx.x;
    __shared__ float xs[D];
    __shared__ float hs[FF];
    for (int i = t; i < D; i += 256) xs[i] = x1[(size_t)row * D + i];
    float acc[4] = {0.f, 0.f, 0.f, 0.f};
    for (int k = 0; k < 2; ++k) {
        const int e = eo[row * 2 + k]; const float gt = go[row * 2 + k];
        const float* pg = wg + (size_t)e * D * FF; const float* pu = wu + (size_t)e * D * FF; const float* pd = wd + (size_t)e * FF * D;
        __syncthreads();
        for (int j = t; j < FF; j += 256) {
            float a = 0.f, b = 0.f;
            for (int i = 0; i < D; ++i) { a += xs[i] * pg[(size_t)i * FF + j]; b += xs[i] * pu[(size_t)i * FF + j]; }
            hs[j] = (a / (1.0f + expf(-a))) * b;
        }
        __syncthreads();
#pragma unroll
        for (int q = 0; q < 4; ++q) {
            const int o = t + 256 * q; float a = 0.f;
            for (int j = 0; j < FF; ++j) a += hs[j] * pd[(size_t)j * D + o];
            acc[q] += gt * a;
        }
    }
#pragma unroll
    for (int q = 0; q < 4; ++q) out[(size_t)row * D + t + 256 * q] = acc[q];
}

struct In {
    const float *x, *w_in, *w_out, *lg, *lb, *wsp, *bsp, *pw, *psc, *ln1g, *ln1b, *rw, *rb, *wg, *wu, *wd, *ln2g, *ln2b;
};
struct Scr { float *proj, *cc, *pooled, *h, *x1, *moe; int* eo; float* go; };
constexpr size_t SCR_FLOATS = (size_t)S * NCOL + (size_t)S * 1024 * 4 + (size_t)S * 256 + S * 4;
__host__ inline Scr carve(float* base) {
    Scr s; s.proj = base; base += (size_t)S * NCOL; s.cc = base; base += (size_t)S * 1024; s.pooled = base; base += (size_t)S * 256;
    s.h = base; base += (size_t)S * 1024; s.x1 = base; base += (size_t)S * 1024; s.moe = base; base += (size_t)S * 1024;
    s.eo = (int*)base; base += S * 2; s.go = base; return s;
}
__host__ inline void layer(const In& I, int l, const float* xin, float* xout, const Scr& s, hipStream_t st) {
    gemm<<<dim3(NCOL / 64, S / 64), 256, 0, st>>>(xin, I.w_in + (size_t)l * D * NCOL, s.proj, S, NCOL, D);
    rope<<<(S * 128 + 255) / 256, 256, 0, st>>>(s.proj);
    attn<<<dim3(S, 8), 64, 0, st>>>(s.proj, s.cc);
    gmlp_prep<<<dim3(S, 4), 64, 0, st>>>(s.proj, I.lg + l * 256, I.lb + l * 256);
    gmlp_mix<<<S, 256, 0, st>>>(s.proj, I.wsp + (size_t)l * 4 * 128 * 128, I.bsp + l * 4 * 128, s.cc);
    pool1<<<S, 256, 0, st>>>(s.proj, s.pooled);
    pool2<<<S, 256, 0, st>>>(s.pooled, I.pw + (size_t)l * 4 * 64 * 64, I.psc + l * 256, s.cc);
    gemm<<<dim3(D / 64, S / 64), 256, 0, st>>>(s.cc, I.w_out + (size_t)l * D * D, s.h, S, D, D);
    ln_res<<<S, 64, 0, st>>>(xin, s.h, I.ln1g + l * D, I.ln1b + l * D, s.x1);
    route<<<S, 64, 0, st>>>(s.x1, I.rw, I.rb, s.eo, s.go);
    moe<<<S, 256, 0, st>>>(s.x1, s.eo, s.go, I.wg + (size_t)l * NE * D * FF, I.wu + (size_t)l * NE * D * FF, I.wd + (size_t)l * NE * FF * D, s.moe);
    ln_res<<<S, 64, 0, st>>>(s.x1, s.moe, I.ln2g + l * D, I.ln2b + l * D, xout);
}
__host__ inline In make_in(void* const* d_in) {
    In I; const float* const* p = (const float* const*)d_in;
    I.x = p[0]; I.w_in = p[1]; I.w_out = p[2]; I.lg = p[3]; I.lb = p[4]; I.wsp = p[5]; I.bsp = p[6]; I.pw = p[7]; I.psc = p[8];
    I.ln1g = p[9]; I.ln1b = p[10]; I.rw = p[11]; I.rb = p[12]; I.wg = p[13]; I.wu = p[14]; I.wd = p[15]; I.ln2g = p[16]; I.ln2b = p[17];
    return I;
}
}
extern "C" void kernel_launch(void* const* d_in, const int* in_sizes, int n_in, void* d_out, int out_size, void* d_ws, size_t ws_size, hipStream_t stream) {
    using namespace nv;
    In I = make_in(d_in);
    float* xcur = (float*)d_ws;
    Scr s = carve(xcur + (size_t)NB * S * D);
    for (int l = 0; l < 2; ++l)
        for (int b = 0; b < NB; ++b) {
            const float* xin = (l == 0 ? I.x : xcur) + (size_t)b * S * D;
            float* xout = (l == 0 ? xcur : (float*)d_out) + (size_t)b * S * D;
            layer(I, l, xin, xout, s, stream);
        }
}
```

```cpp
#define MK_CUT 17
#include <hip/hip_runtime.h>
#include <cstdio>
namespace pg8 {
#define PG8_LAS __attribute__((address_space(3)))
typedef unsigned short bf16_t;
typedef short bf16x8 __attribute__((ext_vector_type(8)));
typedef float f32x4 __attribute__((ext_vector_type(4)));
typedef unsigned u32x4 __attribute__((ext_vector_type(4)));
constexpr int BM = 256, BK = 64, HALF = 128, HTB = HALF * BK * 2  , STAGE_BYTES = 8 * HTB, NXCD = 8, WGM = 8;

__host__ __device__ __forceinline__ int lds_byte(int r, int c) { const int st = (r >> 4) * 2 + (c >> 5), rr = r & 15, cc = c & 31, ob = rr * 64 + cc * 2; return st * 1024 + (ob ^ (((ob >> 9) & 1) << 5)); }
__host__ __device__ __forceinline__ void stage_rc(int b, int& R, int& C) { const int st = b / 1024, sb = b % 1024, swz = sb ^ (((sb >> 9) & 1) << 5); R = (st >> 1) * 16 + swz / 64; C = (st & 1) * 32 + (swz % 64) / 2; }
__host__ __device__ __forceinline__ int perm32(int rho) { const int n = rho >> 4, i = rho & 15; return 8 * (i >> 2) + 4 * n + (i & 3); }

struct Unit { int pm, pn, pb; };
struct Gemm { const bf16_t* A; const bf16_t* Bt; int K; };

struct StaticOrder {
    int nM, nN, nwg, G, c;
    __device__ void init(int nM_, int nN_, int G_, int c_) { nM = nM_; nN = nN_; nwg = nM * nN; G = G_; c = c_; }
    __device__ bool next(int i, Unit& u) const {
        const long L = (long)i * G + c; if (L >= nwg) return false;
        int wgid = (int)L; { const int q = nwg / NXCD, r = nwg % NXCD, xcd = wgid % NXCD, off = wgid / NXCD; wgid = (xcd < r ? xcd * (q + 1) : r * (q + 1) + (xcd - r) * q) + off; }
        const int nig = WGM * nN, gid = wgid / nig, fm = gid * WGM, gsz = (nM - fm) < WGM ? (nM - fm) : WGM;
        u.pm = fm + ((wgid % nig) % gsz); u.pn = (wgid % nig) / gsz; u.pb = u.pn; return true;
    }
};
struct GroupOrder {
    StaticOrder so; const PG8_LAS int* texp;
    __device__ bool next(int i, Unit& u) const { if (!so.next(i, u)) return false; u.pb = texp[u.pm] * so.nN + u.pn; return true; }
};

template <class Epi, class Sched, bool ALIGN_EPI = true>
__device__ __forceinline__ void gemm_phase(PG8_LAS unsigned char* lds, const Gemm g, const Sched& S, const Epi& E, const int wave_id) {
    int lane; asm volatile("v_mbcnt_lo_u32_b32 %0, -1, 0\n\tv_mbcnt_hi_u32_b32 %0, -1, %0" : "=&v"(lane));
    const int wid = wave_id, tid = wid * 64 + lane, wr = wid >> 2, wc = wid & 3, fr = lane & 15, fq = lane >> 4;
    const int K = g.K, nt = K / BK;
    unsigned voffA[2], voffB[2];
#pragma unroll
    for (int i = 0; i < 2; ++i) { int R, C; stage_rc(tid * 16 + i * 8192, R, C); const int Rb = Epi::PERM ? ((R & ~31) + perm32(R & 31)) : R;
        voffA[i] = (unsigned)(R * K + C) * 2u; voffB[i] = (unsigned)(Rb * K + C) * 2u; }
    const size_t kstep = (size_t)(BK * 2);
    const size_t hstep = (size_t)HALF * K * 2;
    const size_t tstep = 2 * hstep;
    const unsigned ldsw = (unsigned)wid * 1024u;
    const int aoff = lds_byte(wr * 64 + fr, fq * 8), boff = lds_byte(wc * 32 + fr, fq * 8);
#define PG8_SA(b, h) (((b) * 2 + (h)) * HTB)
#define PG8_SB(b, h) ((4 + (b) * 2 + (h)) * HTB)
#define PG8_STAGE(bufoff, gbase, voff) do { _Pragma("unroll") for (int _i = 0; _i < 2; ++_i) \
        __builtin_amdgcn_global_load_lds((const unsigned*)((const char*)(gbase) + (voff)[_i]), (PG8_LAS unsigned*)(lds + (bufoff) + ldsw + _i * 8192), 16, 0, 0); } while (0)
#define PG8_LDA(dst, b, h) do { _Pragma("unroll") for (int m = 0; m < 4; ++m) _Pragma("unroll") for (int k = 0; k < 2; ++k) dst[m][k] = *(const PG8_LAS bf16x8*)(lds + PG8_SA(b, h) + aoff + m * 2048 + k * 1024); } while (0)
#define PG8_LDB(dst, b, h) do { _Pragma("unroll") for (int n = 0; n < 2; ++n) _Pragma("unroll") for (int k = 0; k < 2; ++k) dst[n][k] = *(const PG8_LAS bf16x8*)(lds + PG8_SB(b, h) + boff + n * 2048 + k * 1024); } while (0)
#define PG8_MMA(ai, bj, At, Bt) do { __builtin_amdgcn_s_setprio(1); _Pragma("unroll") for (int m = 0; m < 4; ++m) _Pragma("unroll") for (int n = 0; n < 2; ++n) _Pragma("unroll") for (int k = 0; k < 2; ++k) \
        acc[ai][bj][m][n] = __builtin_amdgcn_mfma_f32_16x16x32_bf16(Bt[n][k], At[m][k], acc[ai][bj][m][n], 0, 0, 0); __builtin_amdgcn_s_setprio(0); } while (0)
#define PG8_WAIT_V(n) asm volatile("s_waitcnt vmcnt(" #n ")" ::: "memory")
#define PG8_WAIT_L(n) asm volatile("s_waitcnt lgkmcnt(" #n ")" ::: "memory")
#define PG8_BAR __builtin_amdgcn_s_barrier()
#define PG8_SCHED __builtin_amdgcn_sched_barrier(0)
    Unit cur, nxt; int ui = 0;
    if (!S.next(0, cur)) return;
    f32x4 acc[2][2][4][2];
#pragma unroll
    for (int a = 0; a < 2; ++a)
#pragma unroll
        for (int b = 0; b < 2; ++b)
#pragma unroll
            for (int m = 0; m < 4; ++m)
#pragma unroll
                for (int n = 0; n < 2; ++n) acc[a][b][m][n] = (f32x4){0.f, 0.f, 0.f, 0.f};
    bf16x8 At[4][2], B0[2][2], B1[2][2];
    const char* cA = (const char*)g.A + (size_t)cur.pm * tstep; const char* cB = (const char*)g.Bt + (size_t)cur.pb * tstep;
    PG8_STAGE(PG8_SB(0, 0), cB, voffB); PG8_STAGE(PG8_SB(0, 1), cB + hstep, voffB); PG8_STAGE(PG8_SA(0, 0), cA, voffA); PG8_STAGE(PG8_SA(0, 1), cA + hstep, voffA);
    if (wr == 1) PG8_BAR;
    PG8_WAIT_V(2); PG8_BAR;
    PG8_STAGE(PG8_SB(1, 0), cB + kstep, voffB); PG8_STAGE(PG8_SA(1, 0), cA + kstep, voffA); PG8_STAGE(PG8_SB(1, 1), cB + hstep + kstep, voffB);
    PG8_WAIT_V(6); PG8_BAR;
    for (;;) {
        const bool has_next = S.next(ui + 1, nxt);
        const char* nA = has_next ? (const char*)g.A + (size_t)nxt.pm * tstep : cA; const char* nB = has_next ? (const char*)g.Bt + (size_t)nxt.pb * tstep : cB;
        for (int t = 0; t < nt; t += 2) {
            const bool last = (t == nt - 2);
            const char* a1 = cA + (size_t)(t + 1) * kstep;
            const char* a2 = last ? nA : cA + (size_t)(t + 2) * kstep; const char* b2 = last ? nB : cB + (size_t)(t + 2) * kstep;
            const char* a3 = a2 + kstep; const char* b3 = b2 + kstep;
            PG8_LDB(B0, 0, 0); PG8_LDB(B1, 0, 1); PG8_SCHED; PG8_LDA(At, 0, 0); PG8_STAGE(PG8_SA(1, 1), a1 + hstep, voffA);
            PG8_WAIT_V(8); PG8_WAIT_L(0); PG8_BAR; PG8_MMA(0, 0, At, B0); PG8_MMA(0, 1, At, B1); PG8_BAR; PG8_SCHED;
            PG8_LDA(At, 0, 1); PG8_STAGE(PG8_SB(0, 0), b2, voffB); PG8_STAGE(PG8_SB(0, 1), b2 + hstep, voffB); PG8_STAGE(PG8_SA(0, 0), a2, voffA);
            PG8_WAIT_V(8); PG8_WAIT_L(0); PG8_BAR; PG8_MMA(1, 0, At, B0); PG8_MMA(1, 1, At, B1); PG8_BAR; PG8_SCHED;
            PG8_LDB(B0, 1, 0); PG8_LDB(B1, 1, 1); PG8_SCHED; PG8_LDA(At, 1, 0); PG8_STAGE(PG8_SA(0, 1), a2 + hstep, voffA);
            PG8_WAIT_V(8); PG8_WAIT_L(0); PG8_BAR; PG8_MMA(0, 0, At, B0); PG8_MMA(0, 1, At, B1); PG8_BAR; PG8_SCHED;
            PG8_LDA(At, 1, 1); PG8_STAGE(PG8_SB(1, 0), b3, voffB); PG8_STAGE(PG8_SB(1, 1), b3 + hstep, voffB); PG8_STAGE(PG8_SA(1, 0), a3, voffA);
            PG8_WAIT_V(8); PG8_WAIT_L(0); PG8_BAR; PG8_MMA(1, 0, At, B0); PG8_MMA(1, 1, At, B1); PG8_BAR; PG8_SCHED;
        }
        if constexpr (ALIGN_EPI) { if (wr == 0) PG8_BAR; }
        { int ln_; asm volatile("v_mbcnt_lo_u32_b32 %0, -1, 0\n\tv_mbcnt_hi_u32_b32 %0, -1, %0" : "=&v"(ln_)); E(acc, cur, wr, wc, ln_ & 15, ln_ >> 4); }
        if (!has_next) break;
#pragma unroll
        for (int a = 0; a < 2; ++a)
#pragma unroll
            for (int b = 0; b < 2; ++b)
#pragma unroll
                for (int m = 0; m < 4; ++m)
#pragma unroll
                    for (int n = 0; n < 2; ++n) acc[a][b][m][n] = (f32x4){0.f, 0.f, 0.f, 0.f};
        cur = nxt; cA = nA; cB = nB; ++ui;
        if constexpr (ALIGN_EPI) { if (wr == 1) PG8_BAR; }
    }
    PG8_WAIT_V(0);
    if constexpr (!ALIGN_EPI) { if (wr == 0) PG8_BAR; }
    PG8_BAR;
#undef PG8_SA
#undef PG8_SB
#undef PG8_STAGE
#undef PG8_LDA
#undef PG8_LDB
#undef PG8_MMA
#undef PG8_WAIT_V
#undef PG8_WAIT_L
#undef PG8_BAR
#undef PG8_SCHED
}
}
namespace mk {
constexpr int NB = 16, S = 2048, T = NB * S, D = 1024, NCOL = 2304, NE = 16, FF = 512;
constexpr float ALPHA = 1.4142135623730951f, LN_EPS = 1e-5f, LOG2E = 1.4426950408889634f;
constexpr int NWAVES = 8, NTHREADS = 512;
constexpr int MAXROWS = 69632;
constexpr int MAXTILES = 272;

constexpr size_t MiB = 1u << 20;
constexpr size_t WS_CTL = 0, CTL_ZERO_BYTES = 1 * MiB;
constexpr size_t WS_ROPE = 1 * MiB;
constexpr size_t WS_TOKE = WS_ROPE + 256 * 1024;
constexpr size_t WS_TOKG = WS_TOKE + 256 * 1024;
constexpr size_t WS_TOKP = WS_TOKG + 256 * 1024;
constexpr size_t WS_SLOT = 2 * MiB;
constexpr size_t WS_GSORT = WS_SLOT + 256 * 1024;
constexpr size_t WS_LSE = 3 * MiB;
constexpr size_t WS_WPT = 6 * MiB;
constexpr size_t WS_WST = 6 * MiB + 64 * 1024;
constexpr size_t WS_RWT = 6 * MiB + 512 * 1024;
constexpr size_t WS_WIN = 8 * MiB, WS_WOUT = 17 * MiB, WS_WGU = 21 * MiB, WS_WDN = 85 * MiB;
constexpr size_t WS_X1 = 117 * MiB;
constexpr size_t WS_XG = 245 * MiB;
constexpr size_t WS_HB = 381 * MiB;
constexpr size_t WS_Q = 117 * MiB, WS_K = 149 * MiB, WS_V = 181 * MiB, WS_U = 213 * MiB, WS_G = 229 * MiB, WS_Z = 245 * MiB;
constexpr size_t WS_PO = 261 * MiB;
constexpr size_t WS_CC = 445 * MiB;
constexpr size_t WS_END = 509 * MiB;
constexpr int CW_CNT = 64;
constexpr int CW_BAR = 4096;

constexpr int RING_BYTES = 131072;
constexpr int MISC_OFF = RING_BYTES + 320;
constexpr int TAB_OFF = RING_BYTES + 1024;
constexpr int LDS_BYTES = 147456;

#define GAS __attribute__((address_space(1)))
#define LAS __attribute__((address_space(3)))
typedef unsigned short bf16;
typedef unsigned v4u __attribute__((ext_vector_type(4)));
typedef unsigned v2u __attribute__((ext_vector_type(2)));
typedef float f32x4 __attribute__((ext_vector_type(4)));
typedef float f32x2 __attribute__((ext_vector_type(2)));
typedef float f32x16 __attribute__((ext_vector_type(16)));
typedef short bf16x8 __attribute__((ext_vector_type(8)));
typedef short s16x4 __attribute__((ext_vector_type(4)));
typedef __bf16 bf16x2_t __attribute__((ext_vector_type(2)));
typedef GAS unsigned gu32;
#define RLX_AGENT __ATOMIC_RELAXED, __HIP_MEMORY_SCOPE_AGENT
#define LDS_WAIT() asm volatile("s_waitcnt lgkmcnt(0)" ::: "memory")

__device__ __forceinline__ unsigned pk2(float lo, float hi) { f32x2 v = {lo, hi}; bf16x2_t r = __builtin_convertvector(v, bf16x2_t); return __builtin_bit_cast(unsigned, r); }
__device__ __forceinline__ float bflo(unsigned u) { return __builtin_bit_cast(float, u << 16); }
__device__ __forceinline__ float bfhi(unsigned u) { return __builtin_bit_cast(float, u & 0xffff0000u); }
__device__ __forceinline__ float wave_sum(float v) {
#pragma unroll
    for (int o = 1; o < 64; o <<= 1) v += __shfl_xor(v, o);
    return v;
}
__device__ __forceinline__ float fast_exp2(float x) { return __builtin_amdgcn_exp2f(x); }
__device__ __forceinline__ float fast_rcp(float x) { return __builtin_amdgcn_rcpf(x); }
__device__ __forceinline__ float gelu_t(float x) {
    const float y = x * (1.5957691216057308f + 0.07135481627159498f * x * x);
    return x * fast_rcp(1.0f + fast_exp2(-LOG2E * y));
}
__device__ __forceinline__ float silu_f(float x) { return x * fast_rcp(1.0f + fast_exp2(-LOG2E * x)); }
__device__ __forceinline__ int crow(int reg, int h) { return (reg & 3) + 8 * (reg >> 2) + 4 * h; }

#define XB_TMO      128
#define XB_XCNT(j)  (256  + 64 * (j))
#define XB_XSUB(j)  (1280 + 64 * (j))
#define XB_XGEN(j)  (2304 + 64 * (j))
#define XB_TOP      3328
#define XB_TOPGEN   3392
#define XCD_BAR_WORDS 3456
#define XB_SPIN_CAP (1u << 22)
__device__ __forceinline__ unsigned xb_ld(unsigned* p)              { return __hip_atomic_load(p, __ATOMIC_RELAXED, __HIP_MEMORY_SCOPE_AGENT); }
__device__ __forceinline__ unsigned xb_add(unsigned* p, unsigned v) { return __hip_atomic_fetch_add(p, v, __ATOMIC_RELAXED, __HIP_MEMORY_SCOPE_AGENT); }
__device__ __forceinline__ unsigned xb_xcc_id() { return (unsigned)__builtin_amdgcn_s_getreg((3 << 11) | 20) & 0xFu; }
#define XB_SPIN(cond, bar) do { unsigned _sp = 0; while (cond) { __builtin_amdgcn_s_sleep(1); \
    if ((++_sp & 255u) == 0u) { if (xb_ld(&(bar)[XB_TMO])) break; if (_sp > XB_SPIN_CAP) { atomicAdd(&(bar)[XB_TMO], 1u); break; } } } } while (0)
struct XcdBarrier { unsigned* bar; unsigned x; volatile LAS unsigned* st; };
__device__ __forceinline__ XcdBarrier xcd_barrier_post(unsigned* bar, volatile LAS unsigned* st, int tid) {
    XcdBarrier b; b.bar = bar; b.x = xb_xcc_id(); b.st = st;
    if (tid == 0) (void)xb_add(&bar[XB_XCNT(b.x)], 1u);
    return b;
}
__device__ __forceinline__ void xcd_barrier_complete(unsigned* bar, unsigned x, unsigned& nloc, unsigned& nx) {
    const unsigned G = gridDim.x * gridDim.y * gridDim.z;
    unsigned sum, cnt, mine, sp = 0u;
    for (;;) {
        sum = 0u; cnt = 0u; mine = 0u;
#pragma unroll
        for (unsigned j = 0; j < 16; ++j) { const unsigned c = xb_ld(&bar[XB_XCNT(j)]); sum += c; cnt += (c > 0u) ? 1u : 0u; mine = (j == x) ? c : mine; }
        if (sum == G) break;
        __builtin_amdgcn_s_sleep(1);
        if ((++sp & 255u) == 0u) { if (xb_ld(&bar[XB_TMO])) break; if (sp > XB_SPIN_CAP) { atomicAdd(&bar[XB_TMO], 1u); break; } }
    }
    nloc = mine > 0u ? mine : 1u; nx = cnt > 0u ? cnt : 1u;
}
__device__ __forceinline__ void xcd_barrier(const XcdBarrier& b, int tid) {
    asm volatile("s_waitcnt vmcnt(0)" ::: "memory");
    __syncthreads();
    if (tid == 0) {
        unsigned* bar = b.bar;
        __builtin_amdgcn_s_waitcnt(0);
        unsigned nloc = b.st[0], nx = b.st[1];
        if (nloc == 0u) { xcd_barrier_complete(bar, b.x, nloc, nx); b.st[0] = nloc; b.st[1] = nx; }
        const unsigned old = xb_add(&bar[XB_XSUB(b.x)], 1u);
        const unsigned gen = old / nloc;
        if (old + 1u == (gen + 1u) * nloc) {
            __builtin_amdgcn_fence(__ATOMIC_RELEASE, "agent");
            asm volatile("s_waitcnt vmcnt(0)" ::: "memory");
            const unsigned og = xb_add(&bar[XB_TOP], 1u);
            const unsigned tg = og / nx;
            if (og + 1u == (tg + 1u) * nx) xb_add(&bar[XB_TOPGEN], 1u);
            else XB_SPIN(xb_ld(&bar[XB_TOPGEN]) == tg, bar);
            __builtin_amdgcn_fence(__ATOMIC_ACQUIRE, "agent");
            xb_add(&bar[XB_XGEN(b.x)], 1u);
            asm volatile("s_waitcnt vmcnt(0)" ::: "memory");
        } else {
            XB_SPIN(xb_ld(&bar[XB_XGEN(b.x)]) == gen, bar);
            __builtin_amdgcn_fence(__ATOMIC_ACQUIRE, "agent");
            asm volatile("s_waitcnt vmcnt(0)" ::: "memory");
        }
    }
    __syncthreads();
}

#ifdef NO_FENCE
#define EPI_FENCE() do {} while (0)
#else
#define EPI_FENCE() asm volatile("" ::: "memory")
#endif
using pg8::Unit;
struct EpiProj {
    static constexpr bool PERM = true;
    unsigned char* ws; const float *lg, *lb;
    __device__ __forceinline__ void operator()(const f32x4 (&acc)[2][2][4][2], const Unit& u, int wr, int wc, int fr, int fq) const {
        const int pn = u.pn;
#pragma unroll
        for (int ai = 0; ai < 2; ++ai)
#pragma unroll
            for (int m = 0; m < 4; ++m) {
                const int row = u.pm * 256 + ai * 128 + wr * 64 + m * 16 + fr;
                f32x4 v[2][2];
#pragma unroll
                for (int bj = 0; bj < 2; ++bj)
#pragma unroll
                    for (int n = 0; n < 2; ++n) v[bj][n] = acc[ai][bj][m][n];
                bf16* dst; int cstep = 128;
                if (pn < 4) {
                    if (((wc & 1) == 0) && fq < 2) {
                        const int pos = row & (S - 1);
                        const float* rope = (const float*)(ws + WS_ROPE);
                        const f32x4 cs0 = *(const f32x4*)(rope + (size_t)(pos * 8 + 4 * fq) * 2);
                        const f32x4 cs1 = *(const f32x4*)(rope + (size_t)(pos * 8 + 4 * fq) * 2 + 4);
#pragma unroll
                        for (int bj = 0; bj < 2; ++bj) {
                            float a, b;
                            a = v[bj][0][0]; b = v[bj][0][1]; v[bj][0][0] = a * cs0[0] - b * cs0[1]; v[bj][0][1] = b * cs0[0] + a * cs0[1];
                            a = v[bj][0][2]; b = v[bj][0][3]; v[bj][0][2] = a * cs0[2] - b * cs0[3]; v[bj][0][3] = b * cs0[2] + a * cs0[3];
                            a = v[bj][1][0]; b = v[bj][1][1]; v[bj][1][0] = a * cs1[0] - b * cs1[1]; v[bj][1][1] = b * cs1[0] + a * cs1[1];
                            a = v[bj][1][2]; b = v[bj][1][3]; v[bj][1][2] = a * cs1[2] - b * cs1[3]; v[bj][1][3] = b * cs1[2] + a * cs1[3];
                        }
                    }
                    if (pn < 2) {
#pragma unroll
                        for (int bj = 0; bj < 2; ++bj)
#pragma unroll
                            for (int n = 0; n < 2; ++n) v[bj][n] = v[bj][n] * 0.125f;
                    }
                    dst = (bf16*)(ws + (pn < 2 ? WS_Q : WS_K)) + (size_t)row * 512 + (pn & 1) * 256 + wc * 32 + 8 * fq;
                } else if (pn < 6) {
                    dst = (bf16*)(ws + WS_V) + (size_t)row * 512 + (pn - 4) * 256 + wc * 32 + 8 * fq;
                } else if (pn == 6) {
#pragma unroll
                    for (int bj = 0; bj < 2; ++bj)
#pragma unroll
                        for (int n = 0; n < 2; ++n)
#pragma unroll
                            for (int e = 0; e < 4; ++e) v[bj][n][e] = gelu_t(v[bj][n][e]);
                    dst = (bf16*)(ws + WS_U) + (size_t)row * 256 + wc * 32 + 8 * fq;
                } else if (pn == 7) {
                    float s = 0.f;
#pragma unroll
                    for (int bj = 0; bj < 2; ++bj)
#pragma unroll
                        for (int n = 0; n < 2; ++n)
#pragma unroll
                            for (int e = 0; e < 4; ++e) { v[bj][n][e] = gelu_t(v[bj][n][e]); s += v[bj][n][e]; }
                    s += __shfl_xor(s, 16); s += __shfl_xor(s, 32);
                    const float mu = s * (1.0f / 64.0f); float q = 0.f;
#pragma unroll
                    for (int bj = 0; bj < 2; ++bj)
#pragma unroll
                        for (int n = 0; n < 2; ++n)
#pragma unroll
                            for (int e = 0; e < 4; ++e) { v[bj][n][e] -= mu; q += v[bj][n][e] * v[bj][n][e]; }
                    q += __shfl_xor(q, 16); q += __shfl_xor(q, 32);
                    const float rstd = rsqrtf(q * (1.0f / 64.0f) + LN_EPS);
#pragma unroll
                    for (int bj = 0; bj < 2; ++bj)
#pragma unroll
                        for (int n = 0; n < 2; ++n) {
                            const int dim = wc * 64 + 32 * bj + 8 * fq + 4 * n;
                            const f32x4 gg = *(const f32x4*)(lg + dim), bb = *(const f32x4*)(lb + dim);
                            v[bj][n] = v[bj][n] * rstd * gg + bb;
                        }
                    dst = (bf16*)(ws + WS_G) + (size_t)row * 256 + wc * 64 + 8 * fq; cstep = 32;
                } else {
                    dst = (bf16*)(ws + WS_Z) + (size_t)row * 256 + wc * 32 + 8 * fq;
                }
#pragma unroll
                for (int bj = 0; bj < 2; ++bj) {
                    v4u w; w.x = pk2(v[bj][0][0], v[bj][0][1]); w.y = pk2(v[bj][0][2], v[bj][0][3]); w.z = pk2(v[bj][1][0], v[bj][1][1]); w.w = pk2(v[bj][1][2], v[bj][1][3]);
                    *(v4u*)(dst + bj * cstep) = w;
                }
                EPI_FENCE();
            }
    }
};
struct EpiOut {
    static constexpr bool PERM = false;
    const float* xres; float* Y;
    __device__ __forceinline__ void operator()(const f32x4 (&acc)[2][2][4][2], const Unit& u, int wr, int wc, int fr, int fq) const {
        const int col0 = u.pn * 256 + wc * 32 + 4 * fq;
#pragma unroll
        for (int ai = 0; ai < 2; ++ai)
#pragma unroll
            for (int m = 0; m < 4; ++m) {
                const size_t off = (size_t)(u.pm * 256 + ai * 128 + wr * 64 + m * 16 + fr) * D + col0;
#pragma unroll
                for (int bj = 0; bj < 2; ++bj)
#pragma unroll
                    for (int n = 0; n < 2; ++n) {
                        const f32x4 xr = *(const f32x4*)(xres + off + bj * 128 + n * 16);
                        *(f32x4*)(Y + off + bj * 128 + n * 16) = acc[ai][bj][m][n] + xr * ALPHA;
                    }
                EPI_FENCE();
            }
    }
};
struct EpiGU {
    static constexpr bool PERM = true;
    bf16* H;
    __device__ __forceinline__ void operator()(const f32x4 (&acc)[2][2][4][2], const Unit& u, int wr, int wc, int fr, int fq) const {
#pragma unroll
        for (int ai = 0; ai < 2; ++ai)
#pragma unroll
            for (int m = 0; m < 4; ++m) {
                const int row = u.pm * 256 + ai * 128 + wr * 64 + m * 16 + fr;
                float hv[8];
#pragma unroll
                for (int n = 0; n < 2; ++n)
#pragma unroll
                    for (int e = 0; e < 4; ++e) hv[4 * n + e] = silu_f(acc[ai][0][m][n][e]) * acc[ai][1][m][n][e];
                v4u w; w.x = pk2(hv[0], hv[1]); w.y = pk2(hv[2], hv[3]); w.z = pk2(hv[4], hv[5]); w.w = pk2(hv[6], hv[7]);
                *(v4u*)(H + (size_t)row * FF + u.pn * 128 + wc * 32 + 8 * fq) = w;
            }
    }
};
struct EpiDown {
    static constexpr bool PERM = true;
    bf16* Y; const float* gs;
    __device__ __forceinline__ void operator()(const f32x4 (&acc)[2][2][4][2], const Unit& u, int wr, int wc, int fr, int fq) const {
#pragma unroll
        for (int ai = 0; ai < 2; ++ai)
#pragma unroll
            for (int m = 0; m < 4; ++m) {
                const int row = u.pm * 256 + ai * 128 + wr * 64 + m * 16 + fr;
                const float g = gs[row];
#pragma unroll
                for (int bj = 0; bj < 2; ++bj) {
                    const f32x4 a = acc[ai][bj][m][0] * g, b = acc[ai][bj][m][1] * g;
                    v4u w; w.x = pk2(a[0], a[1]); w.y = pk2(a[2], a[3]); w.z = pk2(b[0], b[1]); w.w = pk2(b[2], b[3]);
                    *(v4u*)(Y + (size_t)row * D + u.pn * 256 + bj * 128 + wc * 32 + 8 * fq) = w;
                }
                EPI_FENCE();
            }
    }
};

__device__ __forceinline__ int win_src_col(int n) {
    if (n < 1024) { int t = n & 63; const int hb = n & ~63; if (t < 16) t = (t & 1) ? 8 + (t >> 1) : (t >> 1); return hb + t; }
    if (n >= 1792 && n < 2048) { const int t = n - 1792, bj = t >> 7, wc = (t >> 5) & 3, j = t & 31; return 1792 + 64 * wc + 32 * bj + j; }
    return n;
}
__device__ __forceinline__ void p0_tr_item(const float* cp, int ld, int K, bf16* WT, int k0, int n0, LAS float* scr, int lane) {
#pragma unroll 8
    for (int i = 0; i < 32; ++i) { const int kk = 2 * i + (lane >> 5); scr[kk * 33 + (lane & 31)] = cp[(size_t)(k0 + kk) * ld]; }
    LDS_WAIT(); asm volatile("" ::: "memory");
    const int c = lane & 7;
#pragma unroll
    for (int j = 0; j < 4; ++j) { const int n = (lane >> 3) + 8 * j; const LAS float* s = scr + (8 * c) * 33 + n;
        v4u o; o.x = pk2(s[0 * 33], s[1 * 33]); o.y = pk2(s[2 * 33], s[3 * 33]); o.z = pk2(s[4 * 33], s[5 * 33]); o.w = pk2(s[6 * 33], s[7 * 33]);
        *(v4u*)(WT + (size_t)(n0 + n) * K + k0 + 8 * c) = o; }
    LDS_WAIT(); asm volatile("" ::: "memory");
}
struct Ptrs {
    const float *x, *w_in, *w_out, *lg, *lb, *wsp, *bsp, *pw, *psc, *ln1g, *ln1b, *rw, *rb, *wg, *wu, *wd, *ln2g, *ln2b;
    float* out; unsigned char* ws;
};
__device__ __forceinline__ void p0_prologue(const Ptrs& P, LAS unsigned char* lds, int vcu, int G, int wave, int lane, int tid) {
    LAS float* scr = (LAS float*)(lds + wave * 16384);
    const int gw = vcu * NWAVES + wave, NGW = G * NWAVES;
    bf16* WIN = (bf16*)(P.ws + WS_WIN); bf16* WOUT = (bf16*)(P.ws + WS_WOUT); bf16* WGU = (bf16*)(P.ws + WS_WGU); bf16* WDN = (bf16*)(P.ws + WS_WDN);
    constexpr int I_IN = 16 * 72, I_OUT = 16 * 32, I_GU = 16 * 32, I_DN = 8 * 32;
    constexpr int N_IN = 2 * I_IN, N_OUT = 2 * I_OUT, N_GU = 32 * I_GU, N_DN = 32 * I_DN;
    for (int it = gw; it < N_IN + N_OUT + N_GU + N_DN; it += NGW) {
        int r = it;
        if (r < N_IN) { const int l = r / I_IN; r -= l * I_IN; const int kb = r / 72, nb = r % 72;
            const float* cp = P.w_in + (size_t)l * D * NCOL + win_src_col(32 * nb + (lane & 31));
            p0_tr_item(cp, NCOL, D, WIN + (size_t)l * NCOL * D, 64 * kb, 32 * nb, scr, lane); continue; }
        r -= N_IN;
        if (r < N_OUT) { const int l = r / I_OUT; r -= l * I_OUT; const int kb = r / 32, nb = r % 32;
            const float* cp = P.w_out + (size_t)l * D * D + 32 * nb + (lane & 31);
            p0_tr_item(cp, D, D, WOUT + (size_t)l * D * D, 64 * kb, 32 * nb, scr, lane); continue; }
        r -= N_OUT;
        if (r < N_GU) { const int le = r / I_GU; r -= le * I_GU; const int kb = r / 32, nb = r % 32;
            const int n = 32 * nb + (lane & 31), pn = n >> 8, t = n & 255;
            const float* cp = (t < 128 ? P.wg : P.wu) + (size_t)le * D * FF + 128 * pn + (t & 127);
            p0_tr_item(cp, FF, D, WGU + (size_t)le * 1024 * D, 64 * kb, 32 * nb, scr, lane); continue; }
        r -= N_GU;
        { const int le = r / I_DN; r -= le * I_DN; const int kb = r / 32, nb = r % 32;
            const float* cp = P.wd + (size_t)le * FF * D + 32 * nb + (lane & 31);
            p0_tr_item(cp, D, FF, WDN + (size_t)le * D * FF, 64 * kb, 32 * nb, scr, lane); }
    }
    bf16* XB = (bf16*)(P.ws + WS_HB);
    for (size_t i = (size_t)gw * 64 + lane; i < (size_t)T * D / 8; i += (size_t)NGW * 64) {
        const f32x4 a = *(const f32x4*)(P.x + i * 8), b = *(const f32x4*)(P.x + i * 8 + 4);
        v4u w; w.x = pk2(a[0], a[1]); w.y = pk2(a[2], a[3]); w.z = pk2(b[0], b[1]); w.w = pk2(b[2], b[3]);
        *(v4u*)(XB + i * 8) = w;
    }
    const int gt = vcu * NTHREADS + tid, NGT = G * NTHREADS;
    float* rope = (float*)(P.ws + WS_ROPE);
    for (int i = gt; i < S * 8; i += NGT) { const int pos = i >> 3, k = i & 7;
        const float inv = powf(500000.0f, -(float)k / 8.0f); const float ang = (float)pos * inv;
        rope[2 * i] = cosf(ang); rope[2 * i + 1] = sinf(ang); }
    bf16* WPT = (bf16*)(P.ws + WS_WPT);
    for (int i = gt; i < 2 * 4 * 64 * 64; i += NGT) { const int ii = i & 63, o = (i >> 6) & 63, lgi = i >> 12;
        WPT[i] = (bf16)(pk2(P.pw[((size_t)lgi * 64 + ii) * 64 + o], 0.f) & 0xffffu); }
    bf16* WST = (bf16*)(P.ws + WS_WST);
    for (int i = gt; i < 2 * 4 * 128 * 128; i += NGT) WST[i] = (bf16)(pk2(P.wsp[i], 0.f) & 0xffffu);
    float* RWT = (float*)(P.ws + WS_RWT);
    for (int i = gt; i < 16 * 1024; i += NGT) { const int e = i >> 10, k = i & 1023; RWT[i] = P.rw[(size_t)k * 16 + e]; }
}

constexpr int KT_STRIDE = 144, VT_STRIDE = 192;
constexpr int ATT_WAVE_LDS = 32 * KT_STRIDE + 32 * VT_STRIDE;
#define MFMA32(a, b, c) __builtin_amdgcn_mfma_f32_32x32x16_bf16((a), (b), (c), 0, 0, 0)
__device__ __forceinline__ s16x4 tr16(LAS unsigned char* p) { return __builtin_amdgcn_ds_read_tr16_b64_v4i16((LAS s16x4*)p); }

__device__ __forceinline__ void attn_task(const bf16* __restrict__ Qb, const bf16* __restrict__ Kb, const bf16* __restrict__ Vb, bf16* __restrict__ POc, float* __restrict__ LSEc,
                                          int b, int h, int dsh, int r, int j0, LAS unsigned char* kt, LAS unsigned char* vt, int lane) {
    const int dil = 1 << dsh, L = S >> dsh;
    const int qi = lane & 31, hh = lane >> 5;
    const size_t brow = (size_t)b * S;
    const size_t qrow = brow + (size_t)(j0 + qi) * dil + r;
    const bf16* qp = Qb + qrow * 512 + h * 64 + 8 * hh;
    bf16x8 qf[4];
#pragma unroll
    for (int ks = 0; ks < 4; ++ks) qf[ks] = *(const bf16x8*)(qp + 16 * ks);
    int kb_lo = 2 - (j0 >> 5); if (kb_lo < 0) kb_lo = 0;
    int kb_hi = ((L - j0) >> 5) + 1; if (kb_hi > 4) kb_hi = 4;
    const int srow = lane >> 3, sch = lane & 7;
    const bf16* kbase = Kb + (brow + r) * 512 + h * 64 + sch * 8;
    const bf16* vbase = Vb + (brow + r) * 512 + h * 64 + sch * 8;
    v4u kreg[4], vreg[4];
    {
        const int jk0 = j0 - 64 + 32 * kb_lo;
#pragma unroll
        for (int i = 0; i < 4; ++i) { const size_t off = (size_t)(jk0 + srow + 8 * i) * dil * 512; kreg[i] = *(const v4u*)(kbase + off); vreg[i] = *(const v4u*)(vbase + off); }
    }
    f32x16 o0, o1;
#pragma unroll
    for (int i = 0; i < 16; ++i) { o0[i] = 0.f; o1[i] = 0.f; }
    float m = -1e30f, l = 0.f;
    const int q4 = (lane & 15) >> 2, p4 = lane & 3, blk = (lane >> 4) & 1;
    LAS unsigned char* vrd = vt + (4 * hh + q4) * VT_STRIDE + (16 * blk + 4 * p4) * 2;
    for (int kb = kb_lo; kb <= kb_hi; ++kb) {
#pragma unroll
        for (int i = 0; i < 4; ++i) { *(LAS v4u*)(kt + (srow + 8 * i) * KT_STRIDE + sch * 16) = kreg[i]; *(LAS v4u*)(vt + (srow + 8 * i) * VT_STRIDE + sch * 16) = vreg[i]; }
        if (kb < kb_hi) {
            const int jk0 = j0 - 64 + 32 * (kb + 1);
#pragma unroll
            for (int i = 0; i < 4; ++i) { const size_t off = (size_t)(jk0 + srow + 8 * i) * dil * 512; kreg[i] = *(const v4u*)(kbase + off); vreg[i] = *(const v4u*)(vbase + off); }
        }
        f32x16 st;
#pragma unroll
        for (int i = 0; i < 16; ++i) st[i] = 0.f;
#pragma unroll
        for (int ks = 0; ks < 4; ++ks) { const bf16x8 kf = *(const LAS bf16x8*)(kt + qi * KT_STRIDE + (16 * ks + 8 * hh) * 2); st = MFMA32(kf, qf[ks], st); }
        float mx = -1e30f;
#pragma unroll
        for (int i = 0; i < 16; ++i) { float s = st[i] * LOG2E; const int kl = crow(i, hh);
            if (kb == 0 && kl < qi) s = -1e30f;
            if (kb == 4 && kl > qi) s = -1e30f;
            st[i] = s; mx = fmaxf(mx, s); }
        mx = fmaxf(mx, __shfl_xor(mx, 32));
        const float mn = fmaxf(m, mx); const float alpha = fast_exp2(m - mn); m = mn;
        float ps = 0.f;
#pragma unroll
        for (int i = 0; i < 16; ++i) { const float p = fast_exp2(st[i] - mn); ps += p; st[i] = p; }
        l = l * alpha + ps;
        o0 = o0 * alpha; o1 = o1 * alpha;
        bf16x8 pf[2];
#pragma unroll
        for (int s = 0; s < 2; ++s) { v4u w; w.x = pk2(st[8 * s], st[8 * s + 1]); w.y = pk2(st[8 * s + 2], st[8 * s + 3]); w.z = pk2(st[8 * s + 4], st[8 * s + 5]); w.w = pk2(st[8 * s + 6], st[8 * s + 7]);
            pf[s] = __builtin_bit_cast(bf16x8, w); }
#pragma unroll
        for (int s = 0; s < 2; ++s) {
            { const s16x4 lo = tr16(vrd + (16 * s) * VT_STRIDE), hi = tr16(vrd + (16 * s + 8) * VT_STRIDE);
              const bf16x8 vf = __builtin_shufflevector(lo, hi, 0, 1, 2, 3, 4, 5, 6, 7); o0 = MFMA32(vf, pf[s], o0); }
            { const s16x4 lo = tr16(vrd + (16 * s) * VT_STRIDE + 64), hi = tr16(vrd + (16 * s + 8) * VT_STRIDE + 64);
              const bf16x8 vf = __builtin_shufflevector(lo, hi, 0, 1, 2, 3, 4, 5, 6, 7); o1 = MFMA32(vf, pf[s], o1); }
        }
    }
    l += __shfl_xor(l, 32);
    const float inv = 1.0f / l;
    bf16* op = POc + qrow * 512 + h * 64 + 4 * hh;
#pragma unroll
    for (int g4 = 0; g4 < 4; ++g4) {
        v2u w; w.x = pk2(o0[4 * g4] * inv, o0[4 * g4 + 1] * inv); w.y = pk2(o0[4 * g4 + 2] * inv, o0[4 * g4 + 3] * inv); *(v2u*)(op + 8 * g4) = w;
        v2u w1; w1.x = pk2(o1[4 * g4] * inv, o1[4 * g4 + 1] * inv); w1.y = pk2(o1[4 * g4 + 2] * inv, o1[4 * g4 + 3] * inv); *(v2u*)(op + 32 + 8 * g4) = w1;
    }
    if (hh == 0) LSEc[qrow * 8 + h] = m + __log2f(l);
}

__device__ __forceinline__ void p2_attention(const unsigned char* ws, unsigned char* wsw, LAS unsigned char* lds, int vcu, int G, int wave, int lane, int tid) {
    const bf16* Qb = (const bf16*)(ws + WS_Q); const bf16* Kb = (const bf16*)(ws + WS_K); const bf16* Vb = (const bf16*)(ws + WS_V);
    bf16* PO = (bf16*)(wsw + WS_PO); float* LSE = (float*)(wsw + WS_LSE); bf16* CC = (bf16*)(wsw + WS_CC);
    LAS unsigned char* kt = lds + wave * ATT_WAVE_LDS; LAS unsigned char* vt = kt + 32 * KT_STRIDE;
    for (int item = vcu; item < NB * 8 * 2; item += G) {
        const int sp = item & 1, h = (item >> 1) & 7, b = item >> 4;
        for (int task = wave; task < 96; task += NWAVES) {
            const int c = task >> 5, tt = task & 31, dsh = 2 * c;
            const int r = tt >> (5 - dsh), jb = tt & ((32 >> dsh) - 1);
            const int j0 = ((1024 * sp) >> dsh) + 32 * jb;
            attn_task(Qb, Kb, Vb, PO + (size_t)c * T * 512, LSE + (size_t)c * T * 8, b, h, dsh, r, j0, kt, vt, lane);
        }
        __syncthreads();
        for (int it = tid; it < 8192; it += NTHREADS) {
            const int pl = it >> 3, ch = it & 7; const size_t row = (size_t)b * S + 1024 * sp + pl;
            const float l0 = LSE[row * 8 + h], l1 = LSE[((size_t)T + row) * 8 + h], l2 = LSE[((size_t)2 * T + row) * 8 + h];
            const float mx = fmaxf(l0, fmaxf(l1, l2));
            float w0 = fast_exp2(l0 - mx), w1 = fast_exp2(l1 - mx), w2 = fast_exp2(l2 - mx);
            const float inv = 1.0f / (w0 + w1 + w2); w0 *= inv; w1 *= inv; w2 *= inv;
            const v4u a = *(const v4u*)(PO + row * 512 + h * 64 + 8 * ch), bq = *(const v4u*)(PO + ((size_t)T + row) * 512 + h * 64 + 8 * ch), cq = *(const v4u*)(PO + ((size_t)2 * T + row) * 512 + h * 64 + 8 * ch);
            v4u o;
            o.x = pk2(w0 * bflo(a.x) + w1 * bflo(bq.x) + w2 * bflo(cq.x), w0 * bfhi(a.x) + w1 * bfhi(bq.x) + w2 * bfhi(cq.x));
            o.y = pk2(w0 * bflo(a.y) + w1 * bflo(bq.y) + w2 * bflo(cq.y), w0 * bfhi(a.y) + w1 * bfhi(bq.y) + w2 * bfhi(cq.y));
            o.z = pk2(w0 * bflo(a.z) + w1 * bflo(bq.z) + w2 * bflo(cq.z), w0 * bfhi(a.z) + w1 * bfhi(bq.z) + w2 * bfhi(cq.z));
            o.w = pk2(w0 * bflo(a.w) + w1 * bflo(bq.w) + w2 * bflo(cq.w), w0 * bfhi(a.w) + w1 * bfhi(bq.w) + w2 * bfhi(cq.w));
            *(v4u*)(CC + row * D + h * 64 + 8 * ch) = o;
        }
        __syncthreads();
    }
}
__device__ __forceinline__ void p2_gmlp(const Ptrs& P, int l, LAS unsigned char* lds, int vcu, int G, int wave, int lane, int tid) {
    const bf16* Gb = (const bf16*)(P.ws + WS_G); const bf16* Ub = (const bf16*)(P.ws + WS_U); bf16* CC = (bf16*)(P.ws + WS_CC);
    const bf16* WST = (const bf16*)(P.ws + WS_WST) + (size_t)l * 4 * 128 * 128;
    const float* bs = P.bsp + l * 4 * 128;
    const int hh = lane >> 5, q4 = (lane & 15) >> 2, p4 = lane & 3, blk = (lane >> 4) & 1;
    const int pb = wave & 3, db = wave >> 2;
    for (int item = vcu; item < NB * 16 * 4; item += G) {
        const int g = item & 3, cch = (item >> 2) & 15, b = item >> 6;
        const size_t row0 = (size_t)b * S + cch * 128;
#pragma unroll
        for (int i = 0; i < 2; ++i) { const int idx = tid + NTHREADS * i, q = idx >> 3, ch = idx & 7;
            *(LAS v4u*)(lds + q * VT_STRIDE + ch * 16) = *(const v4u*)(Gb + (row0 + q) * 256 + g * 64 + ch * 8); }
        __syncthreads();
        f32x16 acc;
#pragma unroll
        for (int i = 0; i < 16; ++i) acc[i] = 0.f;
        const bf16* wp = WST + ((size_t)g * 128 + 32 * pb + (lane & 31)) * 128 + 8 * hh;
        LAS unsigned char* vrd = lds + (8 * hh + q4) * VT_STRIDE + (32 * db + 16 * blk + 4 * p4) * 2;
#pragma unroll
        for (int s = 0; s < 8; ++s) {
            const bf16x8 wf = *(const bf16x8*)(wp + 16 * s);
            const s16x4 lo = tr16(vrd + (16 * s) * VT_STRIDE), hi = tr16(vrd + (16 * s + 4) * VT_STRIDE);
            const bf16x8 vf = __builtin_shufflevector(lo, hi, 0, 1, 2, 3, 4, 5, 6, 7);
            acc = MFMA32(vf, wf, acc);
        }
        const int p = 32 * pb + (lane & 31);
        const float bsv = bs[g * 128 + p];
#pragma unroll
        for (int g4 = 0; g4 < 4; ++g4) {
            const int d0 = 32 * db + 8 * g4 + 4 * hh;
            const v2u uu = *(const v2u*)(Ub + (row0 + p) * 256 + g * 64 + d0);
            v2u w; w.x = pk2(bflo(uu.x) * (acc[4 * g4] + bsv), bfhi(uu.x) * (acc[4 * g4 + 1] + bsv)); w.y = pk2(bflo(uu.y) * (acc[4 * g4 + 2] + bsv), bfhi(uu.y) * (acc[4 * g4 + 3] + bsv));
            *(v2u*)(CC + (row0 + p) * D + 512 + g * 64 + d0) = w;
        }
        __syncthreads();
    }
}
__device__ __forceinline__ void p2_pool(const Ptrs& P, int l, int vcu, int G, int wave, int lane) {
    const bf16* Zb = (const bf16*)(P.ws + WS_Z); bf16* CC = (bf16*)(P.ws + WS_CC);
    const bf16* WPT = (const bf16*)(P.ws + WS_WPT) + (size_t)l * 4 * 64 * 64;
    const float* psc = P.psc + l * 256;
    const int hh = lane >> 5, pl = lane & 31;
    const int gw = vcu * NWAVES + wave, NGW = G * NWAVES;
    for (int task = gw; task < NB * 4 * 64; task += NGW) {
        const int tile = task & 63, g = (task >> 6) & 3, b = task >> 8;
        const int pos = 32 * tile + pl;
        const int w = 2 << g, left = w >> 1, right = w - 1 - left;
        int lo = pos - left; if (lo < 0) lo = 0;
        int hi = pos + right + 1; if (hi > S) hi = S;
        const float inv = 1.0f / (float)(hi - lo);
        const bf16* zb = Zb + (size_t)b * S * 256 + g * 64 + 8 * hh;
        bf16x8 bfr[4];
#pragma unroll
        for (int ks = 0; ks < 4; ++ks) {
            float sm[8];
#pragma unroll
            for (int e = 0; e < 8; ++e) sm[e] = 0.f;
            for (int t = lo; t < hi; ++t) { const v4u z = *(const v4u*)(zb + (size_t)t * 256 + 16 * ks);
                sm[0] += bflo(z.x); sm[1] += bfhi(z.x); sm[2] += bflo(z.y); sm[3] += bfhi(z.y); sm[4] += bflo(z.z); sm[5] += bfhi(z.z); sm[6] += bflo(z.w); sm[7] += bfhi(z.w); }
            const v4u z = *(const v4u*)(zb + (size_t)pos * 256 + 16 * ks);
            v4u o; o.x = pk2(sm[0] * inv - bflo(z.x), sm[1] * inv - bfhi(z.x)); o.y = pk2(sm[2] * inv - bflo(z.y), sm[3] * inv - bfhi(z.y));
            o.z = pk2(sm[4] * inv - bflo(z.z), sm[5] * inv - bfhi(z.z)); o.w = pk2(sm[6] * inv - bflo(z.w), sm[7] * inv - bfhi(z.w));
            bfr[ks] = __builtin_bit_cast(bf16x8, o);
        }
#pragma unroll
        for (int ob = 0; ob < 2; ++ob) {
            f32x16 acc;
#pragma unroll
            for (int i = 0; i < 16; ++i) acc[i] = 0.f;
#pragma unroll
            for (int ks = 0; ks < 4; ++ks) { const bf16x8 af = *(const bf16x8*)(WPT + ((size_t)g * 64 + 32 * ob + pl) * 64 + 16 * ks + 8 * hh); acc = MFMA32(af, bfr[ks], acc); }
#pragma unroll
            for (int g4 = 0; g4 < 4; ++g4) {
                const int o0 = 32 * ob + 8 * g4 + 4 * hh;
                const f32x4 sc = *(const f32x4*)(psc + g * 64 + o0);
                v2u w; w.x = pk2(acc[4 * g4] * sc[0], acc[4 * g4 + 1] * sc[1]); w.y = pk2(acc[4 * g4 + 2] * sc[2], acc[4 * g4 + 3] * sc[3]);
                *(v2u*)(CC + ((size_t)b * S + pos) * D + 768 + g * 64 + o0) = w;
            }
        }
    }
}

__device__ __forceinline__ void route16(const float* logit, const float* __restrict__ rbias, int& e0, int& e1, float& g0, float& g1) {
    float sc[16], bi[16];
#pragma unroll
    for (int e = 0; e < 16; ++e) { sc[e] = 1.0f / (1.0f + expf(-logit[e])); bi[e] = sc[e] + rbias[e]; }
    int gsel = 0; float best = -1e30f;
#pragma unroll
    for (int g = 0; g < 4; ++g) {
        float m1 = -1e30f, m2 = -1e30f;
#pragma unroll
        for (int j = 0; j < 4; ++j) { const float v = bi[g * 4 + j]; if (v > m1) { m2 = m1; m1 = v; } else if (v > m2) m2 = v; }
        const float gs = m1 + m2;
        if (gs > best) { best = gs; gsel = g; }
    }
    float bg[4], sg[4];
#pragma unroll
    for (int j = 0; j < 4; ++j) { bg[j] = bi[j]; sg[j] = sc[j];
#pragma unroll
        for (int g = 1; g < 4; ++g) { bg[j] = (g == gsel) ? bi[g * 4 + j] : bg[j]; sg[j] = (g == gsel) ? sc[g * 4 + j] : sg[j]; } }
    int i1 = 0; float m1 = bg[0], s1 = sg[0];
#pragma unroll
    for (int j = 1; j < 4; ++j) if (bg[j] > m1) { m1 = bg[j]; i1 = j; s1 = sg[j]; }
    int i2 = -1; float m2 = -1e30f, s2 = 0.f;
#pragma unroll
    for (int j = 0; j < 4; ++j) if (j != i1 && bg[j] > m2) { m2 = bg[j]; i2 = j; s2 = sg[j]; }
    e0 = gsel * 4 + i1; e1 = gsel * 4 + i2;
    g0 = s1 / (s1 + s2); g1 = s2 / (s1 + s2);
}
__device__ __forceinline__ void p4_ln_router(const Ptrs& P, int l, LAS unsigned char* lds, int wave, int lane, int tid) {
    float* X1 = (float*)(P.ws + WS_X1); bf16* X1B = (bf16*)(P.ws + WS_HB);
    int* TOKE = (int*)(P.ws + WS_TOKE); float* TOKG = (float*)(P.ws + WS_TOKG); int* TOKP = (int*)(P.ws + WS_TOKP);
    unsigned* cnt = (unsigned*)(P.ws + WS_CTL) + CW_CNT + 16 * l;
    const float* RWT = (const float*)(P.ws + WS_RWT);
    const float* lng = P.ln1g + l * D; const float* lnb = P.ln1b + l * D;
    LAS float* rwt = (LAS float*)lds;
    for (int i = tid; i < 16 * 1024 / 4; i += NTHREADS) ((LAS f32x4*)rwt)[i] = ((const f32x4*)RWT)[i];
    LAS int* s_cnt = (LAS int*)(lds + 65536); LAS int* s_base = s_cnt + 16; LAS int* s_e = s_cnt + 32; LAS int* s_pos = s_e + 256;
    if (tid < 16) s_cnt[tid] = 0;
    __syncthreads();
    f32x4 gq[4], bq[4];
#pragma unroll
    for (int j = 0; j < 4; ++j) { gq[j] = *(const f32x4*)(lng + 4 * lane + 256 * j); bq[j] = *(const f32x4*)(lnb + 4 * lane + 256 * j); }
    for (int blk_row = blockIdx.x * 128; blk_row < T; blk_row += gridDim.x * 128) {
        for (int g4 = 0; g4 < 4; ++g4) {
            const int rowb = blk_row + wave * 16 + 4 * g4;
            f32x4 v[4][4];
#pragma unroll
            for (int rr = 0; rr < 4; ++rr) {
                float* xr = X1 + (size_t)(rowb + rr) * D + 4 * lane;
                float s = 0.f;
#pragma unroll
                for (int j = 0; j < 4; ++j) { v[rr][j] = *(const f32x4*)(xr + 256 * j); s += (v[rr][j][0] + v[rr][j][1]) + (v[rr][j][2] + v[rr][j][3]); }
                const float mu = wave_sum(s) * (1.0f / D); float q = 0.f;
#pragma unroll
                for (int j = 0; j < 4; ++j) { v[rr][j] = v[rr][j] - mu; q += (v[rr][j][0] * v[rr][j][0] + v[rr][j][1] * v[rr][j][1]) + (v[rr][j][2] * v[rr][j][2] + v[rr][j][3] * v[rr][j][3]); }
                const float rstd = rsqrtf(wave_sum(q) * (1.0f / D) + LN_EPS);
#pragma unroll
                for (int j = 0; j < 4; ++j) { v[rr][j] = v[rr][j] * rstd * gq[j] + bq[j];
                    *(f32x4*)(xr + 256 * j) = v[rr][j];
                    v2u w; w.x = pk2(v[rr][j][0], v[rr][j][1]); w.y = pk2(v[rr][j][2], v[rr][j][3]);
                    *(v2u*)(X1B + (size_t)(rowb + rr) * D + 4 * lane + 256 * j) = w; }
            }
            float lrow0 = 0.f, lrow1 = 0.f, lrow2 = 0.f, lrow3 = 0.f;
#pragma unroll 1
            for (int e = 0; e < 16; ++e) {
                float a0 = 0.f, a1 = 0.f, a2 = 0.f, a3 = 0.f;
#pragma unroll
                for (int j = 0; j < 4; ++j) { const f32x4 w = *(const LAS f32x4*)(rwt + e * 1024 + 4 * lane + 256 * j);
                    a0 += v[0][j][0] * w[0] + v[0][j][1] * w[1] + v[0][j][2] * w[2] + v[0][j][3] * w[3];
                    a1 += v[1][j][0] * w[0] + v[1][j][1] * w[1] + v[1][j][2] * w[2] + v[1][j][3] * w[3];
                    a2 += v[2][j][0] * w[0] + v[2][j][1] * w[1] + v[2][j][2] * w[2] + v[2][j][3] * w[3];
                    a3 += v[3][j][0] * w[0] + v[3][j][1] * w[1] + v[3][j][2] * w[2] + v[3][j][3] * w[3]; }
                a0 = wave_sum(a0); a1 = wave_sum(a1); a2 = wave_sum(a2); a3 = wave_sum(a3);
                lrow0 = (lane == e) ? a0 : lrow0; lrow1 = (lane == e) ? a1 : lrow1; lrow2 = (lane == e) ? a2 : lrow2; lrow3 = (lane == e) ? a3 : lrow3;
            }
#pragma unroll
            for (int rr = 0; rr < 4; ++rr) {
                const float lr = rr == 0 ? lrow0 : (rr == 1 ? lrow1 : (rr == 2 ? lrow2 : lrow3));
                float lgs[16];
#pragma unroll
                for (int j = 0; j < 16; ++j) lgs[j] = __builtin_bit_cast(float, __builtin_amdgcn_readlane(__builtin_bit_cast(int, lr), j));
                int e0, e1; float g0, g1;
                route16(lgs, P.rb, e0, e1, g0, g1);
                if (lane == 0) {
                    const int row = rowb + rr, tl = row - blk_row;
                    const int p0 = __hip_atomic_fetch_add(s_cnt + e0, 1, __ATOMIC_RELAXED, __HIP_MEMORY_SCOPE_WORKGROUP);
                    const int p1 = __hip_atomic_fetch_add(s_cnt + e1, 1, __ATOMIC_RELAXED, __HIP_MEMORY_SCOPE_WORKGROUP);
                    s_e[2 * tl] = e0; s_e[2 * tl + 1] = e1; s_pos[2 * tl] = p0; s_pos[2 * tl + 1] = p1;
                    TOKE[2 * row] = e0; TOKE[2 * row + 1] = e1; TOKG[2 * row] = g0; TOKG[2 * row + 1] = g1;
                }
            }
        }
        __syncthreads();
        if (tid < 16) s_base[tid] = (int)__hip_atomic_fetch_add(cnt + tid, (unsigned)s_cnt[tid], RLX_AGENT);
        __syncthreads();
        if (tid < 256) TOKP[2 * blk_row + tid] = s_base[s_e[tid]] + s_pos[tid];
        if (tid < 16) s_cnt[tid] = 0;
        __syncthreads();
    }
}
__device__ __forceinline__ int build_tables(const unsigned char* ws, int l, LAS unsigned char* lds, int tid) {
    LAS int* s_base = (LAS int*)(lds + TAB_OFF); LAS int* texp = s_base + 32;
    const unsigned* cnt = (const unsigned*)(ws + WS_CTL) + CW_CNT + 16 * l;
    if (tid == 0) {
        int base = 0;
        for (int e = 0; e < 16; ++e) { const int c = (int)__hip_atomic_load(cnt + e, RLX_AGENT); const int nt = (c + 255) >> 8;
            s_base[e] = base; for (int t = 0; t < nt; ++t) texp[(base >> 8) + t] = e; base += nt << 8; }
        s_base[16] = base;
    }
    __syncthreads();
    return s_base[16] >> 8;
}
__device__ __forceinline__ void p5_gather(const Ptrs& P, LAS unsigned char* lds, int vcu, int G, int wave, int lane) {
    const LAS int* s_base = (const LAS int*)(lds + TAB_OFF);
    const bf16* X1B = (const bf16*)(P.ws + WS_HB); bf16* XG = (bf16*)(P.ws + WS_XG);
    const int* TOKE = (const int*)(P.ws + WS_TOKE); const float* TOKG = (const float*)(P.ws + WS_TOKG); const int* TOKP = (const int*)(P.ws + WS_TOKP);
    int* SLOT = (int*)(P.ws + WS_SLOT); float* GS = (float*)(P.ws + WS_GSORT);
    const int gw = vcu * NWAVES + wave, NGW = G * NWAVES;
    for (int t = gw; t < T; t += NGW) {
        const int e0 = TOKE[2 * t], e1 = TOKE[2 * t + 1];
        const int r0 = s_base[e0] + TOKP[2 * t], r1 = s_base[e1] + TOKP[2 * t + 1];
        const v4u a = *(const v4u*)(X1B + (size_t)t * D + 8 * lane), b = *(const v4u*)(X1B + (size_t)t * D + 512 + 8 * lane);
        *(v4u*)(XG + (size_t)r0 * D + 8 * lane) = a; *(v4u*)(XG + (size_t)r0 * D + 512 + 8 * lane) = b;
        *(v4u*)(XG + (size_t)r1 * D + 8 * lane) = a; *(v4u*)(XG + (size_t)r1 * D + 512 + 8 * lane) = b;
        if (lane == 0) { GS[r0] = TOKG[2 * t]; GS[r1] = TOKG[2 * t + 1]; SLOT[2 * t] = r0; SLOT[2 * t + 1] = r1; }
    }
}
__device__ __forceinline__ void p8_ln2(const Ptrs& P, int l, float* outp, bool write_xb, int vcu, int G, int wave, int lane) {
    const float* X1 = (const float*)(P.ws + WS_X1); const bf16* YB = (const bf16*)(P.ws + WS_XG); bf16* XB = (bf16*)(P.ws + WS_HB);
    const int* SLOT = (const int*)(P.ws + WS_SLOT);
    const float* lng = P.ln2g + l * D; const float* lnb = P.ln2b + l * D;
    f32x4 gq[4], bq[4];
#pragma unroll
    for (int j = 0; j < 4; ++j) { gq[j] = *(const f32x4*)(lng + 4 * lane + 256 * j); bq[j] = *(const f32x4*)(lnb + 4 * lane + 256 * j); }
    const int gw = vcu * NWAVES + wave, NGW = G * NWAVES;
    for (int t = gw; t < T; t += NGW) {
        const int s0 = SLOT[2 * t], s1 = SLOT[2 * t + 1];
        f32x4 v[4]; float s = 0.f;
#pragma unroll
        for (int j = 0; j < 4; ++j) {
            const f32x4 x = *(const f32x4*)(X1 + (size_t)t * D + 4 * lane + 256 * j);
            const v2u y0 = *(const v2u*)(YB + (size_t)s0 * D + 4 * lane + 256 * j), y1 = *(const v2u*)(YB + (size_t)s1 * D + 4 * lane + 256 * j);
            v[j][0] = ALPHA * x[0] + bflo(y0.x) + bflo(y1.x); v[j][1] = ALPHA * x[1] + bfhi(y0.x) + bfhi(y1.x);
            v[j][2] = ALPHA * x[2] + bflo(y0.y) + bflo(y1.y); v[j][3] = ALPHA * x[3] + bfhi(y0.y) + bfhi(y1.y);
            s += (v[j][0] + v[j][1]) + (v[j][2] + v[j][3]);
        }
        const float mu = wave_sum(s) * (1.0f / D); float q = 0.f;
#pragma unroll
        for (int j = 0; j < 4; ++j) { v[j] = v[j] - mu; q += (v[j][0] * v[j][0] + v[j][1] * v[j][1]) + (v[j][2] * v[j][2] + v[j][3] * v[j][3]); }
        const float rstd = rsqrtf(wave_sum(q) * (1.0f / D) + LN_EPS);
#pragma unroll
        for (int j = 0; j < 4; ++j) { v[j] = v[j] * rstd * gq[j] + bq[j];
            *(f32x4*)(outp + (size_t)t * D + 4 * lane + 256 * j) = v[j];
            if (write_xb) { v2u w; w.x = pk2(v[j][0], v[j][1]); w.y = pk2(v[j][2], v[j][3]); *(v2u*)(XB + (size_t)t * D + 4 * lane + 256 * j) = w; } }
    }
}

template <class Tp> __device__ __forceinline__ Tp* asg(Tp* p) { GAS Tp* g = (GAS Tp*)p; asm volatile("" : "+s"(g)); return (Tp*)g; }
__device__ __forceinline__ Ptrs load_ptrs(const Ptrs& q) {
    Ptrs P;
    P.x = asg(q.x); P.w_in = asg(q.w_in); P.w_out = asg(q.w_out); P.lg = asg(q.lg); P.lb = asg(q.lb); P.wsp = asg(q.wsp); P.bsp = asg(q.bsp); P.pw = asg(q.pw); P.psc = asg(q.psc);
    P.ln1g = asg(q.ln1g); P.ln1b = asg(q.ln1b); P.rw = asg(q.rw); P.rb = asg(q.rb); P.wg = asg(q.wg); P.wu = asg(q.wu); P.wd = asg(q.wd); P.ln2g = asg(q.ln2g); P.ln2b = asg(q.ln2b);
    P.out = asg(q.out); P.ws = asg(q.ws);
    return P;
}
struct Args { Ptrs p; int ph_lo, ph_hi, li, pad; };
constexpr int N_PHASES = 17;
__global__ void __launch_bounds__(NTHREADS, 2) mk_fwd(Args args_unused) {
    const Args* ka_ = (const Args*)__builtin_amdgcn_kernarg_segment_ptr();
#ifndef USE_KA
#define KA() (&args_unused)
#else
#define KA() ({ const Args* p_ = ka_; asm volatile("" : "+s"(p_)); p_; })
#endif
    extern __shared__ __attribute__((aligned(16))) unsigned char lds_raw[];
    LAS unsigned char* lds = (LAS unsigned char*)lds_raw;
    const int tid0 = threadIdx.x; const int wave0 = __builtin_amdgcn_readfirstlane(tid0 >> 6);
    const int G = gridDim.x; const int bx = blockIdx.x; const int vcu = (G % 8 == 0) ? (bx % 8) * (G / 8) + bx / 8 : bx;
    volatile LAS unsigned* MISC = (volatile LAS unsigned*)(lds + MISC_OFF);
    for (int u = tid0; u < (LDS_BYTES - RING_BYTES) / 4; u += NTHREADS) ((LAS unsigned*)(lds + RING_BYTES))[u] = 0u;
    __syncthreads();
    const int lo = KA()->ph_lo, hi = KA()->ph_hi;
    unsigned* ctl = (unsigned*)(asg(KA()->p.ws) + WS_CTL);
    XcdBarrier bar; bar.bar = ctl + CW_BAR + KA()->li * XCD_BAR_WORDS; bar.x = 0; bar.st = nullptr;
    if (hi - lo > 1) bar = xcd_barrier_post(ctl + CW_BAR + KA()->li * XCD_BAR_WORDS, MISC + 8, tid0);
#define IN(k) (lo <= (k) && (k) < hi)
#define PHASE_IDS() int wave = wave0; asm volatile("" : "+s"(wave)); int lane; asm volatile("v_mbcnt_lo_u32_b32 %0, -1, 0\n\tv_mbcnt_hi_u32_b32 %0, -1, %0" : "=&v"(lane)); const int tid = wave * 64 + lane; (void)tid
#define SEAM(k) do { if (IN(k) && IN((k) + 1)) xcd_barrier(bar, tid); } while (0)
#ifndef PH_MASK
#define PH_MASK 0x1ff
#endif
    if ((PH_MASK & 1) && IN(0)) { PHASE_IDS(); const Ptrs P = load_ptrs(KA()->p); p0_prologue(P, lds, vcu, G, wave, lane, tid); SEAM(0); }
    for (int l = 0; l < 2; ++l) {
        const int pb = 1 + 8 * l;
        if ((PH_MASK & 2) && IN(pb + 0)) {
            PHASE_IDS(); const Ptrs P = load_ptrs(KA()->p);
            pg8::Gemm g{(const bf16*)(P.ws + WS_HB), (const bf16*)(P.ws + WS_WIN) + (size_t)l * NCOL * D, D};
            pg8::StaticOrder so; so.init(T / 256, NCOL / 256, G, bx);
            EpiProj E{P.ws, P.lg + l * 256, P.lb + l * 256};
            pg8::gemm_phase<EpiProj, pg8::StaticOrder>(lds, g, so, E, wave);
            SEAM(pb + 0);
        }
        if ((PH_MASK & 4) && IN(pb + 1)) {
            PHASE_IDS(); const Ptrs P = load_ptrs(KA()->p);
            p2_attention(P.ws, P.ws, lds, vcu, G, wave, lane, tid);
            p2_gmlp(P, l, lds, vcu, G, wave, lane, tid);
            p2_pool(P, l, vcu, G, wave, lane);
            SEAM(pb + 1);
        }
        if ((PH_MASK & 8) && IN(pb + 2)) {
            PHASE_IDS(); const Ptrs P = load_ptrs(KA()->p);
            pg8::Gemm g{(const bf16*)(P.ws + WS_CC), (const bf16*)(P.ws + WS_WOUT) + (size_t)l * D * D, D};
            pg8::StaticOrder so; so.init(T / 256, D / 256, G, bx);
            EpiOut E{l == 0 ? P.x : (const float*)P.out, (float*)(P.ws + WS_X1)};
            pg8::gemm_phase<EpiOut, pg8::StaticOrder>(lds, g, so, E, wave);
            SEAM(pb + 2);
        }
        if ((PH_MASK & 16) && IN(pb + 3)) { PHASE_IDS(); const Ptrs P = load_ptrs(KA()->p); p4_ln_router(P, l, lds, wave, lane, tid); SEAM(pb + 3); }
        if ((PH_MASK & 32) && IN(pb + 4)) { PHASE_IDS(); const Ptrs P = load_ptrs(KA()->p); build_tables(P.ws, l, lds, tid); p5_gather(P, lds, vcu, G, wave, lane); SEAM(pb + 4); }
        if ((PH_MASK & 64) && IN(pb + 5)) {
            PHASE_IDS(); const Ptrs P = load_ptrs(KA()->p);
            const int ntiles = build_tables(P.ws, l, lds, tid);
            pg8::Gemm g{(const bf16*)(P.ws + WS_XG), (const bf16*)(P.ws + WS_WGU) + (size_t)l * NE * 1024 * D, D};
            pg8::GroupOrder go; go.so.init(ntiles, 4, G, bx); go.texp = (const LAS int*)(lds + TAB_OFF) + 32;
            EpiGU E{(bf16*)(P.ws + WS_HB)};
            pg8::gemm_phase<EpiGU, pg8::GroupOrder>(lds, g, go, E, wave);
            SEAM(pb + 5);
        }
        if ((PH_MASK & 128) && IN(pb + 6)) {
            PHASE_IDS(); const Ptrs P = load_ptrs(KA()->p);
            const int ntiles = build_tables(P.ws, l, lds, tid);
            pg8::Gemm g{(const bf16*)(P.ws + WS_HB), (const bf16*)(P.ws + WS_WDN) + (size_t)l * NE * D * FF, FF};
            pg8::GroupOrder go; go.so.init(ntiles, 4, G, bx); go.texp = (const LAS int*)(lds + TAB_OFF) + 32;
            EpiDown E{(bf16*)(P.ws + WS_XG), (const float*)(P.ws + WS_GSORT)};
            pg8::gemm_phase<EpiDown, pg8::GroupOrder>(lds, g, go, E, wave);
            SEAM(pb + 6);
        }
        if ((PH_MASK & 256) && IN(pb + 7)) { PHASE_IDS(); const Ptrs P = load_ptrs(KA()->p); p8_ln2(P, l, P.out, l == 0, vcu, G, wave, lane); SEAM(pb + 7); }
    }
#undef IN
#undef SEAM
}
}
#ifndef MK_CUT
#define MK_CUT 17
#endif
#if MK_CUT < 17
namespace glue {
using namespace mk;
__global__ void g1(const unsigned char* ws, int b, float* proj) {
    const int pos = blockIdx.x; const size_t row = (size_t)b * S + pos;
    for (int col = threadIdx.x; col < NCOL; col += blockDim.x) {
        float v;
        if (col < 1024) { const int c = col & 511, head = c >> 6, d = c & 63; const int t = d < 16 ? (d < 8 ? 2 * d : 2 * (d - 8) + 1) : d;
            const bf16* src = (const bf16*)(ws + (col < 512 ? WS_Q : WS_K)); v = bflo(src[row * 512 + head * 64 + t]); if (col < 512) v *= 8.0f; }
        else if (col < 1536) v = bflo(((const bf16*)(ws + WS_V))[row * 512 + col - 1024]);
        else if (col < 1792) v = bflo(((const bf16*)(ws + WS_U))[row * 256 + col - 1536]);
        else if (col < 2048) v = bflo(((const bf16*)(ws + WS_G))[row * 256 + col - 1792]);
        else v = bflo(((const bf16*)(ws + WS_Z))[row * 256 + col - 2048]);
        proj[(size_t)pos * NCOL + col] = v;
    }
}
__global__ void g2(const unsigned char* ws, int b, float* cc) {
    const int pos = blockIdx.x; const size_t row = (size_t)b * S + pos;
    for (int col = threadIdx.x; col < D; col += blockDim.x) cc[(size_t)pos * D + col] = bflo(((const bf16*)(ws + WS_CC))[row * D + col]);
}
__global__ void g8(const unsigned char* ws, int b, float* moe) {
    const int pos = blockIdx.x; const size_t row = (size_t)b * S + pos;
    const int* SLOT = (const int*)(ws + WS_SLOT); const bf16* YB = (const bf16*)(ws + WS_XG);
    const int s0 = SLOT[2 * row], s1 = SLOT[2 * row + 1];
    for (int col = threadIdx.x; col < D; col += blockDim.x) moe[(size_t)pos * D + col] = bflo(YB[(size_t)s0 * D + col]) + bflo(YB[(size_t)s1 * D + col]);
}
}
#endif

static void mk_launch_range(const mk::Ptrs& p, int grid, int lo, int hi, int li, hipStream_t stream) {
    mk::Args a{};
    a.p = p; a.ph_lo = lo; a.ph_hi = hi; a.li = li; a.pad = 0;
    hipLaunchKernelGGL(mk::mk_fwd, dim3(grid), dim3(mk::NTHREADS), mk::LDS_BYTES, stream, a);
}

extern "C" void kernel_launch(void* const* d_in, const int* in_sizes, int n_in, void* d_out, int out_size, void* d_ws, size_t ws_size, hipStream_t stream) {
    using namespace mk;
    static int grid = 0;
    if (grid == 0) {
        if (n_in != 18 || ws_size < WS_END) { fprintf(stderr, "kernel_launch: unexpected n_in %d / ws_size %zu\n", n_in, ws_size); grid = -1; return; }
        int dev = 0, cus = 0;
        if (hipGetDevice(&dev) != hipSuccess || hipDeviceGetAttribute(&cus, hipDeviceAttributeMultiprocessorCount, dev) != hipSuccess) { grid = -1; return; }
        if (hipFuncSetAttribute((const void*)mk_fwd, hipFuncAttributeMaxDynamicSharedMemorySize, LDS_BYTES) != hipSuccess) { fprintf(stderr, "kernel_launch: hipFuncSetAttribute failed\n"); grid = -1; return; }
        grid = cus;
    }
    if (grid < 0) return;
    (void)hipMemsetAsync((char*)d_ws + WS_CTL, 0, CTL_ZERO_BYTES, stream);
    Ptrs p{};
    const float* const* in = (const float* const*)d_in;
    p.x = in[0]; p.w_in = in[1]; p.w_out = in[2]; p.lg = in[3]; p.lb = in[4]; p.wsp = in[5]; p.bsp = in[6]; p.pw = in[7]; p.psc = in[8];
    p.ln1g = in[9]; p.ln1b = in[10]; p.rw = in[11]; p.rb = in[12]; p.wg = in[13]; p.wu = in[14]; p.wd = in[15]; p.ln2g = in[16]; p.ln2b = in[17];
    p.out = (float*)d_out; p.ws = (unsigned char*)d_ws;
#if MK_CUT >= 17
    mk_launch_range(p, grid, 0, N_PHASES, 0, stream);
#else
    mk_launch_range(p, grid, 0, MK_CUT, 0, stream);
    nv::In I = nv::make_in(d_in);
    const unsigned char* ws = (const unsigned char*)d_ws;
    float* scr_base = (float*)((char*)d_ws + 509 * MiB) - nv::SCR_FLOATS - (size_t)T * D;
    (void)scr_base;
    float* nscr = (float*)((char*)d_ws + (MK_CUT <= 2 ? (size_t)357 * MiB : (size_t)261 * MiB));
    nv::Scr s = nv::carve(nscr);
    float* xcur = (float*)d_out;
    for (int b = 0; b < NB; ++b) {
        const float* xin = I.x + (size_t)b * S * D; float* xout = xcur + (size_t)b * S * D; const int l = 0;
#if MK_CUT == 2
        glue::g1<<<S, 256, 0, stream>>>(ws, b, s.proj);
#endif
#if MK_CUT <= 2
        nv::attn<<<dim3(S, 8), 64, 0, stream>>>(s.proj, s.cc);
        nv::gmlp_mix<<<S, 256, 0, stream>>>(s.proj, I.wsp + (size_t)l * 4 * 128 * 128, I.bsp + l * 4 * 128, s.cc);
        nv::pool1<<<S, 256, 0, stream>>>(s.proj, s.pooled);
        nv::pool2<<<S, 256, 0, stream>>>(s.pooled, I.pw + (size_t)l * 4 * 64 * 64, I.psc + l * 256, s.cc);
#endif
#if MK_CUT == 3
        glue::g2<<<S, 256, 0, stream>>>(ws, b, s.cc);
#endif
#if MK_CUT <= 3
        nv::gemm<<<dim3(D / 64, S / 64), 256, 0, stream>>>(s.cc, I.w_out + (size_t)l * D * D, s.h, S, D, D);
        nv::ln_res<<<S, 64, 0, stream>>>(xin, s.h, I.ln1g + l * D, I.ln1b + l * D, s.x1);
#endif
#if MK_CUT == 4
        nv::ln_res<<<S, 64, 0, stream>>>(nullptr, (const float*)(ws + WS_X1) + (size_t)b * S * D, I.ln1g + l * D, I.ln1b + l * D, s.x1);
#endif
#if MK_CUT <= 4
        nv::route<<<S, 64, 0, stream>>>(s.x1, I.rw, I.rb, s.eo, s.go);
        const float* x1p = s.x1; const int* eop = s.eo; const float* gop = s.go;
#else
        const float* x1p = (const float*)(ws + WS_X1) + (size_t)b * S * D; const int* eop = (const int*)(ws + WS_TOKE) + (size_t)b * S * 2; const float* gop = (const float*)(ws + WS_TOKG) + (size_t)b * S * 2;
#endif
#if MK_CUT <= 5
        nv::moe<<<S, 256, 0, stream>>>(x1p, eop, gop, I.wg + (size_t)l * NE * D * FF, I.wu + (size_t)l * NE * D * FF, I.wd + (size_t)l * NE * FF * D, s.moe);
#endif
#if MK_CUT == 8
        glue::g8<<<S, 256, 0, stream>>>(ws, b, s.moe);
#endif
#if MK_CUT <= 8
        nv::ln_res<<<S, 64, 0, stream>>>(x1p, s.moe, I.ln2g + l * D, I.ln2b + l * D, xout);
#endif
    }
    for (int b = 0; b < NB; ++b) { float* xb = xcur + (size_t)b * S * D; nv::layer(I, 1, xb, xb, s, stream); }
#endif
}
```

```cpp
#define MK_CUT 15
#include <hip/hip_runtime.h>
#include <cstdio>
namespace pg8 {
#define PG8_LAS __attribute__((address_space(3)))
typedef unsigned short bf16_t;
typedef short bf16x8 __attribute__((ext_vector_type(8)));
typedef float f32x4 __attribute__((ext_vector_type(4)));
typedef unsigned u32x4 __attribute__((ext_vector_type(4)));
constexpr int BM = 256, BK = 64, HALF = 128, HTB = HALF * BK * 2  , STAGE_BYTES = 8 * HTB, NXCD = 8, WGM = 8;

__host__ __device__ __forceinline__ int lds_byte(int r, int c) { const int st = (r >> 4) * 2 + (c >> 5), rr = r & 15, cc = c & 31, ob = rr * 64 + cc * 2; return st * 1024 + (ob ^ (((ob >> 9) & 1) << 5)); }
__host__ __device__ __forceinline__ void stage_rc(int b, int& R, int& C) { const int st = b / 1024, sb = b % 1024, swz = sb ^ (((sb >> 9) & 1) << 5); R = (st >> 1) * 16 + swz / 64; C = (st & 1) * 32 + (swz % 64) / 2; }
__host__ __device__ __forceinline__ int perm32(int rho) { const int n = rho >> 4, i = rho & 15; return 8 * (i >> 2) + 4 * n + (i & 3); }

struct Unit { int pm, pn, pb, e, l0; };
struct Gemm { const bf16_t* A; const bf16_t* Bt; int K; };

struct StaticOrder {
    int nM, nN, nwg, G, c;
    __device__ void init(int nM_, int nN_, int G_, int c_) { nM = nM_; nN = nN_; nwg = nM * nN; G = G_; c = c_; }
    __device__ bool next(int i, Unit& u) const {
        const long L = (long)i * G + c; if (L >= nwg) return false;
        int wgid = (int)L; { const int q = nwg / NXCD, r = nwg % NXCD, xcd = wgid % NXCD, off = wgid / NXCD; wgid = (xcd < r ? xcd * (q + 1) : r * (q + 1) + (xcd - r) * q) + off; }
        const int nig = WGM * nN, gid = wgid / nig, fm = gid * WGM, gsz = (nM - fm) < WGM ? (nM - fm) : WGM;
        u.pm = fm + ((wgid % nig) % gsz); u.pn = (wgid % nig) / gsz; u.pb = u.pn; u.e = 0; u.l0 = 0; return true;
    }
};
struct GroupOrder {
    StaticOrder so; const PG8_LAS int* s_base; const int* tlist;
    __device__ bool next(int i, Unit& u) const { if (!so.next(i, u)) return false; const int e = s_base[64 + u.pm]; u.e = e; u.l0 = u.pm * 256 - s_base[e]; u.pb = e * so.nN + u.pn; return true; }
    __device__ __forceinline__ int row_token(const Unit& u, int r) const { const int nval = s_base[32 + u.e] - u.l0; return r < nval ? tlist[(size_t)u.e * 32768 + u.l0 + r] : 0; }
};

template <class Epi, class Sched, bool ALIGN_EPI = true, bool GATHER = false>
__device__ __forceinline__ void gemm_phase(PG8_LAS unsigned char* lds, const Gemm g, const Sched& S, const Epi& E, const int wave_id) {
    int lane; asm volatile("v_mbcnt_lo_u32_b32 %0, -1, 0\n\tv_mbcnt_hi_u32_b32 %0, -1, %0" : "=&v"(lane));
    const int wid = wave_id, tid = wid * 64 + lane, wr = wid >> 2, wc = wid & 3, fr = lane & 15, fq = lane >> 4;
    const int K = g.K, nt = K / BK;
    unsigned voffA[2], voffB[2];
#pragma unroll
    for (int i = 0; i < 2; ++i) { int R, C; stage_rc(tid * 16 + i * 8192, R, C); const int Rb = Epi::PERM ? ((R & ~31) + perm32(R & 31)) : R;
        voffA[i] = (unsigned)(R * K + C) * 2u; voffB[i] = (unsigned)(Rb * K + C) * 2u; }
    const size_t kstep = (size_t)(BK * 2);
    const size_t hstep = (size_t)HALF * K * 2;
    const size_t tstep = 2 * hstep;
    const unsigned ldsw = (unsigned)wid * 1024u;
    const int aoff = lds_byte(wr * 64 + fr, fq * 8), boff = lds_byte(wc * 32 + fr, fq * 8);
#define PG8_SA(b, h) (((b) * 2 + (h)) * HTB)
#define PG8_SB(b, h) ((4 + (b) * 2 + (h)) * HTB)
#define PG8_STAGE(bufoff, gbase, voff) do { _Pragma("unroll") for (int _i = 0; _i < 2; ++_i) \
        __builtin_amdgcn_global_load_lds((const unsigned*)((const char*)(gbase) + (voff)[_i]), (PG8_LAS unsigned*)(lds + (bufoff) + ldsw + _i * 8192), 16, 0, 0); } while (0)
#define PG8_STAGE_A(bufoff, gbase, half, usenext) do { if constexpr (GATHER) { _Pragma("unroll") for (int _i = 0; _i < 2; ++_i) \
        __builtin_amdgcn_global_load_lds((const unsigned*)((const char*)(gbase) + ((usenext) ? gn[half][_i] : ga[half][_i])), (PG8_LAS unsigned*)(lds + (bufoff) + ldsw + _i * 8192), 16, 0, 0); } \
        else { PG8_STAGE(bufoff, (gbase) + (half) * hstep, voffA); } } while (0)
#define PG8_LDA(dst, b, h) do { _Pragma("unroll") for (int m = 0; m < 4; ++m) _Pragma("unroll") for (int k = 0; k < 2; ++k) dst[m][k] = *(const PG8_LAS bf16x8*)(lds + PG8_SA(b, h) + aoff + m * 2048 + k * 1024); } while (0)
#define PG8_LDB(dst, b, h) do { _Pragma("unroll") for (int n = 0; n < 2; ++n) _Pragma("unroll") for (int k = 0; k < 2; ++k) dst[n][k] = *(const PG8_LAS bf16x8*)(lds + PG8_SB(b, h) + boff + n * 2048 + k * 1024); } while (0)
#define PG8_MMA(ai, bj, At, Bt) do { __builtin_amdgcn_s_setprio(1); _Pragma("unroll") for (int m = 0; m < 4; ++m) _Pragma("unroll") for (int n = 0; n < 2; ++n) _Pragma("unroll") for (int k = 0; k < 2; ++k) \
        acc[ai][bj][m][n] = __builtin_amdgcn_mfma_f32_16x16x32_bf16(Bt[n][k], At[m][k], acc[ai][bj][m][n], 0, 0, 0); __builtin_amdgcn_s_setprio(0); } while (0)
#define PG8_WAIT_V(n) asm volatile("s_waitcnt vmcnt(" #n ")" ::: "memory")
#define PG8_WAIT_L(n) asm volatile("s_waitcnt lgkmcnt(" #n ")" ::: "memory")
#define PG8_BAR __builtin_amdgcn_s_barrier()
#define PG8_SCHED __builtin_amdgcn_sched_barrier(0)
    Unit cur, nxt; int ui = 0;
    if (!S.next(0, cur)) return;
    f32x4 acc[2][2][4][2];
#pragma unroll
    for (int a = 0; a < 2; ++a)
#pragma unroll
        for (int b = 0; b < 2; ++b)
#pragma unroll
            for (int m = 0; m < 4; ++m)
#pragma unroll
                for (int n = 0; n < 2; ++n) acc[a][b][m][n] = (f32x4){0.f, 0.f, 0.f, 0.f};
    bf16x8 At[4][2], B0[2][2], B1[2][2];
    const char* cA = (const char*)g.A + (GATHER ? (size_t)0 : (size_t)cur.pm * tstep); const char* cB = (const char*)g.Bt + (size_t)cur.pb * tstep;
    unsigned ga[2][2], gn[2][2];
    if constexpr (GATHER) {
#pragma unroll
        for (int h = 0; h < 2; ++h)
#pragma unroll
            for (int i = 0; i < 2; ++i) { int R, C; stage_rc(tid * 16 + i * 8192, R, C); ga[h][i] = (unsigned)S.row_token(cur, 128 * h + R) * (unsigned)(K * 2) + (unsigned)(C * 2); gn[h][i] = ga[h][i]; }
    }
    PG8_STAGE(PG8_SB(0, 0), cB, voffB); PG8_STAGE(PG8_SB(0, 1), cB + hstep, voffB); PG8_STAGE_A(PG8_SA(0, 0), cA, 0, false); PG8_STAGE_A(PG8_SA(0, 1), cA, 1, false);
    if (wr == 1) PG8_BAR;
    PG8_WAIT_V(2); PG8_BAR;
    PG8_STAGE(PG8_SB(1, 0), cB + kstep, voffB); PG8_STAGE_A(PG8_SA(1, 0), cA + kstep, 0, false); PG8_STAGE(PG8_SB(1, 1), cB + hstep + kstep, voffB);
    PG8_WAIT_V(6); PG8_BAR;
    for (;;) {
        const bool has_next = S.next(ui + 1, nxt);
        if constexpr (GATHER) {
            if (has_next) {
#pragma unroll
                for (int h = 0; h < 2; ++h)
#pragma unroll
                    for (int i = 0; i < 2; ++i) { int R, C; stage_rc(tid * 16 + i * 8192, R, C); gn[h][i] = (unsigned)S.row_token(nxt, 128 * h + R) * (unsigned)(K * 2) + (unsigned)(C * 2); }
            }
        }
        const char* nA = (has_next && !GATHER) ? (const char*)g.A + (size_t)nxt.pm * tstep : cA; const char* nB = has_next ? (const char*)g.Bt + (size_t)nxt.pb * tstep : cB;
        for (int t = 0; t < nt; t += 2) {
            const bool last = (t == nt - 2);
            const char* a1 = cA + (size_t)(t + 1) * kstep;
            const char* a2 = last ? nA : cA + (size_t)(t + 2) * kstep; const char* b2 = last ? nB : cB + (size_t)(t + 2) * kstep;
            const char* a3 = a2 + kstep; const char* b3 = b2 + kstep;
            PG8_LDB(B0, 0, 0); PG8_LDB(B1, 0, 1); PG8_SCHED; PG8_LDA(At, 0, 0); PG8_STAGE_A(PG8_SA(1, 1), a1, 1, false);
            PG8_WAIT_V(8); PG8_WAIT_L(0); PG8_BAR; PG8_MMA(0, 0, At, B0); PG8_MMA(0, 1, At, B1); PG8_BAR; PG8_SCHED;
            PG8_LDA(At, 0, 1); PG8_STAGE(PG8_SB(0, 0), b2, voffB); PG8_STAGE(PG8_SB(0, 1), b2 + hstep, voffB); PG8_STAGE_A(PG8_SA(0, 0), a2, 0, last);
            PG8_WAIT_V(8); PG8_WAIT_L(0); PG8_BAR; PG8_MMA(1, 0, At, B0); PG8_MMA(1, 1, At, B1); PG8_BAR; PG8_SCHED;
            PG8_LDB(B0, 1, 0); PG8_LDB(B1, 1, 1); PG8_SCHED; PG8_LDA(At, 1, 0); PG8_STAGE_A(PG8_SA(0, 1), a2, 1, last);
            PG8_WAIT_V(8); PG8_WAIT_L(0); PG8_BAR; PG8_MMA(0, 0, At, B0); PG8_MMA(0, 1, At, B1); PG8_BAR; PG8_SCHED;
            PG8_LDA(At, 1, 1); PG8_STAGE(PG8_SB(1, 0), b3, voffB); PG8_STAGE(PG8_SB(1, 1), b3 + hstep, voffB); PG8_STAGE_A(PG8_SA(1, 0), a3, 0, last);
            PG8_WAIT_V(8); PG8_WAIT_L(0); PG8_BAR; PG8_MMA(1, 0, At, B0); PG8_MMA(1, 1, At, B1); PG8_BAR; PG8_SCHED;
        }
        if constexpr (ALIGN_EPI) { if (wr == 0) PG8_BAR; }
        { int ln_; asm volatile("v_mbcnt_lo_u32_b32 %0, -1, 0\n\tv_mbcnt_hi_u32_b32 %0, -1, %0" : "=&v"(ln_)); E(acc, cur, wr, wc, ln_ & 15, ln_ >> 4); }
        if (!has_next) break;
#pragma unroll
        for (int a = 0; a < 2; ++a)
#pragma unroll
            for (int b = 0; b < 2; ++b)
#pragma unroll
                for (int m = 0; m < 4; ++m)
#pragma unroll
                    for (int n = 0; n < 2; ++n) acc[a][b][m][n] = (f32x4){0.f, 0.f, 0.f, 0.f};
        cur = nxt; cA = nA; cB = nB; ++ui;
        if constexpr (GATHER) {
#pragma unroll
            for (int h = 0; h < 2; ++h)
#pragma unroll
                for (int i = 0; i < 2; ++i) ga[h][i] = gn[h][i];
        }
        if constexpr (ALIGN_EPI) { if (wr == 1) PG8_BAR; }
    }
    PG8_WAIT_V(0);
    if constexpr (!ALIGN_EPI) { if (wr == 0) PG8_BAR; }
    PG8_BAR;
#undef PG8_SA
#undef PG8_SB
#undef PG8_STAGE
#undef PG8_STAGE_A
#undef PG8_LDA
#undef PG8_LDB
#undef PG8_MMA
#undef PG8_WAIT_V
#undef PG8_WAIT_L
#undef PG8_BAR
#undef PG8_SCHED
}
}
namespace mk {
constexpr int NB = 16, S = 2048, T = NB * S, D = 1024, NCOL = 2304, NE = 16, FF = 512;
constexpr float ALPHA = 1.4142135623730951f, LN_EPS = 1e-5f, LOG2E = 1.4426950408889634f;
constexpr int NWAVES = 8, NTHREADS = 512;
constexpr int MAXROWS = 69632;
constexpr int MAXTILES = 272;

constexpr size_t MiB = 1u << 20;
constexpr size_t WS_CTL = 0, CTL_ZERO_BYTES = 1 * MiB;
constexpr size_t WS_ROPE = 1 * MiB;
constexpr size_t WS_TOKE = WS_ROPE + 256 * 1024;
constexpr size_t WS_TOKG = WS_TOKE + 256 * 1024;
constexpr size_t WS_TOKP = WS_TOKG + 256 * 1024;
constexpr size_t WS_STATS = 2 * MiB;
constexpr size_t WS_LSE = 3 * MiB;
constexpr size_t WS_WPT = 6 * MiB;
constexpr size_t WS_WST = 6 * MiB + 64 * 1024;
constexpr size_t WS_RWQ = 6 * MiB + 512 * 1024;
constexpr size_t WS_CR = 6 * MiB + 768 * 1024;
constexpr size_t WS_C1P = 7 * MiB;
constexpr size_t WS_C2P = 7 * MiB + 256 * 1024;
constexpr size_t WS_WIN = 8 * MiB, WS_WOUT = 17 * MiB, WS_WGU = 21 * MiB, WS_WDN = 85 * MiB;
constexpr size_t WS_Y1B = 117 * MiB;
constexpr size_t WS_TLIST = 181 * MiB;
constexpr size_t WS_GLIST = 183 * MiB;
constexpr size_t WS_YB = 245 * MiB;
constexpr size_t WS_HB = 381 * MiB;
constexpr size_t WS_Q = 117 * MiB, WS_K = 149 * MiB, WS_V = 181 * MiB, WS_U = 213 * MiB, WS_G = 229 * MiB, WS_Z = 245 * MiB;
constexpr size_t WS_PO = 261 * MiB;
constexpr size_t WS_CC = 445 * MiB;
constexpr size_t WS_END = 509 * MiB;
constexpr int CW_CNT = 64;
constexpr int CW_BAR = 4096;

constexpr int RING_BYTES = 131072;
constexpr int MISC_OFF = RING_BYTES + 320;
constexpr int TAB_OFF = RING_BYTES + 1024;
constexpr int LDS_BYTES = 147456;

#define GAS __attribute__((address_space(1)))
#define LAS __attribute__((address_space(3)))
typedef unsigned short bf16;
typedef unsigned v4u __attribute__((ext_vector_type(4)));
typedef unsigned v2u __attribute__((ext_vector_type(2)));
typedef float f32x4 __attribute__((ext_vector_type(4)));
typedef float f32x2 __attribute__((ext_vector_type(2)));
typedef float f32x16 __attribute__((ext_vector_type(16)));
typedef short bf16x8 __attribute__((ext_vector_type(8)));
typedef short s16x4 __attribute__((ext_vector_type(4)));
typedef __bf16 bf16x2_t __attribute__((ext_vector_type(2)));
typedef GAS unsigned gu32;
#define RLX_AGENT __ATOMIC_RELAXED, __HIP_MEMORY_SCOPE_AGENT
#define LDS_WAIT() asm volatile("s_waitcnt lgkmcnt(0)" ::: "memory")

__device__ __forceinline__ unsigned pk2(float lo, float hi) { f32x2 v = {lo, hi}; bf16x2_t r = __builtin_convertvector(v, bf16x2_t); return __builtin_bit_cast(unsigned, r); }
__device__ __forceinline__ float bflo(unsigned u) { return __builtin_bit_cast(float, u << 16); }
__device__ __forceinline__ float bfhi(unsigned u) { return __builtin_bit_cast(float, u & 0xffff0000u); }
__device__ __forceinline__ float wave_sum(float v) {
#pragma unroll
    for (int o = 1; o < 64; o <<= 1) v += __shfl_xor(v, o);
    return v;
}
__device__ __forceinline__ float fast_exp2(float x) { return __builtin_amdgcn_exp2f(x); }
__device__ __forceinline__ float fast_rcp(float x) { return __builtin_amdgcn_rcpf(x); }
__device__ __forceinline__ float gelu_t(float x) {
    const float y = x * (1.5957691216057308f + 0.07135481627159498f * x * x);
    return x * fast_rcp(1.0f + fast_exp2(-LOG2E * y));
}
__device__ __forceinline__ float silu_f(float x) { return x * fast_rcp(1.0f + fast_exp2(-LOG2E * x)); }
__device__ __forceinline__ int crow(int reg, int h) { return (reg & 3) + 8 * (reg >> 2) + 4 * h; }

#define XB_TMO      128
#define XB_XCNT(j)  (256  + 64 * (j))
#define XB_XSUB(j)  (1280 + 64 * (j))
#define XB_XGEN(j)  (2304 + 64 * (j))
#define XB_TOP      3328
#define XB_TOPGEN   3392
#define XCD_BAR_WORDS 3456
#define XB_SPIN_CAP (1u << 22)
__device__ __forceinline__ unsigned xb_ld(unsigned* p)              { return __hip_atomic_load(p, __ATOMIC_RELAXED, __HIP_MEMORY_SCOPE_AGENT); }
__device__ __forceinline__ unsigned xb_add(unsigned* p, unsigned v) { return __hip_atomic_fetch_add(p, v, __ATOMIC_RELAXED, __HIP_MEMORY_SCOPE_AGENT); }
__device__ __forceinline__ unsigned xb_xcc_id() { return (unsigned)__builtin_amdgcn_s_getreg((3 << 11) | 20) & 0xFu; }
#define XB_SPIN(cond, bar) do { unsigned _sp = 0; while (cond) { __builtin_amdgcn_s_sleep(1); \
    if ((++_sp & 255u) == 0u) { if (xb_ld(&(bar)[XB_TMO])) break; if (_sp > XB_SPIN_CAP) { atomicAdd(&(bar)[XB_TMO], 1u); break; } } } } while (0)
struct XcdBarrier { unsigned* bar; unsigned x; volatile LAS unsigned* st; };
__device__ __forceinline__ XcdBarrier xcd_barrier_post(unsigned* bar, volatile LAS unsigned* st, int tid) {
    XcdBarrier b; b.bar = bar; b.x = xb_xcc_id(); b.st = st;
    if (tid == 0) (void)xb_add(&bar[XB_XCNT(b.x)], 1u);
    return b;
}
__device__ __forceinline__ void xcd_barrier_complete(unsigned* bar, unsigned x, unsigned& nloc, unsigned& nx) {
    const unsigned G = gridDim.x * gridDim.y * gridDim.z;
    unsigned sum, cnt, mine, sp = 0u;
    for (;;) {
        sum = 0u; cnt = 0u; mine = 0u;
#pragma unroll
        for (unsigned j = 0; j < 16; ++j) { const unsigned c = xb_ld(&bar[XB_XCNT(j)]); sum += c; cnt += (c > 0u) ? 1u : 0u; mine = (j == x) ? c : mine; }
        if (sum == G) break;
        __builtin_amdgcn_s_sleep(1);
        if ((++sp & 255u) == 0u) { if (xb_ld(&bar[XB_TMO])) break; if (sp > XB_SPIN_CAP) { atomicAdd(&bar[XB_TMO], 1u); break; } }
    }
    nloc = mine > 0u ? mine : 1u; nx = cnt > 0u ? cnt : 1u;
}
__device__ __forceinline__ void xcd_barrier(const XcdBarrier& b, int tid) {
    asm volatile("s_waitcnt vmcnt(0)" ::: "memory");
    __syncthreads();
    if (tid == 0) {
        unsigned* bar = b.bar;
        __builtin_amdgcn_s_waitcnt(0);
        unsigned nloc = b.st[0], nx = b.st[1];
        if (nloc == 0u) { xcd_barrier_complete(bar, b.x, nloc, nx); b.st[0] = nloc; b.st[1] = nx; }
        const unsigned old = xb_add(&bar[XB_XSUB(b.x)], 1u);
        const unsigned gen = old / nloc;
        if (old + 1u == (gen + 1u) * nloc) {
            __builtin_amdgcn_fence(__ATOMIC_RELEASE, "agent");
            asm volatile("s_waitcnt vmcnt(0)" ::: "memory");
            const unsigned og = xb_add(&bar[XB_TOP], 1u);
            const unsigned tg = og / nx;
            if (og + 1u == (tg + 1u) * nx) xb_add(&bar[XB_TOPGEN], 1u);
            else XB_SPIN(xb_ld(&bar[XB_TOPGEN]) == tg, bar);
            __builtin_amdgcn_fence(__ATOMIC_ACQUIRE, "agent");
            xb_add(&bar[XB_XGEN(b.x)], 1u);
            asm volatile("s_waitcnt vmcnt(0)" ::: "memory");
        } else {
            XB_SPIN(xb_ld(&bar[XB_XGEN(b.x)]) == gen, bar);
            __builtin_amdgcn_fence(__ATOMIC_ACQUIRE, "agent");
            asm volatile("s_waitcnt vmcnt(0)" ::: "memory");
        }
    }
    __syncthreads();
}

#ifdef NO_FENCE
#define EPI_FENCE() do {} while (0)
#else
#define EPI_FENCE() asm volatile("" ::: "memory")
#endif
using pg8::Unit;
struct EpiProj {
    static constexpr bool PERM = true;
    unsigned char* ws; const float *lg, *lb;
    __device__ __forceinline__ void operator()(const f32x4 (&acc)[2][2][4][2], const Unit& u, int wr, int wc, int fr, int fq) const {
        const int pn = u.pn;
#pragma unroll
        for (int ai = 0; ai < 2; ++ai)
#pragma unroll
            for (int m = 0; m < 4; ++m) {
                const int row = u.pm * 256 + ai * 128 + wr * 64 + m * 16 + fr;
                f32x4 v[2][2];
#pragma unroll
                for (int bj = 0; bj < 2; ++bj)
#pragma unroll
                    for (int n = 0; n < 2; ++n) v[bj][n] = acc[ai][bj][m][n];
                bf16* dst; int cstep = 128;
                if (pn < 4) {
                    if (((wc & 1) == 0) && fq < 2) {
                        const int pos = row & (S - 1);
                        const float* rope = (const float*)(ws + WS_ROPE);
                        const f32x4 cs0 = *(const f32x4*)(rope + (size_t)(pos * 8 + 4 * fq) * 2);
                        const f32x4 cs1 = *(const f32x4*)(rope + (size_t)(pos * 8 + 4 * fq) * 2 + 4);
#pragma unroll
                        for (int bj = 0; bj < 2; ++bj) {
                            float a, b;
                            a = v[bj][0][0]; b = v[bj][0][1]; v[bj][0][0] = a * cs0[0] - b * cs0[1]; v[bj][0][1] = b * cs0[0] + a * cs0[1];
                            a = v[bj][0][2]; b = v[bj][0][3]; v[bj][0][2] = a * cs0[2] - b * cs0[3]; v[bj][0][3] = b * cs0[2] + a * cs0[3];
                            a = v[bj][1][0]; b = v[bj][1][1]; v[bj][1][0] = a * cs1[0] - b * cs1[1]; v[bj][1][1] = b * cs1[0] + a * cs1[1];
                            a = v[bj][1][2]; b = v[bj][1][3]; v[bj][1][2] = a * cs1[2] - b * cs1[3]; v[bj][1][3] = b * cs1[2] + a * cs1[3];
                        }
                    }
                    if (pn < 2) {
#pragma unroll
                        for (int bj = 0; bj < 2; ++bj)
#pragma unroll
                            for (int n = 0; n < 2; ++n) v[bj][n] = v[bj][n] * 0.125f;
                    }
                    dst = (bf16*)(ws + (pn < 2 ? WS_Q : WS_K)) + (size_t)row * 512 + (pn & 1) * 256 + wc * 32 + 8 * fq;
                } else if (pn < 6) {
                    dst = (bf16*)(ws + WS_V) + (size_t)row * 512 + (pn - 4) * 256 + wc * 32 + 8 * fq;
                } else if (pn == 6) {
#pragma unroll
                    for (int bj = 0; bj < 2; ++bj)
#pragma unroll
                        for (int n = 0; n < 2; ++n)
#pragma unroll
                            for (int e = 0; e < 4; ++e) v[bj][n][e] = gelu_t(v[bj][n][e]);
                    dst = (bf16*)(ws + WS_U) + (size_t)row * 256 + wc * 32 + 8 * fq;
                } else if (pn == 7) {
                    float s = 0.f;
#pragma unroll
                    for (int bj = 0; bj < 2; ++bj)
#pragma unroll
                        for (int n = 0; n < 2; ++n)
#pragma unroll
                            for (int e = 0; e < 4; ++e) { v[bj][n][e] = gelu_t(v[bj][n][e]); s += v[bj][n][e]; }
                    s += __shfl_xor(s, 16); s += __shfl_xor(s, 32);
                    const float mu = s * (1.0f / 64.0f); float q = 0.f;
#pragma unroll
                    for (int bj = 0; bj < 2; ++bj)
#pragma unroll
                        for (int n = 0; n < 2; ++n)
#pragma unroll
                            for (int e = 0; e < 4; ++e) { v[bj][n][e] -= mu; q += v[bj][n][e] * v[bj][n][e]; }
                    q += __shfl_xor(q, 16); q += __shfl_xor(q, 32);
                    const float rstd = rsqrtf(q * (1.0f / 64.0f) + LN_EPS);
#pragma unroll
                    for (int bj = 0; bj < 2; ++bj)
#pragma unroll
                        for (int n = 0; n < 2; ++n) {
                            const int dim = wc * 64 + 32 * bj + 8 * fq + 4 * n;
                            const f32x4 gg = *(const f32x4*)(lg + dim), bb = *(const f32x4*)(lb + dim);
                            v[bj][n] = v[bj][n] * rstd * gg + bb;
                        }
                    dst = (bf16*)(ws + WS_G) + (size_t)row * 256 + wc * 64 + 8 * fq; cstep = 32;
                } else {
                    dst = (bf16*)(ws + WS_Z) + (size_t)row * 256 + wc * 32 + 8 * fq;
                }
#pragma unroll
                for (int bj = 0; bj < 2; ++bj) {
                    v4u w; w.x = pk2(v[bj][0][0], v[bj][0][1]); w.y = pk2(v[bj][0][2], v[bj][0][3]); w.z = pk2(v[bj][1][0], v[bj][1][1]); w.w = pk2(v[bj][1][2], v[bj][1][3]);
                    *(v4u*)(dst + bj * cstep) = w;
                }
                EPI_FENCE();
            }
    }
};
struct EpiOutB {
    static constexpr bool PERM = true;
    const bf16* xres; bf16* Y;
    __device__ __forceinline__ void operator()(const f32x4 (&acc)[2][2][4][2], const Unit& u, int wr, int wc, int fr, int fq) const {
        const int col0 = u.pn * 256 + wc * 32 + 8 * fq;
#pragma unroll
        for (int ai = 0; ai < 2; ++ai)
#pragma unroll
            for (int m = 0; m < 4; ++m) {
                const size_t off = (size_t)(u.pm * 256 + ai * 128 + wr * 64 + m * 16 + fr) * D + col0;
#pragma unroll
                for (int bj = 0; bj < 2; ++bj) {
                    const v4u xr = *(const v4u*)(xres + off + bj * 128);
                    const f32x4 a = acc[ai][bj][m][0], b = acc[ai][bj][m][1];
                    v4u w; w.x = pk2(a[0] + ALPHA * bflo(xr.x), a[1] + ALPHA * bfhi(xr.x)); w.y = pk2(a[2] + ALPHA * bflo(xr.y), a[3] + ALPHA * bfhi(xr.y));
                    w.z = pk2(b[0] + ALPHA * bflo(xr.z), b[1] + ALPHA * bfhi(xr.z)); w.w = pk2(b[2] + ALPHA * bflo(xr.w), b[3] + ALPHA * bfhi(xr.w));
                    *(v4u*)(Y + off + bj * 128) = w;
                }
                EPI_FENCE();
            }
    }
};
struct EpiGU {
    static constexpr bool PERM = true;
    bf16* H; const int* tlist; const float* stats; const float *c1a, *c1b, *c2a, *c2b; const LAS int* s_cntx;
    __device__ __forceinline__ void operator()(const f32x4 (&acc)[2][2][4][2], const Unit& u, int wr, int wc, int fr, int fq) const {
        const int cb = u.e * 1024 + u.pn * 256 + wc * 32 + 8 * fq;
        float c1[2][8], c2[2][8];
#pragma unroll
        for (int bj = 0; bj < 2; ++bj)
#pragma unroll
            for (int n = 0; n < 2; ++n) {
                const f32x4 a = *(const f32x4*)(c1a + cb + bj * 128 + 4 * n), b = *(const f32x4*)(c1b + cb + bj * 128 + 4 * n);
                const f32x4 c = *(const f32x4*)(c2a + cb + bj * 128 + 4 * n), d = *(const f32x4*)(c2b + cb + bj * 128 + 4 * n);
#pragma unroll
                for (int e = 0; e < 4; ++e) { c1[bj][4 * n + e] = a[e] + b[e]; c2[bj][4 * n + e] = c[e] + d[e]; }
            }
        const int nval = s_cntx[u.e] - u.l0;
#pragma unroll
        for (int ai = 0; ai < 2; ++ai)
#pragma unroll
            for (int m = 0; m < 4; ++m) {
                const int rl = ai * 128 + wr * 64 + m * 16 + fr;
                const int tok = rl < nval ? tlist[(size_t)u.e * T + u.l0 + rl] : 0;
                const f32x2 st = *(const f32x2*)(stats + 2 * (size_t)tok);
                float hv[8];
#pragma unroll
                for (int n = 0; n < 2; ++n)
#pragma unroll
                    for (int e = 0; e < 4; ++e) {
                        const float g = st.y * (acc[ai][0][m][n][e] - st.x * c1[0][4 * n + e]) + c2[0][4 * n + e];
                        const float up = st.y * (acc[ai][1][m][n][e] - st.x * c1[1][4 * n + e]) + c2[1][4 * n + e];
                        hv[4 * n + e] = silu_f(g) * up;
                    }
                v4u w; w.x = pk2(hv[0], hv[1]); w.y = pk2(hv[2], hv[3]); w.z = pk2(hv[4], hv[5]); w.w = pk2(hv[6], hv[7]);
                *(v4u*)(H + (size_t)(u.pm * 256 + rl) * FF + u.pn * 128 + wc * 32 + 8 * fq) = w;
                EPI_FENCE();
            }
    }
};
struct EpiDown {
    static constexpr bool PERM = true;
    bf16* Y; const float* glist; const LAS int* s_cntx;
    __device__ __forceinline__ void operator()(const f32x4 (&acc)[2][2][4][2], const Unit& u, int wr, int wc, int fr, int fq) const {
        const int nval = s_cntx[u.e] - u.l0;
#pragma unroll
        for (int ai = 0; ai < 2; ++ai)
#pragma unroll
            for (int m = 0; m < 4; ++m) {
                const int rl = ai * 128 + wr * 64 + m * 16 + fr;
                const float g = rl < nval ? glist[(size_t)u.e * T + u.l0 + rl] : 0.f;
#pragma unroll
                for (int bj = 0; bj < 2; ++bj) {
                    const f32x4 a = acc[ai][bj][m][0] * g, b = acc[ai][bj][m][1] * g;
                    v4u w; w.x = pk2(a[0], a[1]); w.y = pk2(a[2], a[3]); w.z = pk2(b[0], b[1]); w.w = pk2(b[2], b[3]);
                    *(v4u*)(Y + (size_t)(u.pm * 256 + rl) * D + u.pn * 256 + bj * 128 + wc * 32 + 8 * fq) = w;
                }
                EPI_FENCE();
            }
    }
};

__device__ __forceinline__ int win_src_col(int n) {
    if (n < 1024) { int t = n & 63; const int hb = n & ~63; if (t < 16) t = (t & 1) ? 8 + (t >> 1) : (t >> 1); return hb + t; }
    if (n >= 1792 && n < 2048) { const int t = n - 1792, bj = t >> 7, wc = (t >> 5) & 3, j = t & 31; return 1792 + 64 * wc + 32 * bj + j; }
    return n;
}
__device__ __forceinline__ void p0_tr_item(const float* cp, int ld, int K, bf16* WT, int k0, int n0, LAS float* scr, int lane) {
#pragma unroll 8
    for (int i = 0; i < 32; ++i) { const int kk = 2 * i + (lane >> 5); scr[kk * 33 + (lane & 31)] = cp[(size_t)(k0 + kk) * ld]; }
    LDS_WAIT(); asm volatile("" ::: "memory");
    const int c = lane & 7;
#pragma unroll
    for (int j = 0; j < 4; ++j) { const int n = (lane >> 3) + 8 * j; const LAS float* s = scr + (8 * c) * 33 + n;
        v4u o; o.x = pk2(s[0 * 33], s[1 * 33]); o.y = pk2(s[2 * 33], s[3 * 33]); o.z = pk2(s[4 * 33], s[5 * 33]); o.w = pk2(s[6 * 33], s[7 * 33]);
        *(v4u*)(WT + (size_t)(n0 + n) * K + k0 + 8 * c) = o; }
    LDS_WAIT(); asm volatile("" ::: "memory");
}
__device__ __forceinline__ void p0_gu_item(const float* cp, int ld, const float* gk, const float* bk, bf16* WT, int n0, int kh, float* c1p, float* c2p, LAS float* scr, int lane) {
    float c1 = 0.f, c2 = 0.f;
    for (int kb = kh * 8; kb < kh * 8 + 8; ++kb) {
        const int k0 = 64 * kb;
#pragma unroll 8
        for (int i = 0; i < 32; ++i) { const int kk = 2 * i + (lane >> 5); const float w = cp[(size_t)(k0 + kk) * ld];
            const float r = bflo(pk2(w * gk[k0 + kk], 0.f)); c1 += r; c2 += bk[k0 + kk] * w; scr[kk * 33 + (lane & 31)] = r; }
        LDS_WAIT(); asm volatile("" ::: "memory");
        const int c = lane & 7;
#pragma unroll
        for (int j = 0; j < 4; ++j) { const int n = (lane >> 3) + 8 * j; const LAS float* sp = scr + (8 * c) * 33 + n;
            v4u o; o.x = pk2(sp[0 * 33], sp[1 * 33]); o.y = pk2(sp[2 * 33], sp[3 * 33]); o.z = pk2(sp[4 * 33], sp[5 * 33]); o.w = pk2(sp[6 * 33], sp[7 * 33]);
            *(v4u*)(WT + (size_t)(n0 + n) * D + k0 + 8 * c) = o; }
        LDS_WAIT(); asm volatile("" ::: "memory");
    }
    c1 += __shfl_xor(c1, 32); c2 += __shfl_xor(c2, 32);
    if (lane < 32) { c1p[n0 + lane] = c1; c2p[n0 + lane] = c2; }
}
struct Ptrs {
    const float *x, *w_in, *w_out, *lg, *lb, *wsp, *bsp, *pw, *psc, *ln1g, *ln1b, *rw, *rb, *wg, *wu, *wd, *ln2g, *ln2b;
    float* out; unsigned char* ws;
};
__device__ __forceinline__ void p0_prologue(const Ptrs& P, LAS unsigned char* lds, int vcu, int G, int wave, int lane, int tid) {
    LAS float* scr = (LAS float*)(lds + wave * 16384);
    const int gw = vcu * NWAVES + wave, NGW = G * NWAVES;
    bf16* WIN = (bf16*)(P.ws + WS_WIN); bf16* WOUT = (bf16*)(P.ws + WS_WOUT); bf16* WGU = (bf16*)(P.ws + WS_WGU); bf16* WDN = (bf16*)(P.ws + WS_WDN);
    constexpr int I_IN = 16 * 72, I_OUT = 16 * 32, I_GU = 2 * 32, I_DN = 8 * 32;
    constexpr int N_IN = 2 * I_IN, N_OUT = 2 * I_OUT, N_GU = 32 * I_GU, N_DN = 32 * I_DN;
    for (int it = gw; it < N_IN + N_OUT + N_GU + N_DN; it += NGW) {
        int r = it;
        if (r < N_IN) { const int l = r / I_IN; r -= l * I_IN; const int kb = r / 72, nb = r % 72;
            const float* cp = P.w_in + (size_t)l * D * NCOL + win_src_col(32 * nb + (lane & 31));
            p0_tr_item(cp, NCOL, D, WIN + (size_t)l * NCOL * D, 64 * kb, 32 * nb, scr, lane); continue; }
        r -= N_IN;
        if (r < N_OUT) { const int l = r / I_OUT; r -= l * I_OUT; const int kb = r / 32, nb = r % 32;
            const float* cp = P.w_out + (size_t)l * D * D + 32 * nb + (lane & 31);
            p0_tr_item(cp, D, D, WOUT + (size_t)l * D * D, 64 * kb, 32 * nb, scr, lane); continue; }
        r -= N_OUT;
        if (r < N_GU) { const int le = r / I_GU; r -= le * I_GU; const int kh = r / 32, nb = r % 32, l = le >> 4;
            const int n = 32 * nb + (lane & 31), pn = n >> 8, t = n & 255;
            const float* cp = (t < 128 ? P.wg : P.wu) + (size_t)le * D * FF + 128 * pn + (t & 127);
            p0_gu_item(cp, FF, P.ln1g + l * D, P.ln1b + l * D, WGU + (size_t)le * 1024 * D, 32 * nb, kh,
                       (float*)(P.ws + WS_C1P) + ((size_t)kh * 32 + le) * 1024, (float*)(P.ws + WS_C2P) + ((size_t)kh * 32 + le) * 1024, scr, lane); continue; }
        r -= N_GU;
        { const int le = r / I_DN; r -= le * I_DN; const int kb = r / 32, nb = r % 32;
            const float* cp = P.wd + (size_t)le * FF * D + 32 * nb + (lane & 31);
            p0_tr_item(cp, D, FF, WDN + (size_t)le * D * FF, 64 * kb, 32 * nb, scr, lane); }
    }
    bf16* XB = (bf16*)(P.ws + WS_HB);
    for (size_t i = (size_t)gw * 64 + lane; i < (size_t)T * D / 8; i += (size_t)NGW * 64) {
        const f32x4 a = *(const f32x4*)(P.x + i * 8), b = *(const f32x4*)(P.x + i * 8 + 4);
        v4u w; w.x = pk2(a[0], a[1]); w.y = pk2(a[2], a[3]); w.z = pk2(b[0], b[1]); w.w = pk2(b[2], b[3]);
        *(v4u*)(XB + i * 8) = w;
    }
    const int gt = vcu * NTHREADS + tid, NGT = G * NTHREADS;
    float* rope = (float*)(P.ws + WS_ROPE);
    for (int i = gt; i < S * 8; i += NGT) { const int pos = i >> 3, k = i & 7;
        const float inv = powf(500000.0f, -(float)k / 8.0f); const float ang = (float)pos * inv;
        rope[2 * i] = cosf(ang); rope[2 * i + 1] = sinf(ang); }
    bf16* WPT = (bf16*)(P.ws + WS_WPT);
    for (int i = gt; i < 2 * 4 * 64 * 64; i += NGT) { const int ii = i & 63, o = (i >> 6) & 63, lgi = i >> 12;
        WPT[i] = (bf16)(pk2(P.pw[((size_t)lgi * 64 + ii) * 64 + o], 0.f) & 0xffffu); }
    bf16* WST = (bf16*)(P.ws + WS_WST);
    for (int i = gt; i < 2 * 4 * 128 * 128; i += NGT) WST[i] = (bf16)(pk2(P.wsp[i], 0.f) & 0xffffu);
    float* RWQ = (float*)(P.ws + WS_RWQ);
    for (int i = gt; i < 2 * 16384; i += NGT) { const int j = i & 3, e = (i >> 2) & 15, kq = (i >> 6) & 255, l = i >> 14; const int k = 4 * kq + j;
        RWQ[i] = P.ln1g[l * D + k] * P.rw[(size_t)k * 16 + e]; }
    float* CR = (float*)(P.ws + WS_CR);
    if (gw < 32) { const int l = gw >> 4, e = gw & 15; float a = 0.f, b = 0.f;
        for (int j = 0; j < 16; ++j) { const int k = lane + 64 * j; const float w = P.rw[(size_t)k * 16 + e]; a += P.ln1g[l * D + k] * w; b += P.ln1b[l * D + k] * w; }
        a = wave_sum(a); b = wave_sum(b);
        if (lane == 0) { CR[l * 32 + e] = a; CR[l * 32 + 16 + e] = b; } }
}

constexpr int KT_STRIDE = 144, VT_STRIDE = 192;
constexpr int ATT_WAVE_LDS = 32 * KT_STRIDE + 32 * VT_STRIDE;
#define MFMA32(a, b, c) __builtin_amdgcn_mfma_f32_32x32x16_bf16((a), (b), (c), 0, 0, 0)
__device__ __forceinline__ s16x4 tr16(LAS unsigned char* p) { return __builtin_amdgcn_ds_read_tr16_b64_v4i16((LAS s16x4*)p); }

__device__ __forceinline__ void attn_task(const bf16* __restrict__ Qb, const bf16* __restrict__ Kb, const bf16* __restrict__ Vb, bf16* __restrict__ POc, float* __restrict__ LSEc,
                                          int b, int h, int dsh, int r, int j0, LAS unsigned char* kt, LAS unsigned char* vt, int lane) {
    const int dil = 1 << dsh, L = S >> dsh;
    const int qi = lane & 31, hh = lane >> 5;
    const size_t brow = (size_t)b * S;
    const size_t qrow = brow + (size_t)(j0 + qi) * dil + r;
    const bf16* qp = Qb + qrow * 512 + h * 64 + 8 * hh;
    bf16x8 qf[4];
#pragma unroll
    for (int ks = 0; ks < 4; ++ks) qf[ks] = *(const bf16x8*)(qp + 16 * ks);
    int kb_lo = 2 - (j0 >> 5); if (kb_lo < 0) kb_lo = 0;
    int kb_hi = ((L - j0) >> 5) + 1; if (kb_hi > 4) kb_hi = 4;
    const int srow = lane >> 3, sch = lane & 7;
    const bf16* kbase = Kb + (brow + r) * 512 + h * 64 + sch * 8;
    const bf16* vbase = Vb + (brow + r) * 512 + h * 64 + sch * 8;
    v4u kreg[4], vreg[4];
    {
        const int jk0 = j0 - 64 + 32 * kb_lo;
#pragma unroll
        for (int i = 0; i < 4; ++i) { const size_t off = (size_t)(jk0 + srow + 8 * i) * dil * 512; kreg[i] = *(const v4u*)(kbase + off); vreg[i] = *(const v4u*)(vbase + off); }
    }
    f32x16 o0, o1;
#pragma unroll
    for (int i = 0; i < 16; ++i) { o0[i] = 0.f; o1[i] = 0.f; }
    float m = -1e30f, l = 0.f;
    const int q4 = (lane & 15) >> 2, p4 = lane & 3, blk = (lane >> 4) & 1;
    LAS unsigned char* vrd = vt + (4 * hh + q4) * VT_STRIDE + (16 * blk + 4 * p4) * 2;
    for (int kb = kb_lo; kb <= kb_hi; ++kb) {
#pragma unroll
        for (int i = 0; i < 4; ++i) { *(LAS v4u*)(kt + (srow + 8 * i) * KT_STRIDE + sch * 16) = kreg[i]; *(LAS v4u*)(vt + (srow + 8 * i) * VT_STRIDE + sch * 16) = vreg[i]; }
        if (kb < kb_hi) {
            const int jk0 = j0 - 64 + 32 * (kb + 1);
#pragma unroll
            for (int i = 0; i < 4; ++i) { const size_t off = (size_t)(jk0 + srow + 8 * i) * dil * 512; kreg[i] = *(const v4u*)(kbase + off); vreg[i] = *(const v4u*)(vbase + off); }
        }
        f32x16 st;
#pragma unroll
        for (int i = 0; i < 16; ++i) st[i] = 0.f;
#pragma unroll
        for (int ks = 0; ks < 4; ++ks) { const bf16x8 kf = *(const LAS bf16x8*)(kt + qi * KT_STRIDE + (16 * ks + 8 * hh) * 2); st = MFMA32(kf, qf[ks], st); }
        float mx = -1e30f;
#pragma unroll
        for (int i = 0; i < 16; ++i) { float s = st[i] * LOG2E; const int kl = crow(i, hh);
            if (kb == 0 && kl < qi) s = -1e30f;
            if (kb == 4 && kl > qi) s = -1e30f;
            st[i] = s; mx = fmaxf(mx, s); }
        mx = fmaxf(mx, __shfl_xor(mx, 32));
        const float mn = fmaxf(m, mx); const float alpha = fast_exp2(m - mn); m = mn;
        float ps = 0.f;
#pragma unroll
        for (int i = 0; i < 16; ++i) { const float p = fast_exp2(st[i] - mn); ps += p; st[i] = p; }
        l = l * alpha + ps;
        o0 = o0 * alpha; o1 = o1 * alpha;
        bf16x8 pf[2];
#pragma unroll
        for (int s = 0; s < 2; ++s) { v4u w; w.x = pk2(st[8 * s], st[8 * s + 1]); w.y = pk2(st[8 * s + 2], st[8 * s + 3]); w.z = pk2(st[8 * s + 4], st[8 * s + 5]); w.w = pk2(st[8 * s + 6], st[8 * s + 7]);
            pf[s] = __builtin_bit_cast(bf16x8, w); }
#pragma unroll
        for (int s = 0; s < 2; ++s) {
            { const s16x4 lo = tr16(vrd + (16 * s) * VT_STRIDE), hi = tr16(vrd + (16 * s + 8) * VT_STRIDE);
              const bf16x8 vf = __builtin_shufflevector(lo, hi, 0, 1, 2, 3, 4, 5, 6, 7); o0 = MFMA32(vf, pf[s], o0); }
            { const s16x4 lo = tr16(vrd + (16 * s) * VT_STRIDE + 64), hi = tr16(vrd + (16 * s + 8) * VT_STRIDE + 64);
              const bf16x8 vf = __builtin_shufflevector(lo, hi, 0, 1, 2, 3, 4, 5, 6, 7); o1 = MFMA32(vf, pf[s], o1); }
        }
    }
    l += __shfl_xor(l, 32);
    const float inv = 1.0f / l;
    bf16* op = POc + qrow * 512 + h * 64 + 4 * hh;
#pragma unroll
    for (int g4 = 0; g4 < 4; ++g4) {
        v2u w; w.x = pk2(o0[4 * g4] * inv, o0[4 * g4 + 1] * inv); w.y = pk2(o0[4 * g4 + 2] * inv, o0[4 * g4 + 3] * inv); *(v2u*)(op + 8 * g4) = w;
        v2u w1; w1.x = pk2(o1[4 * g4] * inv, o1[4 * g4 + 1] * inv); w1.y = pk2(o1[4 * g4 + 2] * inv, o1[4 * g4 + 3] * inv); *(v2u*)(op + 32 + 8 * g4) = w1;
    }
    if (hh == 0) LSEc[qrow * 8 + h] = m + __log2f(l);
}

__device__ __forceinline__ void p2_attention(const unsigned char* ws, unsigned char* wsw, LAS unsigned char* lds, int vcu, int G, int wave, int lane, int tid) {
    const bf16* Qb = (const bf16*)(ws + WS_Q); const bf16* Kb = (const bf16*)(ws + WS_K); const bf16* Vb = (const bf16*)(ws + WS_V);
    bf16* PO = (bf16*)(wsw + WS_PO); float* LSE = (float*)(wsw + WS_LSE); bf16* CC = (bf16*)(wsw + WS_CC);
    LAS unsigned char* kt = lds + wave * ATT_WAVE_LDS; LAS unsigned char* vt = kt + 32 * KT_STRIDE;
    for (int item = vcu; item < NB * 8 * 2; item += G) {
        const int sp = item & 1, h = (item >> 1) & 7, b = item >> 4;
        for (int task = wave; task < 96; task += NWAVES) {
            const int c = task >> 5, tt = task & 31, dsh = 2 * c;
            const int r = tt >> (5 - dsh), jb = tt & ((32 >> dsh) - 1);
            const int j0 = ((1024 * sp) >> dsh) + 32 * jb;
            attn_task(Qb, Kb, Vb, PO + (size_t)c * T * 512, LSE + (size_t)c * T * 8, b, h, dsh, r, j0, kt, vt, lane);
        }
        __syncthreads();
        for (int it = tid; it < 8192; it += NTHREADS) {
            const int pl = it >> 3, ch = it & 7; const size_t row = (size_t)b * S + 1024 * sp + pl;
            const float l0 = LSE[row * 8 + h], l1 = LSE[((size_t)T + row) * 8 + h], l2 = LSE[((size_t)2 * T + row) * 8 + h];
            const float mx = fmaxf(l0, fmaxf(l1, l2));
            float w0 = fast_exp2(l0 - mx), w1 = fast_exp2(l1 - mx), w2 = fast_exp2(l2 - mx);
            const float inv = 1.0f / (w0 + w1 + w2); w0 *= inv; w1 *= inv; w2 *= inv;
            const v4u a = *(const v4u*)(PO + row * 512 + h * 64 + 8 * ch), bq = *(const v4u*)(PO + ((size_t)T + row) * 512 + h * 64 + 8 * ch), cq = *(const v4u*)(PO + ((size_t)2 * T + row) * 512 + h * 64 + 8 * ch);
            v4u o;
            o.x = pk2(w0 * bflo(a.x) + w1 * bflo(bq.x) + w2 * bflo(cq.x), w0 * bfhi(a.x) + w1 * bfhi(bq.x) + w2 * bfhi(cq.x));
            o.y = pk2(w0 * bflo(a.y) + w1 * bflo(bq.y) + w2 * bflo(cq.y), w0 * bfhi(a.y) + w1 * bfhi(bq.y) + w2 * bfhi(cq.y));
            o.z = pk2(w0 * bflo(a.z) + w1 * bflo(bq.z) + w2 * bflo(cq.z), w0 * bfhi(a.z) + w1 * bfhi(bq.z) + w2 * bfhi(cq.z));
            o.w = pk2(w0 * bflo(a.w) + w1 * bflo(bq.w) + w2 * bflo(cq.w), w0 * bfhi(a.w) + w1 * bfhi(bq.w) + w2 * bfhi(cq.w));
            *(v4u*)(CC + row * D + h * 64 + 8 * ch) = o;
        }
        __syncthreads();
    }
}
__device__ __forceinline__ void p2_gmlp(const Ptrs& P, int l, LAS unsigned char* lds, int vcu, int G, int wave, int lane, int tid) {
    const bf16* Gb = (const bf16*)(P.ws + WS_G); const bf16* Ub = (const bf16*)(P.ws + WS_U); bf16* CC = (bf16*)(P.ws + WS_CC);
    const bf16* WST = (const bf16*)(P.ws + WS_WST) + (size_t)l * 4 * 128 * 128;
    const float* bs = P.bsp + l * 4 * 128;
    const int hh = lane >> 5, q4 = (lane & 15) >> 2, p4 = lane & 3, blk = (lane >> 4) & 1;
    const int pb = wave & 3, db = wave >> 2;
    for (int item = vcu; item < NB * 16 * 4; item += G) {
        const int g = item & 3, cch = (item >> 2) & 15, b = item >> 6;
        const size_t row0 = (size_t)b * S + cch * 128;
#pragma unroll
        for (int i = 0; i < 2; ++i) { const int idx = tid + NTHREADS * i, q = idx >> 3, ch = idx & 7;
            *(LAS v4u*)(lds + q * VT_STRIDE + ch * 16) = *(const v4u*)(Gb + (row0 + q) * 256 + g * 64 + ch * 8); }
        __syncthreads();
        f32x16 acc;
#pragma unroll
        for (int i = 0; i < 16; ++i) acc[i] = 0.f;
        const bf16* wp = WST + ((size_t)g * 128 + 32 * pb + (lane & 31)) * 128 + 8 * hh;
        LAS unsigned char* vrd = lds + (8 * hh + q4) * VT_STRIDE + (32 * db + 16 * blk + 4 * p4) * 2;
#pragma unroll
        for (int s = 0; s < 8; ++s) {
            const bf16x8 wf = *(const bf16x8*)(wp + 16 * s);
            const s16x4 lo = tr16(vrd + (16 * s) * VT_STRIDE), hi = tr16(vrd + (16 * s + 4) * VT_STRIDE);
            const bf16x8 vf = __builtin_shufflevector(lo, hi, 0, 1, 2, 3, 4, 5, 6, 7);
            acc = MFMA32(vf, wf, acc);
        }
        const int p = 32 * pb + (lane & 31);
        const float bsv = bs[g * 128 + p];
#pragma unroll
        for (int g4 = 0; g4 < 4; ++g4) {
            const int d0 = 32 * db + 8 * g4 + 4 * hh;
            const v2u uu = *(const v2u*)(Ub + (row0 + p) * 256 + g * 64 + d0);
            v2u w; w.x = pk2(bflo(uu.x) * (acc[4 * g4] + bsv), bfhi(uu.x) * (acc[4 * g4 + 1] + bsv)); w.y = pk2(bflo(uu.y) * (acc[4 * g4 + 2] + bsv), bfhi(uu.y) * (acc[4 * g4 + 3] + bsv));
            *(v2u*)(CC + (row0 + p) * D + 512 + g * 64 + d0) = w;
        }
        __syncthreads();
    }
}
__device__ __forceinline__ void p2_pool(const Ptrs& P, int l, int vcu, int G, int wave, int lane) {
    const bf16* Zb = (const bf16*)(P.ws + WS_Z); bf16* CC = (bf16*)(P.ws + WS_CC);
    const bf16* WPT = (const bf16*)(P.ws + WS_WPT) + (size_t)l * 4 * 64 * 64;
    const float* psc = P.psc + l * 256;
    const int hh = lane >> 5, pl = lane & 31;
    const int gw = vcu * NWAVES + wave, NGW = G * NWAVES;
    for (int task = gw; task < NB * 4 * 64; task += NGW) {
        const int tile = task & 63, g = (task >> 6) & 3, b = task >> 8;
        const int pos = 32 * tile + pl;
        const int w = 2 << g, left = w >> 1, right = w - 1 - left;
        int lo = pos - left; if (lo < 0) lo = 0;
        int hi = pos + right + 1; if (hi > S) hi = S;
        const float inv = 1.0f / (float)(hi - lo);
        const bf16* zb = Zb + (size_t)b * S * 256 + g * 64 + 8 * hh;
        bf16x8 bfr[4];
#pragma unroll
        for (int ks = 0; ks < 4; ++ks) {
            float sm[8];
#pragma unroll
            for (int e = 0; e < 8; ++e) sm[e] = 0.f;
            for (int t = lo; t < hi; ++t) { const v4u z = *(const v4u*)(zb + (size_t)t * 256 + 16 * ks);
                sm[0] += bflo(z.x); sm[1] += bfhi(z.x); sm[2] += bflo(z.y); sm[3] += bfhi(z.y); sm[4] += bflo(z.z); sm[5] += bfhi(z.z); sm[6] += bflo(z.w); sm[7] += bfhi(z.w); }
            const v4u z = *(const v4u*)(zb + (size_t)pos * 256 + 16 * ks);
            v4u o; o.x = pk2(sm[0] * inv - bflo(z.x), sm[1] * inv - bfhi(z.x)); o.y = pk2(sm[2] * inv - bflo(z.y), sm[3] * inv - bfhi(z.y));
            o.z = pk2(sm[4] * inv - bflo(z.z), sm[5] * inv - bfhi(z.z)); o.w = pk2(sm[6] * inv - bflo(z.w), sm[7] * inv - bfhi(z.w));
            bfr[ks] = __builtin_bit_cast(bf16x8, o);
        }
#pragma unroll
        for (int ob = 0; ob < 2; ++ob) {
            f32x16 acc;
#pragma unroll
            for (int i = 0; i < 16; ++i) acc[i] = 0.f;
#pragma unroll
            for (int ks = 0; ks < 4; ++ks) { const bf16x8 af = *(const bf16x8*)(WPT + ((size_t)g * 64 + 32 * ob + pl) * 64 + 16 * ks + 8 * hh); acc = MFMA32(af, bfr[ks], acc); }
#pragma unroll
            for (int g4 = 0; g4 < 4; ++g4) {
                const int o0 = 32 * ob + 8 * g4 + 4 * hh;
                const f32x4 sc = *(const f32x4*)(psc + g * 64 + o0);
                v2u w; w.x = pk2(acc[4 * g4] * sc[0], acc[4 * g4 + 1] * sc[1]); w.y = pk2(acc[4 * g4 + 2] * sc[2], acc[4 * g4 + 3] * sc[3]);
                *(v2u*)(CC + ((size_t)b * S + pos) * D + 768 + g * 64 + o0) = w;
            }
        }
    }
}

__device__ __forceinline__ void route16(const float* logit, const float* __restrict__ rbias, int& e0, int& e1, float& g0, float& g1) {
    float sc[16], bi[16];
#pragma unroll
    for (int e = 0; e < 16; ++e) { sc[e] = 1.0f / (1.0f + expf(-logit[e])); bi[e] = sc[e] + rbias[e]; }
    int gsel = 0; float best = -1e30f;
#pragma unroll
    for (int g = 0; g < 4; ++g) {
        float m1 = -1e30f, m2 = -1e30f;
#pragma unroll
        for (int j = 0; j < 4; ++j) { const float v = bi[g * 4 + j]; if (v > m1) { m2 = m1; m1 = v; } else if (v > m2) m2 = v; }
        const float gs = m1 + m2;
        if (gs > best) { best = gs; gsel = g; }
    }
    float bg[4], sg[4];
#pragma unroll
    for (int j = 0; j < 4; ++j) { bg[j] = bi[j]; sg[j] = sc[j];
#pragma unroll
        for (int g = 1; g < 4; ++g) { bg[j] = (g == gsel) ? bi[g * 4 + j] : bg[j]; sg[j] = (g == gsel) ? sc[g * 4 + j] : sg[j]; } }
    int i1 = 0; float m1 = bg[0], s1 = sg[0];
#pragma unroll
    for (int j = 1; j < 4; ++j) if (bg[j] > m1) { m1 = bg[j]; i1 = j; s1 = sg[j]; }
    int i2 = -1; float m2 = -1e30f, s2 = 0.f;
#pragma unroll
    for (int j = 0; j < 4; ++j) if (j != i1 && bg[j] > m2) { m2 = bg[j]; i2 = j; s2 = sg[j]; }
    e0 = gsel * 4 + i1; e1 = gsel * 4 + i2;
    g0 = s1 / (s1 + s2); g1 = s2 / (s1 + s2);
}
__device__ __forceinline__ void p4_stats_router(const Ptrs& P, int l, LAS unsigned char* lds, int wave, int lane, int tid) {
    const bf16* Y1B = (const bf16*)(P.ws + WS_Y1B); float* STATS = (float*)(P.ws + WS_STATS);
    int* TOKE = (int*)(P.ws + WS_TOKE); float* TOKG = (float*)(P.ws + WS_TOKG); int* TOKP = (int*)(P.ws + WS_TOKP);
    int* TLIST = (int*)(P.ws + WS_TLIST); float* GLIST = (float*)(P.ws + WS_GLIST);
    unsigned* cnt = (unsigned*)(P.ws + WS_CTL) + CW_CNT + 16 * l;
    const float* RWQ = (const float*)(P.ws + WS_RWQ) + (size_t)l * 16384; const float* CR = (const float*)(P.ws + WS_CR) + l * 32;
    LAS float* rwq = (LAS float*)lds;
    for (int i = tid; i < 4096; i += NTHREADS) ((LAS f32x4*)rwq)[i] = ((const f32x4*)RWQ)[i];
    LAS float* dots = (LAS float*)(lds + 65536) + wave * 256;
    LAS int* s_cnt = (LAS int*)(lds + 65536 + 8192); LAS int* s_base = s_cnt + 16; LAS int* s_e = s_cnt + 32; LAS int* s_pos = s_e + 256; LAS float* s_g = (LAS float*)(s_pos + 256);
    if (tid < 16) s_cnt[tid] = 0;
    __syncthreads();
    const int row_l = lane & 15, q = lane >> 4;
    for (int blk_row = blockIdx.x * 128; blk_row < T; blk_row += gridDim.x * 128) {
        const int row = blk_row + wave * 16 + row_l;
        const bf16* yp = Y1B + (size_t)row * D + 8 * q;
        f32x4 acc = {0.f, 0.f, 0.f, 0.f}; float s1 = 0.f, s2 = 0.f;
#pragma unroll 1
        for (int jc = 0; jc < 4; ++jc) {
            v4u yv[8];
#pragma unroll
            for (int jj = 0; jj < 8; ++jj) yv[jj] = *(const v4u*)(yp + 32 * (8 * jc + jj));
#pragma unroll
            for (int jj = 0; jj < 8; ++jj) {
                const int jp = 8 * jc + jj;
                const float y0 = bflo(yv[jj].x), y1 = bfhi(yv[jj].x), y2 = bflo(yv[jj].y), y3 = bfhi(yv[jj].y), y4 = bflo(yv[jj].z), y5 = bfhi(yv[jj].z), y6 = bflo(yv[jj].w), y7 = bfhi(yv[jj].w);
                const LAS f32x4* bp = (const LAS f32x4*)rwq + (8 * jp + 2 * q) * 16 + row_l;
                const f32x4 b0 = bp[0], b1 = bp[16];
                acc = __builtin_amdgcn_mfma_f32_16x16x4f32(y0, b0[0], acc, 0, 0, 0); acc = __builtin_amdgcn_mfma_f32_16x16x4f32(y1, b0[1], acc, 0, 0, 0);
                acc = __builtin_amdgcn_mfma_f32_16x16x4f32(y2, b0[2], acc, 0, 0, 0); acc = __builtin_amdgcn_mfma_f32_16x16x4f32(y3, b0[3], acc, 0, 0, 0);
                acc = __builtin_amdgcn_mfma_f32_16x16x4f32(y4, b1[0], acc, 0, 0, 0); acc = __builtin_amdgcn_mfma_f32_16x16x4f32(y5, b1[1], acc, 0, 0, 0);
                acc = __builtin_amdgcn_mfma_f32_16x16x4f32(y6, b1[2], acc, 0, 0, 0); acc = __builtin_amdgcn_mfma_f32_16x16x4f32(y7, b1[3], acc, 0, 0, 0);
                s1 += ((y0 + y1) + (y2 + y3)) + ((y4 + y5) + (y6 + y7));
                s2 += ((y0 * y0 + y1 * y1) + (y2 * y2 + y3 * y3)) + ((y4 * y4 + y5 * y5) + (y6 * y6 + y7 * y7));
            }
        }
        s1 += __shfl_xor(s1, 16); s1 += __shfl_xor(s1, 32); s2 += __shfl_xor(s2, 16); s2 += __shfl_xor(s2, 32);
#pragma unroll
        for (int i = 0; i < 4; ++i) dots[(4 * q + i) * 16 + row_l] = acc[i];
        LDS_WAIT();
        if (lane < 16) {
            const int grow = blk_row + wave * 16 + lane;
            const float mu = s1 * (1.0f / D), var = s2 * (1.0f / D) - mu * mu, rstd = rsqrtf(var + LN_EPS);
            *(f32x2*)(STATS + 2 * (size_t)grow) = (f32x2){mu, rstd};
            float lg[16];
#pragma unroll
            for (int e4 = 0; e4 < 4; ++e4) { const f32x4 d = *(const LAS f32x4*)(dots + lane * 16 + 4 * e4);
#pragma unroll
                for (int e = 0; e < 4; ++e) lg[4 * e4 + e] = rstd * (d[e] - mu * CR[4 * e4 + e]) + CR[16 + 4 * e4 + e]; }
            int e0, e1; float g0, g1;
            route16(lg, P.rb, e0, e1, g0, g1);
            const int tl = wave * 16 + lane;
            const int p0 = __hip_atomic_fetch_add(s_cnt + e0, 1, __ATOMIC_RELAXED, __HIP_MEMORY_SCOPE_WORKGROUP);
            const int p1 = __hip_atomic_fetch_add(s_cnt + e1, 1, __ATOMIC_RELAXED, __HIP_MEMORY_SCOPE_WORKGROUP);
            s_e[2 * tl] = e0; s_e[2 * tl + 1] = e1; s_pos[2 * tl] = p0; s_pos[2 * tl + 1] = p1; s_g[2 * tl] = g0; s_g[2 * tl + 1] = g1;
            TOKE[2 * grow] = e0; TOKE[2 * grow + 1] = e1; TOKG[2 * grow] = g0; TOKG[2 * grow + 1] = g1;
        }
        __syncthreads();
        if (tid < 16) s_base[tid] = (int)__hip_atomic_fetch_add(cnt + tid, (unsigned)s_cnt[tid], RLX_AGENT);
        __syncthreads();
        if (tid < 256) { const int e = s_e[tid], p = s_base[e] + s_pos[tid]; TOKP[2 * blk_row + tid] = p;
            TLIST[(size_t)e * T + p] = blk_row + (tid >> 1); GLIST[(size_t)e * T + p] = s_g[tid]; }
        if (tid < 16) s_cnt[tid] = 0;
        __syncthreads();
    }
}
__device__ __forceinline__ int build_tables(const unsigned char* ws, int l, LAS unsigned char* lds, int tid) {
    LAS int* s_base = (LAS int*)(lds + TAB_OFF); LAS int* s_cntx = s_base + 32; LAS int* texp = s_base + 64;
    const unsigned* cnt = (const unsigned*)(ws + WS_CTL) + CW_CNT + 16 * l;
    if (tid == 0) {
        int base = 0;
        for (int e = 0; e < 16; ++e) { const int c = (int)__hip_atomic_load(cnt + e, RLX_AGENT); const int nt = (c + 255) >> 8;
            s_cntx[e] = c; s_base[e] = base; for (int t = 0; t < nt; ++t) texp[(base >> 8) + t] = e; base += nt << 8; }
        s_base[16] = base;
    }
    __syncthreads();
    return s_base[16] >> 8;
}
__device__ __forceinline__ void p8_ln2(const Ptrs& P, int l, bool last, LAS unsigned char* lds, int vcu, int G, int wave, int lane) {
    const LAS int* s_base = (const LAS int*)(lds + TAB_OFF);
    const bf16* Y1B = (const bf16*)(P.ws + WS_Y1B); const float* STATS = (const float*)(P.ws + WS_STATS); const bf16* YB = (const bf16*)(P.ws + WS_YB); bf16* XB = (bf16*)(P.ws + WS_HB);
    const int* TOKE = (const int*)(P.ws + WS_TOKE); const int* TOKP = (const int*)(P.ws + WS_TOKP);
    const float* g1p = P.ln1g + l * D; const float* b1p = P.ln1b + l * D; const float* g2p = P.ln2g + l * D; const float* b2p = P.ln2b + l * D;
    float g1[16], b1[16], g2[16], b2[16];
#pragma unroll
    for (int j = 0; j < 2; ++j)
#pragma unroll
        for (int h = 0; h < 2; ++h) { const int c = 8 * lane + 512 * j + 4 * h;
            const f32x4 a = *(const f32x4*)(g1p + c), b = *(const f32x4*)(b1p + c), cc = *(const f32x4*)(g2p + c), d = *(const f32x4*)(b2p + c);
#pragma unroll
            for (int e = 0; e < 4; ++e) { g1[8 * j + 4 * h + e] = a[e]; b1[8 * j + 4 * h + e] = b[e]; g2[8 * j + 4 * h + e] = cc[e]; b2[8 * j + 4 * h + e] = d[e]; } }
    const int gw = vcu * NWAVES + wave, NGW = G * NWAVES;
    for (int t = gw; t < T; t += NGW) {
        const int r0 = s_base[TOKE[2 * t]] + TOKP[2 * t], r1 = s_base[TOKE[2 * t + 1]] + TOKP[2 * t + 1];
        const f32x2 st = *(const f32x2*)(STATS + 2 * (size_t)t);
        float v[16]; float s = 0.f;
#pragma unroll
        for (int j = 0; j < 2; ++j) {
            const v4u y = *(const v4u*)(Y1B + (size_t)t * D + 8 * lane + 512 * j);
            const v4u a = *(const v4u*)(YB + (size_t)r0 * D + 8 * lane + 512 * j), b = *(const v4u*)(YB + (size_t)r1 * D + 8 * lane + 512 * j);
            const unsigned yw[4] = {y.x, y.y, y.z, y.w}, aw[4] = {a.x, a.y, a.z, a.w}, bw[4] = {b.x, b.y, b.z, b.w};
#pragma unroll
            for (int k = 0; k < 4; ++k) {
                const int i0 = 8 * j + 2 * k;
                v[i0] = ALPHA * ((bflo(yw[k]) - st.x) * st.y * g1[i0] + b1[i0]) + bflo(aw[k]) + bflo(bw[k]);
                v[i0 + 1] = ALPHA * ((bfhi(yw[k]) - st.x) * st.y * g1[i0 + 1] + b1[i0 + 1]) + bfhi(aw[k]) + bfhi(bw[k]);
                s += v[i0] + v[i0 + 1];
            }
        }
        const float mu = wave_sum(s) * (1.0f / D); float q = 0.f;
#pragma unroll
        for (int i = 0; i < 16; ++i) { v[i] -= mu; q += v[i] * v[i]; }
        const float rstd = rsqrtf(wave_sum(q) * (1.0f / D) + LN_EPS);
#pragma unroll
        for (int i = 0; i < 16; ++i) v[i] = v[i] * rstd * g2[i] + b2[i];
        if (last) {
#pragma unroll
            for (int j = 0; j < 2; ++j) { float* op = P.out + (size_t)t * D + 8 * lane + 512 * j;
                *(f32x4*)op = (f32x4){v[8 * j], v[8 * j + 1], v[8 * j + 2], v[8 * j + 3]}; *(f32x4*)(op + 4) = (f32x4){v[8 * j + 4], v[8 * j + 5], v[8 * j + 6], v[8 * j + 7]}; }
        } else {
#pragma unroll
            for (int j = 0; j < 2; ++j) { v4u w; w.x = pk2(v[8 * j], v[8 * j + 1]); w.y = pk2(v[8 * j + 2], v[8 * j + 3]); w.z = pk2(v[8 * j + 4], v[8 * j + 5]); w.w = pk2(v[8 * j + 6], v[8 * j + 7]);
                *(v4u*)(XB + (size_t)t * D + 8 * lane + 512 * j) = w; }
        }
    }
}

template <class Tp> __device__ __forceinline__ Tp* asg(Tp* p) { GAS Tp* g = (GAS Tp*)p; asm volatile("" : "+s"(g)); return (Tp*)g; }
__device__ __forceinline__ Ptrs load_ptrs(const Ptrs& q) {
    Ptrs P;
    P.x = asg(q.x); P.w_in = asg(q.w_in); P.w_out = asg(q.w_out); P.lg = asg(q.lg); P.lb = asg(q.lb); P.wsp = asg(q.wsp); P.bsp = asg(q.bsp); P.pw = asg(q.pw); P.psc = asg(q.psc);
    P.ln1g = asg(q.ln1g); P.ln1b = asg(q.ln1b); P.rw = asg(q.rw); P.rb = asg(q.rb); P.wg = asg(q.wg); P.wu = asg(q.wu); P.wd = asg(q.wd); P.ln2g = asg(q.ln2g); P.ln2b = asg(q.ln2b);
    P.out = asg(q.out); P.ws = asg(q.ws);
    return P;
}
struct Args { Ptrs p; int ph_lo, ph_hi, li, pad; };
constexpr int N_PHASES = 15;
__global__ void __launch_bounds__(NTHREADS, 2) mk_fwd(Args args_unused) {
    const Args* ka_ = (const Args*)__builtin_amdgcn_kernarg_segment_ptr();
#ifndef USE_KA
#define KA() (&args_unused)
#else
#define KA() ({ const Args* p_ = ka_; asm volatile("" : "+s"(p_)); p_; })
#endif
    extern __shared__ __attribute__((aligned(16))) unsigned char lds_raw[];
    LAS unsigned char* lds = (LAS unsigned char*)lds_raw;
    const int tid0 = threadIdx.x; const int wave0 = __builtin_amdgcn_readfirstlane(tid0 >> 6);
    const int G = gridDim.x; const int bx = blockIdx.x; const int vcu = (G % 8 == 0) ? (bx % 8) * (G / 8) + bx / 8 : bx;
    volatile LAS unsigned* MISC = (volatile LAS unsigned*)(lds + MISC_OFF);
    for (int u = tid0; u < (LDS_BYTES - RING_BYTES) / 4; u += NTHREADS) ((LAS unsigned*)(lds + RING_BYTES))[u] = 0u;
    __syncthreads();
    const int lo = KA()->ph_lo, hi = KA()->ph_hi;
    unsigned* ctl = (unsigned*)(asg(KA()->p.ws) + WS_CTL);
    XcdBarrier bar; bar.bar = ctl + CW_BAR + KA()->li * XCD_BAR_WORDS; bar.x = 0; bar.st = nullptr;
    if (hi - lo > 1) bar = xcd_barrier_post(ctl + CW_BAR + KA()->li * XCD_BAR_WORDS, MISC + 8, tid0);
#define IN(k) (lo <= (k) && (k) < hi)
#ifndef MK_REPEAT
#define MK_REPEAT -1
#endif
#define REP(k) for (int rep_ = 0; rep_ < ((MK_REPEAT == (k)) ? 2 : 1); ++rep_)
#define PHASE_IDS() int wave = wave0; asm volatile("" : "+s"(wave)); int lane; asm volatile("v_mbcnt_lo_u32_b32 %0, -1, 0\n\tv_mbcnt_hi_u32_b32 %0, -1, %0" : "=&v"(lane)); const int tid = wave * 64 + lane; (void)tid
#define SEAM(k) do { if (IN(k) && IN((k) + 1)) xcd_barrier(bar, tid); } while (0)
#ifndef PH_MASK
#define PH_MASK 0x1ff
#endif
    if ((PH_MASK & 1) && IN(0)) REP(0) { PHASE_IDS(); const Ptrs P = load_ptrs(KA()->p); p0_prologue(P, lds, vcu, G, wave, lane, tid); SEAM(0); }
    for (int l = 0; l < 2; ++l) {
        const int pb = 1 + 7 * l;
        if ((PH_MASK & 2) && IN(pb + 0)) REP(1) {
            PHASE_IDS(); const Ptrs P = load_ptrs(KA()->p);
            pg8::Gemm g{(const bf16*)(P.ws + WS_HB), (const bf16*)(P.ws + WS_WIN) + (size_t)l * NCOL * D, D};
            pg8::StaticOrder so; so.init(T / 256, NCOL / 256, G, bx);
            EpiProj E{P.ws, P.lg + l * 256, P.lb + l * 256};
            pg8::gemm_phase<EpiProj, pg8::StaticOrder>(lds, g, so, E, wave);
            SEAM(pb + 0);
        }
        if ((PH_MASK & 4) && IN(pb + 1)) REP(2) {
            PHASE_IDS(); const Ptrs P = load_ptrs(KA()->p);
            REP(21) p2_attention(P.ws, P.ws, lds, vcu, G, wave, lane, tid);
            REP(22) p2_gmlp(P, l, lds, vcu, G, wave, lane, tid);
            REP(23) p2_pool(P, l, vcu, G, wave, lane);
            SEAM(pb + 1);
        }
        if ((PH_MASK & 8) && IN(pb + 2)) REP(3) {
            PHASE_IDS(); const Ptrs P = load_ptrs(KA()->p);
            pg8::Gemm g{(const bf16*)(P.ws + WS_CC), (const bf16*)(P.ws + WS_WOUT) + (size_t)l * D * D, D};
            pg8::StaticOrder so; so.init(T / 256, D / 256, G, bx);
            EpiOutB E{(const bf16*)(P.ws + WS_HB), (bf16*)(P.ws + WS_Y1B)};
            pg8::gemm_phase<EpiOutB, pg8::StaticOrder>(lds, g, so, E, wave);
            SEAM(pb + 2);
        }
        if ((PH_MASK & 16) && IN(pb + 3)) { PHASE_IDS(); const Ptrs P = load_ptrs(KA()->p); p4_stats_router(P, l, lds, wave, lane, tid); SEAM(pb + 3); }
        if ((PH_MASK & 64) && IN(pb + 4)) REP(6) {
            PHASE_IDS(); const Ptrs P = load_ptrs(KA()->p);
            const int ntiles = build_tables(P.ws, l, lds, tid);
            pg8::Gemm g{(const bf16*)(P.ws + WS_Y1B), (const bf16*)(P.ws + WS_WGU) + (size_t)l * NE * 1024 * D, D};
            pg8::GroupOrder go; go.so.init(ntiles, 4, G, bx); go.s_base = (const LAS int*)(lds + TAB_OFF); go.tlist = (const int*)(P.ws + WS_TLIST);
            const float* c1 = (const float*)(P.ws + WS_C1P) + (size_t)l * 16 * 1024; const float* c2 = (const float*)(P.ws + WS_C2P) + (size_t)l * 16 * 1024;
            EpiGU E{(bf16*)(P.ws + WS_HB), (const int*)(P.ws + WS_TLIST), (const float*)(P.ws + WS_STATS), c1, c1 + 32 * 1024, c2, c2 + 32 * 1024, (const LAS int*)(lds + TAB_OFF) + 32};
            pg8::gemm_phase<EpiGU, pg8::GroupOrder, true, true>(lds, g, go, E, wave);
            SEAM(pb + 4);
        }
        if ((PH_MASK & 128) && IN(pb + 5)) REP(7) {
            PHASE_IDS(); const Ptrs P = load_ptrs(KA()->p);
            const int ntiles = build_tables(P.ws, l, lds, tid);
            pg8::Gemm g{(const bf16*)(P.ws + WS_HB), (const bf16*)(P.ws + WS_WDN) + (size_t)l * NE * D * FF, FF};
            pg8::GroupOrder go; go.so.init(ntiles, 4, G, bx); go.s_base = (const LAS int*)(lds + TAB_OFF); go.tlist = nullptr;
            EpiDown E{(bf16*)(P.ws + WS_YB), (const float*)(P.ws + WS_GLIST), (const LAS int*)(lds + TAB_OFF) + 32};
            pg8::gemm_phase<EpiDown, pg8::GroupOrder>(lds, g, go, E, wave);
            SEAM(pb + 5);
        }
        if ((PH_MASK & 256) && IN(pb + 6)) REP(8) { PHASE_IDS(); const Ptrs P = load_ptrs(KA()->p); build_tables(P.ws, l, lds, tid); p8_ln2(P, l, l == 1, lds, vcu, G, wave, lane); SEAM(pb + 6); }
    }
#undef IN
#undef SEAM
}
}
#ifndef MK_CUT
#define MK_CUT 15
#endif
#if MK_CUT < 15
namespace glue {
using namespace mk;
__global__ void g1(const unsigned char* ws, int b, float* proj) {
    const int pos = blockIdx.x; const size_t row = (size_t)b * S + pos;
    for (int col = threadIdx.x; col < NCOL; col += blockDim.x) {
        float v;
        if (col < 1024) { const int c = col & 511, head = c >> 6, d = c & 63; const int t = d < 16 ? (d < 8 ? 2 * d : 2 * (d - 8) + 1) : d;
            const bf16* src = (const bf16*)(ws + (col < 512 ? WS_Q : WS_K)); v = bflo(src[row * 512 + head * 64 + t]); if (col < 512) v *= 8.0f; }
        else if (col < 1536) v = bflo(((const bf16*)(ws + WS_V))[row * 512 + col - 1024]);
        else if (col < 1792) v = bflo(((const bf16*)(ws + WS_U))[row * 256 + col - 1536]);
        else if (col < 2048) v = bflo(((const bf16*)(ws + WS_G))[row * 256 + col - 1792]);
        else v = bflo(((const bf16*)(ws + WS_Z))[row * 256 + col - 2048]);
        proj[(size_t)pos * NCOL + col] = v;
    }
}
__global__ void g2(const unsigned char* ws, int b, float* cc) {
    const int pos = blockIdx.x; const size_t row = (size_t)b * S + pos;
    for (int col = threadIdx.x; col < D; col += blockDim.x) cc[(size_t)pos * D + col] = bflo(((const bf16*)(ws + WS_CC))[row * D + col]);
}
}
#endif

static void mk_launch_range(const mk::Ptrs& p, int grid, int lo, int hi, int li, hipStream_t stream) {
    mk::Args a{};
    a.p = p; a.ph_lo = lo; a.ph_hi = hi; a.li = li; a.pad = 0;
    hipLaunchKernelGGL(mk::mk_fwd, dim3(grid), dim3(mk::NTHREADS), mk::LDS_BYTES, stream, a);
}

extern "C" void kernel_launch(void* const* d_in, const int* in_sizes, int n_in, void* d_out, int out_size, void* d_ws, size_t ws_size, hipStream_t stream) {
    using namespace mk;
    static int grid = 0;
    if (grid == 0) {
        if (n_in != 18 || ws_size < WS_END) { fprintf(stderr, "kernel_launch: unexpected n_in %d / ws_size %zu\n", n_in, ws_size); grid = -1; return; }
        int dev = 0, cus = 0;
        if (hipGetDevice(&dev) != hipSuccess || hipDeviceGetAttribute(&cus, hipDeviceAttributeMultiprocessorCount, dev) != hipSuccess) { grid = -1; return; }
        if (hipFuncSetAttribute((const void*)mk_fwd, hipFuncAttributeMaxDynamicSharedMemorySize, LDS_BYTES) != hipSuccess) { fprintf(stderr, "kernel_launch: hipFuncSetAttribute failed\n"); grid = -1; return; }
        grid = cus;
    }
    if (grid < 0) return;
    (void)hipMemsetAsync((char*)d_ws + WS_CTL, 0, CTL_ZERO_BYTES, stream);
    Ptrs p{};
    const float* const* in = (const float* const*)d_in;
    p.x = in[0]; p.w_in = in[1]; p.w_out = in[2]; p.lg = in[3]; p.lb = in[4]; p.wsp = in[5]; p.bsp = in[6]; p.pw = in[7]; p.psc = in[8];
    p.ln1g = in[9]; p.ln1b = in[10]; p.rw = in[11]; p.rb = in[12]; p.wg = in[13]; p.wu = in[14]; p.wd = in[15]; p.ln2g = in[16]; p.ln2b = in[17];
    p.out = (float*)d_out; p.ws = (unsigned char*)d_ws;
#if MK_CUT >= 15
    mk_launch_range(p, grid, 0, N_PHASES, 0, stream);
#else
    mk_launch_range(p, grid, 0, MK_CUT, 0, stream);
    nv::In I = nv::make_in(d_in);
    const unsigned char* ws = (const unsigned char*)d_ws;
    float* scr_base = (float*)((char*)d_ws + 509 * MiB) - nv::SCR_FLOATS - (size_t)T * D;
    (void)scr_base;
    float* nscr = (float*)((char*)d_ws + (MK_CUT <= 2 ? (size_t)357 * MiB : (size_t)261 * MiB));
    nv::Scr s = nv::carve(nscr);
    float* xcur = (float*)d_out;
    for (int b = 0; b < NB; ++b) {
        const float* xin = I.x + (size_t)b * S * D; float* xout = xcur + (size_t)b * S * D; const int l = 0;
#if MK_CUT == 2
        glue::g1<<<S, 256, 0, stream>>>(ws, b, s.proj);
#endif
#if MK_CUT <= 2
        nv::attn<<<dim3(S, 8), 64, 0, stream>>>(s.proj, s.cc);
        nv::gmlp_mix<<<S, 256, 0, stream>>>(s.proj, I.wsp + (size_t)l * 4 * 128 * 128, I.bsp + l * 4 * 128, s.cc);
        nv::pool1<<<S, 256, 0, stream>>>(s.proj, s.pooled);
        nv::pool2<<<S, 256, 0, stream>>>(s.pooled, I.pw + (size_t)l * 4 * 64 * 64, I.psc + l * 256, s.cc);
#endif
#if MK_CUT == 3
        glue::g2<<<S, 256, 0, stream>>>(ws, b, s.cc);
#endif
#if MK_CUT <= 3
        nv::gemm<<<dim3(D / 64, S / 64), 256, 0, stream>>>(s.cc, I.w_out + (size_t)l * D * D, s.h, S, D, D);
        nv::ln_res<<<S, 64, 0, stream>>>(xin, s.h, I.ln1g + l * D, I.ln1b + l * D, s.x1);
#endif
        nv::route<<<S, 64, 0, stream>>>(s.x1, I.rw, I.rb, s.eo, s.go);
        nv::moe<<<S, 256, 0, stream>>>(s.x1, s.eo, s.go, I.wg + (size_t)l * NE * D * FF, I.wu + (size_t)l * NE * D * FF, I.wd + (size_t)l * NE * FF * D, s.moe);
        nv::ln_res<<<S, 64, 0, stream>>>(s.x1, s.moe, I.ln2g + l * D, I.ln2b + l * D, xout);
    }
    for (int b = 0; b < NB; ++b) { float* xb = xcur + (size_t)b * S * D; nv::layer(I, 1, xb, xb, s, stream); }
#endif
}
```

```cpp
#define MK_CUT 15
#include <hip/hip_runtime.h>
#include <cstdio>
namespace pg8 {
#define PG8_LAS __attribute__((address_space(3)))
typedef unsigned short bf16_t;
typedef short bf16x8 __attribute__((ext_vector_type(8)));
typedef float f32x4 __attribute__((ext_vector_type(4)));
typedef unsigned u32x4 __attribute__((ext_vector_type(4)));
constexpr int BM = 256, BK = 64, HALF = 128, HTB = HALF * BK * 2  , STAGE_BYTES = 8 * HTB, NXCD = 8, WGM = 8;

__host__ __device__ __forceinline__ int lds_byte(int r, int c) { const int st = (r >> 4) * 2 + (c >> 5), rr = r & 15, cc = c & 31, ob = rr * 64 + cc * 2; return st * 1024 + (ob ^ (((ob >> 9) & 1) << 5)); }
__host__ __device__ __forceinline__ void stage_rc(int b, int& R, int& C) { const int st = b / 1024, sb = b % 1024, swz = sb ^ (((sb >> 9) & 1) << 5); R = (st >> 1) * 16 + swz / 64; C = (st & 1) * 32 + (swz % 64) / 2; }
__host__ __device__ __forceinline__ int perm32(int rho) { const int n = rho >> 4, i = rho & 15; return 8 * (i >> 2) + 4 * n + (i & 3); }

struct Unit { int pm, pn, pb, e, l0, ui; };
struct Gemm { const bf16_t* A; const bf16_t* Bt; int K; };

struct StaticOrder {
    int nM, nN, nwg, G, c;
    __device__ void init(int nM_, int nN_, int G_, int c_) { nM = nM_; nN = nN_; nwg = nM * nN; G = G_; c = c_; }
    __device__ bool next(int i, Unit& u) const {
        const long L = (long)i * G + c; if (L >= nwg) return false;
        int wgid = (int)L; { const int q = nwg / NXCD, r = nwg % NXCD, xcd = wgid % NXCD, off = wgid / NXCD; wgid = (xcd < r ? xcd * (q + 1) : r * (q + 1) + (xcd - r) * q) + off; }
        const int nig = WGM * nN, gid = wgid / nig, fm = gid * WGM, gsz = (nM - fm) < WGM ? (nM - fm) : WGM;
        u.pm = fm + ((wgid % nig) % gsz); u.pn = (wgid % nig) / gsz; u.pb = u.pn; u.e = 0; u.l0 = 0; u.ui = i; return true;
    }
};
struct GroupOrder {
    StaticOrder so; const PG8_LAS int* s_base; const int* tlist; const PG8_LAS unsigned short* toks;
    __device__ bool next(int i, Unit& u) const { if (!so.next(i, u)) return false; const int e = s_base[64 + u.pm]; u.e = e; u.l0 = u.pm * 256 - s_base[e]; u.pb = e * so.nN + u.pn; return true; }
    __device__ __forceinline__ int row_token(int ui, int r) const { return (int)toks[ui * 256 + r]; }
    __device__ __forceinline__ void stage_tokens(PG8_LAS unsigned short* dst, int tid, int nthreads) const {
        Unit u;
        for (int ui = 0; so.next(ui, u); ++ui) {
            const int e = s_base[64 + u.pm], l0 = u.pm * 256 - s_base[e], nval = s_base[32 + e] - l0;
            for (int r = tid; r < 256; r += nthreads) dst[ui * 256 + r] = (unsigned short)(r < nval ? tlist[(size_t)e * 32768 + l0 + r] : 0);
        }
    }
};

template <class Epi, class Sched, bool ALIGN_EPI = true, bool GATHER = false>
__device__ __forceinline__ void gemm_phase(PG8_LAS unsigned char* lds, const Gemm g, const Sched& S, const Epi& E, const int wave_id) {
    int lane; asm volatile("v_mbcnt_lo_u32_b32 %0, -1, 0\n\tv_mbcnt_hi_u32_b32 %0, -1, %0" : "=&v"(lane));
    const int wid = wave_id, tid = wid * 64 + lane, wr = wid >> 2, wc = wid & 3, fr = lane & 15, fq = lane >> 4;
    const int K = g.K, nt = K / BK;
    unsigned voffA[2], voffB[2];
#pragma unroll
    for (int i = 0; i < 2; ++i) { int R, C; stage_rc(tid * 16 + i * 8192, R, C); const int Rb = Epi::PERM ? ((R & ~31) + perm32(R & 31)) : R;
        voffA[i] = (unsigned)(R * K + C) * 2u; voffB[i] = (unsigned)(Rb * K + C) * 2u; }
    const size_t kstep = (size_t)(BK * 2);
    const size_t hstep = (size_t)HALF * K * 2;
    const size_t tstep = 2 * hstep;
    const unsigned ldsw = (unsigned)wid * 1024u;
    const int aoff = lds_byte(wr * 64 + fr, fq * 8), boff = lds_byte(wc * 32 + fr, fq * 8);
#define PG8_SA(b, h) (((b) * 2 + (h)) * HTB)
#define PG8_SB(b, h) ((4 + (b) * 2 + (h)) * HTB)
#define PG8_STAGE(bufoff, gbase, voff) do { _Pragma("unroll") for (int _i = 0; _i < 2; ++_i) \
        __builtin_amdgcn_global_load_lds((const unsigned*)((const char*)(gbase) + (voff)[_i]), (PG8_LAS unsigned*)(lds + (bufoff) + ldsw + _i * 8192), 16, 0, 0); } while (0)
#define PG8_STAGE_A(bufoff, gbase, half, usenext) do { if constexpr (GATHER) { _Pragma("unroll") for (int _i = 0; _i < 2; ++_i) \
        __builtin_amdgcn_global_load_lds((const unsigned*)((const char*)(gbase) + ((usenext) ? (((gnp[_i] >> (16 * (half))) & 0xffffu) * (unsigned)(K * 2) + (ga[half][_i] & (unsigned)(K * 2 - 1))) : ga[half][_i])), (PG8_LAS unsigned*)(lds + (bufoff) + ldsw + _i * 8192), 16, 0, 0); } \
        else { PG8_STAGE(bufoff, (gbase) + (half) * hstep, voffA); } } while (0)
#define PG8_LDA(dst, b, h) do { _Pragma("unroll") for (int m = 0; m < 4; ++m) _Pragma("unroll") for (int k = 0; k < 2; ++k) dst[m][k] = *(const PG8_LAS bf16x8*)(lds + PG8_SA(b, h) + aoff + m * 2048 + k * 1024); } while (0)
#define PG8_LDB(dst, b, h) do { _Pragma("unroll") for (int n = 0; n < 2; ++n) _Pragma("unroll") for (int k = 0; k < 2; ++k) dst[n][k] = *(const PG8_LAS bf16x8*)(lds + PG8_SB(b, h) + boff + n * 2048 + k * 1024); } while (0)
#define PG8_MMA(ai, bj, At, Bt) do { __builtin_amdgcn_s_setprio(1); _Pragma("unroll") for (int m = 0; m < 4; ++m) _Pragma("unroll") for (int n = 0; n < 2; ++n) _Pragma("unroll") for (int k = 0; k < 2; ++k) \
        acc[ai][bj][m][n] = __builtin_amdgcn_mfma_f32_16x16x32_bf16(Bt[n][k], At[m][k], acc[ai][bj][m][n], 0, 0, 0); __builtin_amdgcn_s_setprio(0); } while (0)
#define PG8_WAIT_V(n) asm volatile("s_waitcnt vmcnt(" #n ")" ::: "memory")
#define PG8_WAIT_L(n) asm volatile("s_waitcnt lgkmcnt(" #n ")" ::: "memory")
#define PG8_BAR __builtin_amdgcn_s_barrier()
#define PG8_SCHED __builtin_amdgcn_sched_barrier(0)
    Unit cur, nxt; int ui = 0;
    if (!S.next(0, cur)) return;
    f32x4 acc[2][2][4][2];
#pragma unroll
    for (int a = 0; a < 2; ++a)
#pragma unroll
        for (int b = 0; b < 2; ++b)
#pragma unroll
            for (int m = 0; m < 4; ++m)
#pragma unroll
                for (int n = 0; n < 2; ++n) acc[a][b][m][n] = (f32x4){0.f, 0.f, 0.f, 0.f};
    bf16x8 At[4][2], B0[2][2], B1[2][2];
    const char* cA = (const char*)g.A + (GATHER ? (size_t)0 : (size_t)cur.pm * tstep); const char* cB = (const char*)g.Bt + (size_t)cur.pb * tstep;
    unsigned ga[2][2], gnp[2];
    if constexpr (GATHER) {
#pragma unroll
        for (int i = 0; i < 2; ++i) { int R, C; stage_rc(tid * 16 + i * 8192, R, C);
            const unsigned t0 = (unsigned)S.row_token(0, R), t1 = (unsigned)S.row_token(0, 128 + R);
            ga[0][i] = t0 * (unsigned)(K * 2) + (unsigned)(C * 2); ga[1][i] = t1 * (unsigned)(K * 2) + (unsigned)(C * 2); gnp[i] = t0 | (t1 << 16); }
    }
    PG8_STAGE(PG8_SB(0, 0), cB, voffB); PG8_STAGE(PG8_SB(0, 1), cB + hstep, voffB); PG8_STAGE_A(PG8_SA(0, 0), cA, 0, false); PG8_STAGE_A(PG8_SA(0, 1), cA, 1, false);
    if (wr == 1) PG8_BAR;
    PG8_WAIT_V(2); PG8_BAR;
    PG8_STAGE(PG8_SB(1, 0), cB + kstep, voffB); PG8_STAGE_A(PG8_SA(1, 0), cA + kstep, 0, false); PG8_STAGE(PG8_SB(1, 1), cB + hstep + kstep, voffB);
    PG8_WAIT_V(6); PG8_BAR;
    for (;;) {
        const bool has_next = S.next(ui + 1, nxt);
        if constexpr (GATHER) {
            if (has_next) {
                int ln2_; asm volatile("v_mbcnt_lo_u32_b32 %0, -1, 0\n\tv_mbcnt_hi_u32_b32 %0, -1, %0" : "=&v"(ln2_)); const int tid2_ = wid * 64 + ln2_;
#pragma unroll
                for (int i = 0; i < 2; ++i) { int R, C; stage_rc(tid2_ * 16 + i * 8192, R, C); gnp[i] = (unsigned)S.row_token(ui + 1, R) | ((unsigned)S.row_token(ui + 1, 128 + R) << 16); }
            }
        }
        const char* nA = (has_next && !GATHER) ? (const char*)g.A + (size_t)nxt.pm * tstep : cA; const char* nB = has_next ? (const char*)g.Bt + (size_t)nxt.pb * tstep : cB;
        for (int t = 0; t < nt; t += 2) {
            const bool last = (t == nt - 2);
            const char* a1 = cA + (size_t)(t + 1) * kstep;
            const char* a2 = last ? nA : cA + (size_t)(t + 2) * kstep; const char* b2 = last ? nB : cB + (size_t)(t + 2) * kstep;
            const char* a3 = a2 + kstep; const char* b3 = b2 + kstep;
            PG8_LDB(B0, 0, 0); PG8_LDB(B1, 0, 1); PG8_SCHED; PG8_LDA(At, 0, 0); PG8_STAGE_A(PG8_SA(1, 1), a1, 1, false);
            PG8_WAIT_V(8); PG8_WAIT_L(0); PG8_BAR; PG8_MMA(0, 0, At, B0); PG8_MMA(0, 1, At, B1); PG8_BAR; PG8_SCHED;
            PG8_LDA(At, 0, 1); PG8_STAGE(PG8_SB(0, 0), b2, voffB); PG8_STAGE(PG8_SB(0, 1), b2 + hstep, voffB); PG8_STAGE_A(PG8_SA(0, 0), a2, 0, last);
            PG8_WAIT_V(8); PG8_WAIT_L(0); PG8_BAR; PG8_MMA(1, 0, At, B0); PG8_MMA(1, 1, At, B1); PG8_BAR; PG8_SCHED;
            PG8_LDB(B0, 1, 0); PG8_LDB(B1, 1, 1); PG8_SCHED; PG8_LDA(At, 1, 0); PG8_STAGE_A(PG8_SA(0, 1), a2, 1, last);
            PG8_WAIT_V(8); PG8_WAIT_L(0); PG8_BAR; PG8_MMA(0, 0, At, B0); PG8_MMA(0, 1, At, B1); PG8_BAR; PG8_SCHED;
            PG8_LDA(At, 1, 1); PG8_STAGE(PG8_SB(1, 0), b3, voffB); PG8_STAGE(PG8_SB(1, 1), b3 + hstep, voffB); PG8_STAGE_A(PG8_SA(1, 0), a3, 0, last);
            PG8_WAIT_V(8); PG8_WAIT_L(0); PG8_BAR; PG8_MMA(1, 0, At, B0); PG8_MMA(1, 1, At, B1); PG8_BAR; PG8_SCHED;
        }
        if constexpr (ALIGN_EPI) { if (wr == 0) PG8_BAR; }
        { int ln_; asm volatile("v_mbcnt_lo_u32_b32 %0, -1, 0\n\tv_mbcnt_hi_u32_b32 %0, -1, %0" : "=&v"(ln_)); E(acc, cur, wr, wc, ln_ & 15, ln_ >> 4); }
        if (!has_next) break;
#pragma unroll
        for (int a = 0; a < 2; ++a)
#pragma unroll
            for (int b = 0; b < 2; ++b)
#pragma unroll
                for (int m = 0; m < 4; ++m)
#pragma unroll
                    for (int n = 0; n < 2; ++n) acc[a][b][m][n] = (f32x4){0.f, 0.f, 0.f, 0.f};
        cur = nxt; cA = nA; cB = nB; ++ui;
        if constexpr (GATHER) {
#pragma unroll
            for (int h = 0; h < 2; ++h)
#pragma unroll
                for (int i = 0; i < 2; ++i) ga[h][i] = ((gnp[i] >> (16 * h)) & 0xffffu) * (unsigned)(K * 2) + (ga[h][i] & (unsigned)(K * 2 - 1));
        }
        if constexpr (ALIGN_EPI) { if (wr == 1) PG8_BAR; }
    }
    PG8_WAIT_V(0);
    if constexpr (!ALIGN_EPI) { if (wr == 0) PG8_BAR; }
    PG8_BAR;
#undef PG8_SA
#undef PG8_SB
#undef PG8_STAGE
#undef PG8_STAGE_A
#undef PG8_LDA
#undef PG8_LDB
#undef PG8_MMA
#undef PG8_WAIT_V
#undef PG8_WAIT_L
#undef PG8_BAR
#undef PG8_SCHED
}
}
namespace mk {
constexpr int NB = 16, S = 2048, T = NB * S, D = 1024, NCOL = 2304, NE = 16, FF = 512;
constexpr float ALPHA = 1.4142135623730951f, LN_EPS = 1e-5f, LOG2E = 1.4426950408889634f;
constexpr int NWAVES = 8, NTHREADS = 512;
constexpr int MAXROWS = 69632;
constexpr int MAXTILES = 272;

constexpr size_t MiB = 1u << 20;
constexpr size_t WS_CTL = 0, CTL_ZERO_BYTES = 1 * MiB;
constexpr size_t WS_ROPE = 1 * MiB;
constexpr size_t WS_TOKE = WS_ROPE + 256 * 1024;
constexpr size_t WS_TOKG = WS_TOKE + 256 * 1024;
constexpr size_t WS_TOKP = WS_TOKG + 256 * 1024;
constexpr size_t WS_STATS = 2 * MiB;
constexpr size_t WS_LSE = 3 * MiB;
constexpr size_t WS_WPT = 6 * MiB;
constexpr size_t WS_WST = 6 * MiB + 64 * 1024;
constexpr size_t WS_RWQ = 6 * MiB + 512 * 1024;
constexpr size_t WS_CR = 6 * MiB + 768 * 1024;
constexpr size_t WS_C1P = 7 * MiB;
constexpr size_t WS_C2P = 7 * MiB + 256 * 1024;
constexpr size_t WS_WIN = 8 * MiB, WS_WOUT = 17 * MiB, WS_WGU = 21 * MiB, WS_WDN = 85 * MiB;
constexpr size_t WS_Y1B = 117 * MiB;
constexpr size_t WS_TLIST = 181 * MiB;
constexpr size_t WS_GLIST = 183 * MiB;
constexpr size_t WS_YB = 245 * MiB;
constexpr size_t WS_HB = 381 * MiB;
constexpr size_t WS_Q = 117 * MiB, WS_K = 149 * MiB, WS_V = 181 * MiB, WS_U = 213 * MiB, WS_G = 229 * MiB, WS_Z = 245 * MiB;
constexpr size_t WS_PO = 261 * MiB;
constexpr size_t WS_CC = 445 * MiB;
constexpr size_t WS_END = 509 * MiB;
constexpr int CW_CNT = 64;
constexpr int CW_BAR = 4096;

constexpr int RING_BYTES = 131072;
constexpr int MISC_OFF = RING_BYTES + 320;
constexpr int TAB_OFF = RING_BYTES + 1024;
constexpr int LDS_BYTES = 147456;

#define GAS __attribute__((address_space(1)))
#define LAS __attribute__((address_space(3)))
typedef unsigned short bf16;
typedef unsigned v4u __attribute__((ext_vector_type(4)));
typedef unsigned v2u __attribute__((ext_vector_type(2)));
typedef float f32x4 __attribute__((ext_vector_type(4)));
typedef float f32x2 __attribute__((ext_vector_type(2)));
typedef float f32x16 __attribute__((ext_vector_type(16)));
typedef short bf16x8 __attribute__((ext_vector_type(8)));
typedef short s16x4 __attribute__((ext_vector_type(4)));
typedef __bf16 bf16x2_t __attribute__((ext_vector_type(2)));
typedef GAS unsigned gu32;
#define RLX_AGENT __ATOMIC_RELAXED, __HIP_MEMORY_SCOPE_AGENT
#define LDS_WAIT() asm volatile("s_waitcnt lgkmcnt(0)" ::: "memory")

__device__ __forceinline__ unsigned pk2(float lo, float hi) { f32x2 v = {lo, hi}; bf16x2_t r = __builtin_convertvector(v, bf16x2_t); return __builtin_bit_cast(unsigned, r); }
__device__ __forceinline__ float bflo(unsigned u) { return __builtin_bit_cast(float, u << 16); }
__device__ __forceinline__ float bfhi(unsigned u) { return __builtin_bit_cast(float, u & 0xffff0000u); }
__device__ __forceinline__ float wave_sum(float v) {
#pragma unroll
    for (int o = 1; o < 64; o <<= 1) v += __shfl_xor(v, o);
    return v;
}
__device__ __forceinline__ float fast_exp2(float x) { return __builtin_amdgcn_exp2f(x); }
__device__ __forceinline__ float fast_rcp(float x) { return __builtin_amdgcn_rcpf(x); }
__device__ __forceinline__ float gelu_t(float x) {
    const float y = x * (1.5957691216057308f + 0.07135481627159498f * x * x);
    return x * fast_rcp(1.0f + fast_exp2(-LOG2E * y));
}
__device__ __forceinline__ float silu_f(float x) { return x * fast_rcp(1.0f + fast_exp2(-LOG2E * x)); }
__device__ __forceinline__ int crow(int reg, int h) { return (reg & 3) + 8 * (reg >> 2) + 4 * h; }

#define XB_TMO      128
#define XB_XCNT(j)  (256  + 64 * (j))
#define XB_XSUB(j)  (1280 + 64 * (j))
#define XB_XGEN(j)  (2304 + 64 * (j))
#define XB_TOP      3328
#define XB_TOPGEN   3392
#define XCD_BAR_WORDS 3456
#define XB_SPIN_CAP (1u << 22)
__device__ __forceinline__ unsigned xb_ld(unsigned* p)              { return __hip_atomic_load(p, __ATOMIC_RELAXED, __HIP_MEMORY_SCOPE_AGENT); }
__device__ __forceinline__ unsigned xb_add(unsigned* p, unsigned v) { return __hip_atomic_fetch_add(p, v, __ATOMIC_RELAXED, __HIP_MEMORY_SCOPE_AGENT); }
__device__ __forceinline__ unsigned xb_xcc_id() { return (unsigned)__builtin_amdgcn_s_getreg((3 << 11) | 20) & 0xFu; }
#define XB_SPIN(cond, bar) do { unsigned _sp = 0; while (cond) { __builtin_amdgcn_s_sleep(1); \
    if ((++_sp & 255u) == 0u) { if (xb_ld(&(bar)[XB_TMO])) break; if (_sp > XB_SPIN_CAP) { atomicAdd(&(bar)[XB_TMO], 1u); break; } } } } while (0)
struct XcdBarrier { unsigned* bar; unsigned x; volatile LAS unsigned* st; };
__device__ __forceinline__ XcdBarrier xcd_barrier_post(unsigned* bar, volatile LAS unsigned* st, int tid) {
    XcdBarrier b; b.bar = bar; b.x = xb_xcc_id(); b.st = st;
    if (tid == 0) (void)xb_add(&bar[XB_XCNT(b.x)], 1u);
    return b;
}
__device__ __forceinline__ void xcd_barrier_complete(unsigned* bar, unsigned x, unsigned& nloc, unsigned& nx) {
    const unsigned G = gridDim.x * gridDim.y * gridDim.z;
    unsigned sum, cnt, mine, sp = 0u;
    for (;;) {
        sum = 0u; cnt = 0u; mine = 0u;
#pragma unroll
        for (unsigned j = 0; j < 16; ++j) { const unsigned c = xb_ld(&bar[XB_XCNT(j)]); sum += c; cnt += (c > 0u) ? 1u : 0u; mine = (j == x) ? c : mine; }
        if (sum == G) break;
        __builtin_amdgcn_s_sleep(1);
        if ((++sp & 255u) == 0u) { if (xb_ld(&bar[XB_TMO])) break; if (sp > XB_SPIN_CAP) { atomicAdd(&bar[XB_TMO], 1u); break; } }
    }
    nloc = mine > 0u ? mine : 1u; nx = cnt > 0u ? cnt : 1u;
}
__device__ __forceinline__ void xcd_barrier(const XcdBarrier& b, int tid) {
    asm volatile("s_waitcnt vmcnt(0)" ::: "memory");
    __syncthreads();
    if (tid == 0) {
        unsigned* bar = b.bar;
        __builtin_amdgcn_s_waitcnt(0);
        unsigned nloc = b.st[0], nx = b.st[1];
        if (nloc == 0u) { xcd_barrier_complete(bar, b.x, nloc, nx); b.st[0] = nloc; b.st[1] = nx; }
        const unsigned old = xb_add(&bar[XB_XSUB(b.x)], 1u);
        const unsigned gen = old / nloc;
        if (old + 1u == (gen + 1u) * nloc) {
            __builtin_amdgcn_fence(__ATOMIC_RELEASE, "agent");
            asm volatile("s_waitcnt vmcnt(0)" ::: "memory");
            const unsigned og = xb_add(&bar[XB_TOP], 1u);
            const unsigned tg = og / nx;
            if (og + 1u == (tg + 1u) * nx) xb_add(&bar[XB_TOPGEN], 1u);
            else XB_SPIN(xb_ld(&bar[XB_TOPGEN]) == tg, bar);
            __builtin_amdgcn_fence(__ATOMIC_ACQUIRE, "agent");
            xb_add(&bar[XB_XGEN(b.x)], 1u);
            asm volatile("s_waitcnt vmcnt(0)" ::: "memory");
        } else {
            XB_SPIN(xb_ld(&bar[XB_XGEN(b.x)]) == gen, bar);
            __builtin_amdgcn_fence(__ATOMIC_ACQUIRE, "agent");
            asm volatile("s_waitcnt vmcnt(0)" ::: "memory");
        }
    }
    __syncthreads();
}

#ifdef NO_FENCE
#define EPI_FENCE() do {} while (0)
#else
#define EPI_FENCE() asm volatile("" ::: "memory")
#endif
using pg8::Unit;
struct EpiProj {
    static constexpr bool PERM = true;
    unsigned char* ws; const float *lg, *lb;
    static __device__ __forceinline__ void store16(bf16* dst, const f32x4 (&v)[2]) {
        v4u w; w.x = pk2(v[0][0], v[0][1]); w.y = pk2(v[0][2], v[0][3]); w.z = pk2(v[1][0], v[1][1]); w.w = pk2(v[1][2], v[1][3]);
        *(v4u*)dst = w;
    }
    template <int MODE>
    __device__ __forceinline__ void run(const f32x4 (&acc)[2][2][4][2], const Unit& u, int wr, int wc, int fr, int fq) const {
        const int pn = u.pn;
        const int rowb = u.pm * 256 + wr * 64 + fr;
        bf16* dbase; int cstep = 128, rstride = 512;
        if (MODE == 0) dbase = (bf16*)(ws + (pn < 2 ? WS_Q : WS_K)) + (pn & 1) * 256 + wc * 32 + 8 * fq;
        else if (MODE == 1) { if (pn < 6) dbase = (bf16*)(ws + WS_V) + (pn - 4) * 256 + wc * 32 + 8 * fq; else { dbase = (bf16*)(ws + WS_Z) + wc * 32 + 8 * fq; rstride = 256; } }
        else if (MODE == 2) { dbase = (bf16*)(ws + WS_U) + wc * 32 + 8 * fq; rstride = 256; }
        else { dbase = (bf16*)(ws + WS_G) + wc * 64 + 8 * fq; rstride = 256; cstep = 32; }
        const bool dorope = ((wc & 1) == 0) && (fq < 2);
        const float sc = pn < 2 ? 0.125f : 1.0f;
        const float* rope = (const float*)(ws + WS_ROPE) + (size_t)(4 * (fq & 1)) * 2;
        f32x4 rc[4][2];
        if (MODE == 0) {
#pragma unroll
            for (int g = 0; g < 4; ++g) { const int pos = (rowb + (g >> 2) * 128 + (g & 3) * 16) & (S - 1);
                rc[g][0] = *(const f32x4*)(rope + (size_t)pos * 16); rc[g][1] = *(const f32x4*)(rope + (size_t)pos * 16 + 4); }
        }
        f32x4 lgv[2][2], lbv[2][2];
        if (MODE == 3) {
#pragma unroll
            for (int bj = 0; bj < 2; ++bj)
#pragma unroll
                for (int n = 0; n < 2; ++n) { const int dim = wc * 64 + 32 * bj + 8 * fq + 4 * n; lgv[bj][n] = *(const f32x4*)(lg + dim); lbv[bj][n] = *(const f32x4*)(lb + dim); }
        }
#pragma unroll
        for (int g = 0; g < 8; ++g) {
            const int ai = g >> 2, m = g & 3;
            const int row = rowb + ai * 128 + m * 16;
            f32x4 v[2][2];
#pragma unroll
            for (int bj = 0; bj < 2; ++bj)
#pragma unroll
                for (int n = 0; n < 2; ++n) v[bj][n] = acc[ai][bj][m][n];
            if (MODE == 0) {
                const f32x4 cs0 = rc[g & 3][0], cs1 = rc[g & 3][1];
                if (g + 4 < 8) { const int pos = (rowb + ((g + 4) >> 2) * 128 + ((g + 4) & 3) * 16) & (S - 1);
                    rc[g & 3][0] = *(const f32x4*)(rope + (size_t)pos * 16); rc[g & 3][1] = *(const f32x4*)(rope + (size_t)pos * 16 + 4); }
                if (dorope) {
#pragma unroll
                    for (int bj = 0; bj < 2; ++bj) {
                        float a, b;
                        a = v[bj][0][0]; b = v[bj][0][1]; v[bj][0][0] = a * cs0[0] - b * cs0[1]; v[bj][0][1] = b * cs0[0] + a * cs0[1];
                        a = v[bj][0][2]; b = v[bj][0][3]; v[bj][0][2] = a * cs0[2] - b * cs0[3]; v[bj][0][3] = b * cs0[2] + a * cs0[3];
                        a = v[bj][1][0]; b = v[bj][1][1]; v[bj][1][0] = a * cs1[0] - b * cs1[1]; v[bj][1][1] = b * cs1[0] + a * cs1[1];
                        a = v[bj][1][2]; b = v[bj][1][3]; v[bj][1][2] = a * cs1[2] - b * cs1[3]; v[bj][1][3] = b * cs1[2] + a * cs1[3];
                    }
                }
#pragma unroll
                for (int bj = 0; bj < 2; ++bj)
#pragma unroll
                    for (int n = 0; n < 2; ++n) v[bj][n] = v[bj][n] * sc;
            }
            if (MODE == 2 || MODE == 3) {
#pragma unroll
                for (int bj = 0; bj < 2; ++bj)
#pragma unroll
                    for (int n = 0; n < 2; ++n)
#pragma unroll
                        for (int e = 0; e < 4; ++e) v[bj][n][e] = gelu_t(v[bj][n][e]);
            }
            if (MODE == 3) {
                float s = 0.f;
#pragma unroll
                for (int bj = 0; bj < 2; ++bj)
#pragma unroll
                    for (int n = 0; n < 2; ++n) s += (v[bj][n][0] + v[bj][n][1]) + (v[bj][n][2] + v[bj][n][3]);
                s += __shfl_xor(s, 16); s += __shfl_xor(s, 32);
                const float mu = s * (1.0f / 64.0f); float q = 0.f;
#pragma unroll
                for (int bj = 0; bj < 2; ++bj)
#pragma unroll
                    for (int n = 0; n < 2; ++n)
#pragma unroll
                        for (int e = 0; e < 4; ++e) { v[bj][n][e] -= mu; q += v[bj][n][e] * v[bj][n][e]; }
                q += __shfl_xor(q, 16); q += __shfl_xor(q, 32);
                const float rstd = rsqrtf(q * (1.0f / 64.0f) + LN_EPS);
#pragma unroll
                for (int bj = 0; bj < 2; ++bj)
#pragma unroll
                    for (int n = 0; n < 2; ++n) v[bj][n] = v[bj][n] * rstd * lgv[bj][n] + lbv[bj][n];
            }
            bf16* dst = dbase + (size_t)row * rstride;
            store16(dst, v[0]); store16(dst + cstep, v[1]);
            EPI_FENCE();
        }
    }
    __device__ __forceinline__ void operator()(const f32x4 (&acc)[2][2][4][2], const Unit& u, int wr, int wc, int fr, int fq) const {
        const int pn = u.pn;
        if (pn < 4) run<0>(acc, u, wr, wc, fr, fq);
        else if (pn == 6) run<2>(acc, u, wr, wc, fr, fq);
        else if (pn == 7) run<3>(acc, u, wr, wc, fr, fq);
        else run<1>(acc, u, wr, wc, fr, fq);
    }
};
struct EpiOutB {
    static constexpr bool PERM = true;
    const bf16* xres; bf16* Y;
    __device__ __forceinline__ void operator()(const f32x4 (&acc)[2][2][4][2], const Unit& u, int wr, int wc, int fr, int fq) const {
        const size_t off0 = (size_t)(u.pm * 256 + wr * 64 + fr) * D + u.pn * 256 + wc * 32 + 8 * fq;
        v4u xr[4][2];
#pragma unroll
        for (int g = 0; g < 4; ++g) { const size_t off = off0 + (size_t)((g >> 2) * 128 + (g & 3) * 16) * D; xr[g][0] = *(const v4u*)(xres + off); xr[g][1] = *(const v4u*)(xres + off + 128); }
#pragma unroll
        for (int g = 0; g < 8; ++g) {
            const int ai = g >> 2, m = g & 3;
            const size_t off = off0 + (size_t)(ai * 128 + m * 16) * D;
            const v4u x0 = xr[g & 3][0], x1 = xr[g & 3][1];
            if (g + 4 < 8) { const size_t offn = off0 + (size_t)(((g + 4) >> 2) * 128 + ((g + 4) & 3) * 16) * D; xr[g & 3][0] = *(const v4u*)(xres + offn); xr[g & 3][1] = *(const v4u*)(xres + offn + 128); }
#pragma unroll
            for (int bj = 0; bj < 2; ++bj) {
                const v4u x = bj ? x1 : x0;
                const f32x4 a = acc[ai][bj][m][0], b = acc[ai][bj][m][1];
                v4u w; w.x = pk2(a[0] + ALPHA * bflo(x.x), a[1] + ALPHA * bfhi(x.x)); w.y = pk2(a[2] + ALPHA * bflo(x.y), a[3] + ALPHA * bfhi(x.y));
                w.z = pk2(b[0] + ALPHA * bflo(x.z), b[1] + ALPHA * bfhi(x.z)); w.w = pk2(b[2] + ALPHA * bflo(x.w), b[3] + ALPHA * bfhi(x.w));
                *(v4u*)(Y + off + bj * 128) = w;
            }
            EPI_FENCE();
        }
    }
};
struct EpiGU {
    static constexpr bool PERM = true;
    unsigned char* ws; const LAS unsigned short* toks; int l;
    __device__ __forceinline__ void operator()(const f32x4 (&acc)[2][2][4][2], const Unit& u, int wr, int wc, int fr, int fq) const {
        const int cb = u.e * 1024 + u.pn * 256 + wc * 32 + 8 * fq;
        bf16* H = (bf16*)(ws + WS_HB); const float* stats = (const float*)(ws + WS_STATS);
        const float* c1a = (const float*)(ws + WS_C1P) + (size_t)l * 16 * 1024; const float* c1b = c1a + 32 * 1024; const float* c2a = c1a + 65536; const float* c2b = c2a + 32 * 1024;
        float c1[2][8], c2[2][8];
#pragma unroll
        for (int bj = 0; bj < 2; ++bj)
#pragma unroll
            for (int n = 0; n < 2; ++n) {
                const f32x4 a = *(const f32x4*)(c1a + cb + bj * 128 + 4 * n), b = *(const f32x4*)(c1b + cb + bj * 128 + 4 * n);
                const f32x4 c = *(const f32x4*)(c2a + cb + bj * 128 + 4 * n), d = *(const f32x4*)(c2b + cb + bj * 128 + 4 * n);
#pragma unroll
                for (int e = 0; e < 4; ++e) { c1[bj][4 * n + e] = a[e] + b[e]; c2[bj][4 * n + e] = c[e] + d[e]; }
            }
        f32x2 stv[4];
#pragma unroll
        for (int g = 0; g < 4; ++g) { const int tok = (int)toks[u.ui * 256 + wr * 64 + g * 16 + fr]; stv[g] = *(const f32x2*)(stats + 2 * (size_t)tok); }
#pragma unroll
        for (int ai = 0; ai < 2; ++ai)
#pragma unroll
            for (int m = 0; m < 4; ++m) {
                const int rl = ai * 128 + wr * 64 + m * 16 + fr;
                const f32x2 st = stv[m];
                if (ai == 0) { const int tok = (int)toks[u.ui * 256 + 128 + wr * 64 + m * 16 + fr]; stv[m] = *(const f32x2*)(stats + 2 * (size_t)tok); }
                float hv[8];
#pragma unroll
                for (int n = 0; n < 2; ++n)
#pragma unroll
                    for (int e = 0; e < 4; ++e) {
                        const float g = st.y * (acc[ai][0][m][n][e] - st.x * c1[0][4 * n + e]) + c2[0][4 * n + e];
                        const float up = st.y * (acc[ai][1][m][n][e] - st.x * c1[1][4 * n + e]) + c2[1][4 * n + e];
                        hv[4 * n + e] = silu_f(g) * up;
                    }
                v4u w; w.x = pk2(hv[0], hv[1]); w.y = pk2(hv[2], hv[3]); w.z = pk2(hv[4], hv[5]); w.w = pk2(hv[6], hv[7]);
                *(v4u*)(H + (size_t)(u.pm * 256 + rl) * FF + u.pn * 128 + wc * 32 + 8 * fq) = w;
                EPI_FENCE();
            }
    }
};
struct EpiDown {
    static constexpr bool PERM = true;
    bf16* Y; const float* glist; const LAS int* s_cntx;
    __device__ __forceinline__ void operator()(const f32x4 (&acc)[2][2][4][2], const Unit& u, int wr, int wc, int fr, int fq) const {
        const int nval = s_cntx[u.e] - u.l0;
        float gv[8];
#pragma unroll
        for (int g = 0; g < 8; ++g) { const int rl = (g >> 2) * 128 + wr * 64 + (g & 3) * 16 + fr; gv[g] = rl < nval ? glist[(size_t)u.e * T + u.l0 + rl] : 0.f; }
#pragma unroll
        for (int ai = 0; ai < 2; ++ai)
#pragma unroll
            for (int m = 0; m < 4; ++m) {
                const int rl = ai * 128 + wr * 64 + m * 16 + fr;
                const float g = gv[ai * 4 + m];
#pragma unroll
                for (int bj = 0; bj < 2; ++bj) {
                    const f32x4 a = acc[ai][bj][m][0] * g, b = acc[ai][bj][m][1] * g;
                    v4u w; w.x = pk2(a[0], a[1]); w.y = pk2(a[2], a[3]); w.z = pk2(b[0], b[1]); w.w = pk2(b[2], b[3]);
                    *(v4u*)(Y + (size_t)(u.pm * 256 + rl) * D + u.pn * 256 + bj * 128 + wc * 32 + 8 * fq) = w;
                }
                EPI_FENCE();
            }
    }
};

__device__ __forceinline__ int win_src_col(int n) {
    if (n < 1024) { int t = n & 63; const int hb = n & ~63; if (t < 16) t = (t & 1) ? 8 + (t >> 1) : (t >> 1); return hb + t; }
    if (n >= 1792 && n < 2048) { const int t = n - 1792, bj = t >> 7, wc = (t >> 5) & 3, j = t & 31; return 1792 + 64 * wc + 32 * bj + j; }
    return n;
}
__device__ __forceinline__ void p0_tr_item(const float* cp, int ld, int K, bf16* WT, int k0, int n0, LAS float* scr, int lane) {
#pragma unroll 8
    for (int i = 0; i < 32; ++i) { const int kk = 2 * i + (lane >> 5); scr[kk * 33 + (lane & 31)] = cp[(size_t)(k0 + kk) * ld]; }
    LDS_WAIT(); asm volatile("" ::: "memory");
    const int c = lane & 7;
#pragma unroll
    for (int j = 0; j < 4; ++j) { const int n = (lane >> 3) + 8 * j; const LAS float* s = scr + (8 * c) * 33 + n;
        v4u o; o.x = pk2(s[0 * 33], s[1 * 33]); o.y = pk2(s[2 * 33], s[3 * 33]); o.z = pk2(s[4 * 33], s[5 * 33]); o.w = pk2(s[6 * 33], s[7 * 33]);
        *(v4u*)(WT + (size_t)(n0 + n) * K + k0 + 8 * c) = o; }
    LDS_WAIT(); asm volatile("" ::: "memory");
}
__device__ __forceinline__ void p0_gu_item(const float* cp, int ld, const float* gk, const float* bk, bf16* WT, int n0, int kh, float* c1p, float* c2p, LAS float* scr, int lane) {
    float c1 = 0.f, c2 = 0.f;
    for (int kb = kh * 8; kb < kh * 8 + 8; ++kb) {
        const int k0 = 64 * kb;
#pragma unroll 8
        for (int i = 0; i < 32; ++i) { const int kk = 2 * i + (lane >> 5); const float w = cp[(size_t)(k0 + kk) * ld];
            const float r = bflo(pk2(w * gk[k0 + kk], 0.f)); c1 += r; c2 += bk[k0 + kk] * w; scr[kk * 33 + (lane & 31)] = r; }
        LDS_WAIT(); asm volatile("" ::: "memory");
        const int c = lane & 7;
#pragma unroll
        for (int j = 0; j < 4; ++j) { const int n = (lane >> 3) + 8 * j; const LAS float* sp = scr + (8 * c) * 33 + n;
            v4u o; o.x = pk2(sp[0 * 33], sp[1 * 33]); o.y = pk2(sp[2 * 33], sp[3 * 33]); o.z = pk2(sp[4 * 33], sp[5 * 33]); o.w = pk2(sp[6 * 33], sp[7 * 33]);
            *(v4u*)(WT + (size_t)(n0 + n) * D + k0 + 8 * c) = o; }
        LDS_WAIT(); asm volatile("" ::: "memory");
    }
    c1 += __shfl_xor(c1, 32); c2 += __shfl_xor(c2, 32);
    if (lane < 32) { c1p[n0 + lane] = c1; c2p[n0 + lane] = c2; }
}
struct Ptrs {
    const float *x, *w_in, *w_out, *lg, *lb, *wsp, *bsp, *pw, *psc, *ln1g, *ln1b, *rw, *rb, *wg, *wu, *wd, *ln2g, *ln2b;
    float* out; unsigned char* ws;
};
__device__ __forceinline__ void p0_prologue(const Ptrs& P, LAS unsigned char* lds, int vcu, int G, int wave, int lane, int tid) {
    LAS float* scr = (LAS float*)(lds + wave * 16384);
    const int gw = vcu * NWAVES + wave, NGW = G * NWAVES;
    bf16* WIN = (bf16*)(P.ws + WS_WIN); bf16* WOUT = (bf16*)(P.ws + WS_WOUT); bf16* WGU = (bf16*)(P.ws + WS_WGU); bf16* WDN = (bf16*)(P.ws + WS_WDN);
    constexpr int I_IN = 16 * 72, I_OUT = 16 * 32, I_GU = 2 * 32, I_DN = 8 * 32;
    constexpr int N_IN = 2 * I_IN, N_OUT = 2 * I_OUT, N_GU = 32 * I_GU, N_DN = 32 * I_DN;
    for (int it = gw; it < N_IN + N_OUT + N_GU + N_DN; it += NGW) {
        int r = it;
        if (r < N_IN) { const int l = r / I_IN; r -= l * I_IN; const int kb = r / 72, nb = r % 72;
            const float* cp = P.w_in + (size_t)l * D * NCOL + win_src_col(32 * nb + (lane & 31));
            p0_tr_item(cp, NCOL, D, WIN + (size_t)l * NCOL * D, 64 * kb, 32 * nb, scr, lane); continue; }
        r -= N_IN;
        if (r < N_OUT) { const int l = r / I_OUT; r -= l * I_OUT; const int kb = r / 32, nb = r % 32;
            const float* cp = P.w_out + (size_t)l * D * D + 32 * nb + (lane & 31);
            p0_tr_item(cp, D, D, WOUT + (size_t)l * D * D, 64 * kb, 32 * nb, scr, lane); continue; }
        r -= N_OUT;
        if (r < N_GU) { const int le = r / I_GU; r -= le * I_GU; const int kh = r / 32, nb = r % 32, l = le >> 4;
            const int n = 32 * nb + (lane & 31), pn = n >> 8, t = n & 255;
            const float* cp = (t < 128 ? P.wg : P.wu) + (size_t)le * D * FF + 128 * pn + (t & 127);
            p0_gu_item(cp, FF, P.ln1g + l * D, P.ln1b + l * D, WGU + (size_t)le * 1024 * D, 32 * nb, kh,
                       (float*)(P.ws + WS_C1P) + ((size_t)kh * 32 + le) * 1024, (float*)(P.ws + WS_C2P) + ((size_t)kh * 32 + le) * 1024, scr, lane); continue; }
        r -= N_GU;
        { const int le = r / I_DN; r -= le * I_DN; const int kb = r / 32, nb = r % 32;
            const float* cp = P.wd + (size_t)le * FF * D + 32 * nb + (lane & 31);
            p0_tr_item(cp, D, FF, WDN + (size_t)le * D * FF, 64 * kb, 32 * nb, scr, lane); }
    }
    bf16* XB = (bf16*)(P.ws + WS_HB);
    for (size_t i = (size_t)gw * 64 + lane; i < (size_t)T * D / 8; i += (size_t)NGW * 64) {
        const f32x4 a = *(const f32x4*)(P.x + i * 8), b = *(const f32x4*)(P.x + i * 8 + 4);
        v4u w; w.x = pk2(a[0], a[1]); w.y = pk2(a[2], a[3]); w.z = pk2(b[0], b[1]); w.w = pk2(b[2], b[3]);
        *(v4u*)(XB + i * 8) = w;
    }
    const int gt = vcu * NTHREADS + tid, NGT = G * NTHREADS;
    float* rope = (float*)(P.ws + WS_ROPE);
    for (int i = gt; i < S * 8; i += NGT) { const int pos = i >> 3, k = i & 7;
        const float inv = powf(500000.0f, -(float)k / 8.0f); const float ang = (float)pos * inv;
        rope[2 * i] = cosf(ang); rope[2 * i + 1] = sinf(ang); }
    bf16* WPT = (bf16*)(P.ws + WS_WPT);
    for (int i = gt; i < 2 * 4 * 64 * 64; i += NGT) { const int ii = i & 63, o = (i >> 6) & 63, lgi = i >> 12;
        WPT[i] = (bf16)(pk2(P.pw[((size_t)lgi * 64 + ii) * 64 + o], 0.f) & 0xffffu); }
    bf16* WST = (bf16*)(P.ws + WS_WST);
    for (int i = gt; i < 2 * 4 * 128 * 128; i += NGT) WST[i] = (bf16)(pk2(P.wsp[i], 0.f) & 0xffffu);
    float* RWQ = (float*)(P.ws + WS_RWQ);
    for (int i = gt; i < 2 * 16384; i += NGT) { const int j = i & 3, e = (i >> 2) & 15, kq = (i >> 6) & 255, l = i >> 14; const int k = 4 * kq + j;
        RWQ[i] = P.ln1g[l * D + k] * P.rw[(size_t)k * 16 + e]; }
    float* CR = (float*)(P.ws + WS_CR);
    if (gw < 32) { const int l = gw >> 4, e = gw & 15; float a = 0.f, b = 0.f;
        for (int j = 0; j < 16; ++j) { const int k = lane + 64 * j; const float w = P.rw[(size_t)k * 16 + e]; a += P.ln1g[l * D + k] * w; b += P.ln1b[l * D + k] * w; }
        a = wave_sum(a); b = wave_sum(b);
        if (lane == 0) { CR[l * 32 + e] = a; CR[l * 32 + 16 + e] = b; } }
}

constexpr int KT_STRIDE = 144, VT_STRIDE = 192;
constexpr int ATT_WAVE_LDS = 32 * KT_STRIDE + 32 * VT_STRIDE;
#define MFMA32(a, b, c) __builtin_amdgcn_mfma_f32_32x32x16_bf16((a), (b), (c), 0, 0, 0)
__device__ __forceinline__ s16x4 tr16(LAS unsigned char* p) { return __builtin_amdgcn_ds_read_tr16_b64_v4i16((LAS s16x4*)p); }

__device__ __forceinline__ void attn_task(const bf16* __restrict__ Kb, bf16* __restrict__ POc, float* __restrict__ LSEc, const bf16x8 (&qf)[4],
                                          int b, int h, int dsh, int r, int j0, const LAS unsigned char* vt, int rbase, int lane) {
    const int dil = 1 << dsh, L = S >> dsh;
    const int qi = lane & 31, hh = lane >> 5;
    const size_t brow = (size_t)b * S;
    const size_t qrow = brow + (size_t)(j0 + qi) * dil + r;
    int kb_lo = 2 - (j0 >> 5); if (kb_lo < 0) kb_lo = 0;
    int kb_hi = ((L - j0) >> 5) + 1; if (kb_hi > 4) kb_hi = 4;
    const bf16* kbase = Kb + (brow + r) * 512 + h * 64 + 8 * hh;
    bf16x8 kf[4];
    {
        const size_t off = (size_t)(j0 - 64 + 32 * kb_lo + qi) * dil * 512;
#pragma unroll
        for (int ks = 0; ks < 4; ++ks) kf[ks] = *(const bf16x8*)(kbase + off + 16 * ks);
    }
    f32x16 o0, o1;
#pragma unroll
    for (int i = 0; i < 16; ++i) { o0[i] = 0.f; o1[i] = 0.f; }
    float m = -1e30f, l = 0.f;
    const int q4 = (lane & 15) >> 2, p4 = lane & 3, blk = (lane >> 4) & 1;
    const LAS unsigned char* vrd0 = vt + (rbase + j0 - 64 + 4 * hh + q4) * VT_STRIDE + (16 * blk + 4 * p4) * 2;
    for (int kb = kb_lo; kb <= kb_hi; ++kb) {
        f32x16 st;
#pragma unroll
        for (int i = 0; i < 16; ++i) st[i] = 0.f;
#pragma unroll
        for (int ks = 0; ks < 4; ++ks) st = MFMA32(kf[ks], qf[ks], st);
        if (kb < kb_hi) {
            const size_t off = (size_t)(j0 - 64 + 32 * (kb + 1) + qi) * dil * 512;
#pragma unroll
            for (int ks = 0; ks < 4; ++ks) kf[ks] = *(const bf16x8*)(kbase + off + 16 * ks);
        }
        float mx = -1e30f;
#pragma unroll
        for (int i = 0; i < 16; ++i) { float sv = st[i] * LOG2E; const int kl = crow(i, hh);
            if (kb == 0 && kl < qi) sv = -1e30f;
            if (kb == 4 && kl > qi) sv = -1e30f;
            st[i] = sv; mx = fmaxf(mx, sv); }
        mx = fmaxf(mx, __shfl_xor(mx, 32));
        const float mn = fmaxf(m, mx); const float alpha = fast_exp2(m - mn); m = mn;
        float ps = 0.f;
#pragma unroll
        for (int i = 0; i < 16; ++i) { const float pe = fast_exp2(st[i] - mn); ps += pe; st[i] = pe; }
        l = l * alpha + ps;
        o0 = o0 * alpha; o1 = o1 * alpha;
        bf16x8 pf[2];
#pragma unroll
        for (int sx = 0; sx < 2; ++sx) { v4u w; w.x = pk2(st[8 * sx], st[8 * sx + 1]); w.y = pk2(st[8 * sx + 2], st[8 * sx + 3]); w.z = pk2(st[8 * sx + 4], st[8 * sx + 5]); w.w = pk2(st[8 * sx + 6], st[8 * sx + 7]);
            pf[sx] = __builtin_bit_cast(bf16x8, w); }
        LAS unsigned char* vrd = (LAS unsigned char*)vrd0 + (32 * kb) * VT_STRIDE;
#pragma unroll
        for (int sx = 0; sx < 2; ++sx) {
            { const s16x4 lo = tr16(vrd + (16 * sx) * VT_STRIDE), hi = tr16(vrd + (16 * sx + 8) * VT_STRIDE);
              const bf16x8 vf = __builtin_shufflevector(lo, hi, 0, 1, 2, 3, 4, 5, 6, 7); o0 = MFMA32(vf, pf[sx], o0); }
            { const s16x4 lo = tr16(vrd + (16 * sx) * VT_STRIDE + 64), hi = tr16(vrd + (16 * sx + 8) * VT_STRIDE + 64);
              const bf16x8 vf = __builtin_shufflevector(lo, hi, 0, 1, 2, 3, 4, 5, 6, 7); o1 = MFMA32(vf, pf[sx], o1); }
        }
    }
    l += __shfl_xor(l, 32);
    const float inv = 1.0f / l;
    bf16* op = POc + qrow * 512 + h * 64 + 4 * hh;
#pragma unroll
    for (int g4 = 0; g4 < 4; ++g4) {
        v2u w; w.x = pk2(o0[4 * g4] * inv, o0[4 * g4 + 1] * inv); w.y = pk2(o0[4 * g4 + 2] * inv, o0[4 * g4 + 3] * inv); *(v2u*)(op + 8 * g4) = w;
        v2u w1; w1.x = pk2(o1[4 * g4] * inv, o1[4 * g4 + 1] * inv); w1.y = pk2(o1[4 * g4 + 2] * inv, o1[4 * g4 + 3] * inv); *(v2u*)(op + 32 + 8 * g4) = w1;
    }
    if (hh == 0) LSEc[qrow * 8 + h] = m + __log2f(l);
}
struct AttItem { int dsh, r, j0, rbase; };
__device__ __forceinline__ AttItem att_item(int it, int sp, int wave) {
    AttItem a;
    if (it < 4)      { a.dsh = 0; a.r = 0;      const int js = 1024 * sp + 256 * it; a.j0 = js + 32 * wave; a.rbase = 64 - js; }
    else if (it < 8) { a.dsh = 2; a.r = it - 4; const int js = 256 * sp;             a.j0 = js + 32 * wave; a.rbase = 64 - js; }
    else             { a.dsh = 4; a.r = 4 * (it - 8) + (wave >> 1); a.j0 = 64 * sp + 32 * (wave & 1); a.rbase = 128 * (wave >> 1); }
    return a;
}
__device__ __forceinline__ const bf16* att_vsrc(const bf16* Vb, int it, int sp, size_t brow, int h, int idx) {
    const int rho = idx >> 3, ch = idx & 7;
    if (it < 8) {
        if (rho >= 384) return nullptr;
        const int dsh = it < 4 ? 0 : 2, r = it < 4 ? 0 : it - 4, js = it < 4 ? 1024 * sp + 256 * it : 256 * sp;
        const int j = js - 64 + rho; if (j < 0 || j >= (S >> dsh)) return nullptr;
        return Vb + (brow + ((size_t)j << dsh) + r) * 512 + h * 64 + ch * 8;
    }
    const int sl = rho >> 7, j = rho & 127, r = 4 * (it - 8) + sl;
    return Vb + (brow + (size_t)j * 16 + r) * 512 + h * 64 + ch * 8;
}

__device__ __forceinline__ void p2_attention(const unsigned char* ws, unsigned char* wsw, LAS unsigned char* lds, int vcu, int G, int wave, int lane, int tid) {
    const bf16* Qb = (const bf16*)(ws + WS_Q); const bf16* Kb = (const bf16*)(ws + WS_K); const bf16* Vb = (const bf16*)(ws + WS_V);
    bf16* PO = (bf16*)(wsw + WS_PO); float* LSE = (float*)(wsw + WS_LSE); bf16* CC = (bf16*)(wsw + WS_CC);
    const int qi = lane & 31, hh = lane >> 5;
    for (int item = vcu; item < NB * 8 * 2; item += G) {
        const int sp = item & 1, h = (item >> 1) & 7, b = item >> 4;
        const size_t brow = (size_t)b * S;
        v4u vreg[8];
#pragma unroll
        for (int i = 0; i < 8; ++i) { const bf16* src = att_vsrc(Vb, 0, sp, brow, h, tid + NTHREADS * i); vreg[i] = src ? *(const v4u*)src : (v4u){0u, 0u, 0u, 0u}; }
        bf16x8 qf[4], qn[4];
        { const AttItem a = att_item(0, sp, wave); const bf16* qp = Qb + (brow + ((size_t)(a.j0 + qi) << a.dsh) + a.r) * 512 + h * 64 + 8 * hh;
#pragma unroll
          for (int ks = 0; ks < 4; ++ks) qf[ks] = *(const bf16x8*)(qp + 16 * ks); }
#pragma unroll 1
        for (int it = 0; it < 12; ++it) {
            __syncthreads();
#pragma unroll
            for (int i = 0; i < 8; ++i) { const int idx = tid + NTHREADS * i; *(LAS v4u*)(lds + (idx >> 3) * VT_STRIDE + (idx & 7) * 16) = vreg[i]; }
            __syncthreads();
            const AttItem a = att_item(it, sp, wave);
            if (it < 11) {
#pragma unroll
                for (int i = 0; i < 8; ++i) { const bf16* src = att_vsrc(Vb, it + 1, sp, brow, h, tid + NTHREADS * i); vreg[i] = src ? *(const v4u*)src : (v4u){0u, 0u, 0u, 0u}; }
                const AttItem an = att_item(it + 1, sp, wave); const bf16* qp = Qb + (brow + ((size_t)(an.j0 + qi) << an.dsh) + an.r) * 512 + h * 64 + 8 * hh;
#pragma unroll
                for (int ks = 0; ks < 4; ++ks) qn[ks] = *(const bf16x8*)(qp + 16 * ks);
            }
            const int c = it >> 2;
            attn_task(Kb, PO + (size_t)c * T * 512, LSE + (size_t)c * T * 8, qf, b, h, a.dsh, a.r, a.j0, lds, a.rbase, lane);
#pragma unroll
            for (int ks = 0; ks < 4; ++ks) qf[ks] = qn[ks];
        }
        __syncthreads();
        for (int it = tid; it < 8192; it += NTHREADS) {
            const int pl = it >> 3, ch = it & 7; const size_t row = (size_t)b * S + 1024 * sp + pl;
            const float l0 = LSE[row * 8 + h], l1 = LSE[((size_t)T + row) * 8 + h], l2 = LSE[((size_t)2 * T + row) * 8 + h];
            const float mx = fmaxf(l0, fmaxf(l1, l2));
            float w0 = fast_exp2(l0 - mx), w1 = fast_exp2(l1 - mx), w2 = fast_exp2(l2 - mx);
            const float inv = 1.0f / (w0 + w1 + w2); w0 *= inv; w1 *= inv; w2 *= inv;
            const v4u a = *(const v4u*)(PO + row * 512 + h * 64 + 8 * ch), bq = *(const v4u*)(PO + ((size_t)T + row) * 512 + h * 64 + 8 * ch), cq = *(const v4u*)(PO + ((size_t)2 * T + row) * 512 + h * 64 + 8 * ch);
            v4u o;
            o.x = pk2(w0 * bflo(a.x) + w1 * bflo(bq.x) + w2 * bflo(cq.x), w0 * bfhi(a.x) + w1 * bfhi(bq.x) + w2 * bfhi(cq.x));
            o.y = pk2(w0 * bflo(a.y) + w1 * bflo(bq.y) + w2 * bflo(cq.y), w0 * bfhi(a.y) + w1 * bfhi(bq.y) + w2 * bfhi(cq.y));
            o.z = pk2(w0 * bflo(a.z) + w1 * bflo(bq.z) + w2 * bflo(cq.z), w0 * bfhi(a.z) + w1 * bfhi(bq.z) + w2 * bfhi(cq.z));
            o.w = pk2(w0 * bflo(a.w) + w1 * bflo(bq.w) + w2 * bflo(cq.w), w0 * bfhi(a.w) + w1 * bfhi(bq.w) + w2 * bfhi(cq.w));
            *(v4u*)(CC + row * D + h * 64 + 8 * ch) = o;
        }
        __syncthreads();
    }
}
__device__ __forceinline__ void p2_gmlp(const Ptrs& P, int l, LAS unsigned char* lds, int vcu, int G, int wave, int lane, int tid) {
    const bf16* Gb = (const bf16*)(P.ws + WS_G); const bf16* Ub = (const bf16*)(P.ws + WS_U); bf16* CC = (bf16*)(P.ws + WS_CC);
    const bf16* WST = (const bf16*)(P.ws + WS_WST) + (size_t)l * 4 * 128 * 128;
    const float* bs = P.bsp + l * 4 * 128;
    const int hh = lane >> 5, q4 = (lane & 15) >> 2, p4 = lane & 3, blk = (lane >> 4) & 1;
    const int pb = wave & 3, db = wave >> 2;
    for (int item = vcu; item < NB * 16 * 4; item += G) {
        const int g = item & 3, cch = (item >> 2) & 15, b = item >> 6;
        const size_t row0 = (size_t)b * S + cch * 128;
#pragma unroll
        for (int i = 0; i < 2; ++i) { const int idx = tid + NTHREADS * i, q = idx >> 3, ch = idx & 7;
            *(LAS v4u*)(lds + q * VT_STRIDE + ch * 16) = *(const v4u*)(Gb + (row0 + q) * 256 + g * 64 + ch * 8); }
        __syncthreads();
        f32x16 acc;
#pragma unroll
        for (int i = 0; i < 16; ++i) acc[i] = 0.f;
        const bf16* wp = WST + ((size_t)g * 128 + 32 * pb + (lane & 31)) * 128 + 8 * hh;
        LAS unsigned char* vrd = lds + (8 * hh + q4) * VT_STRIDE + (32 * db + 16 * blk + 4 * p4) * 2;
#pragma unroll
        for (int s = 0; s < 8; ++s) {
            const bf16x8 wf = *(const bf16x8*)(wp + 16 * s);
            const s16x4 lo = tr16(vrd + (16 * s) * VT_STRIDE), hi = tr16(vrd + (16 * s + 4) * VT_STRIDE);
            const bf16x8 vf = __builtin_shufflevector(lo, hi, 0, 1, 2, 3, 4, 5, 6, 7);
            acc = MFMA32(vf, wf, acc);
        }
        const int p = 32 * pb + (lane & 31);
        const float bsv = bs[g * 128 + p];
#pragma unroll
        for (int g4 = 0; g4 < 4; ++g4) {
            const int d0 = 32 * db + 8 * g4 + 4 * hh;
            const v2u uu = *(const v2u*)(Ub + (row0 + p) * 256 + g * 64 + d0);
            v2u w; w.x = pk2(bflo(uu.x) * (acc[4 * g4] + bsv), bfhi(uu.x) * (acc[4 * g4 + 1] + bsv)); w.y = pk2(bflo(uu.y) * (acc[4 * g4 + 2] + bsv), bfhi(uu.y) * (acc[4 * g4 + 3] + bsv));
            *(v2u*)(CC + (row0 + p) * D + 512 + g * 64 + d0) = w;
        }
        __syncthreads();
    }
}
__device__ __forceinline__ void p2_pool(const Ptrs& P, int l, int vcu, int G, int wave, int lane) {
    const bf16* Zb = (const bf16*)(P.ws + WS_Z); bf16* CC = (bf16*)(P.ws + WS_CC);
    const bf16* WPT = (const bf16*)(P.ws + WS_WPT) + (size_t)l * 4 * 64 * 64;
    const float* psc = P.psc + l * 256;
    const int hh = lane >> 5, pl = lane & 31;
    const int gw = vcu * NWAVES + wave, NGW = G * NWAVES;
    for (int task = gw; task < NB * 4 * 64; task += NGW) {
        const int tile = task & 63, g = (task >> 6) & 3, b = task >> 8;
        const int pos = 32 * tile + pl;
        const int w = 2 << g, left = w >> 1, right = w - 1 - left;
        int lo = pos - left; if (lo < 0) lo = 0;
        int hi = pos + right + 1; if (hi > S) hi = S;
        const float inv = 1.0f / (float)(hi - lo);
        const bf16* zb = Zb + (size_t)b * S * 256 + g * 64 + 8 * hh;
        bf16x8 bfr[4];
#pragma unroll
        for (int ks = 0; ks < 4; ++ks) {
            float sm[8];
#pragma unroll
            for (int e = 0; e < 8; ++e) sm[e] = 0.f;
            for (int t = lo; t < hi; ++t) { const v4u z = *(const v4u*)(zb + (size_t)t * 256 + 16 * ks);
                sm[0] += bflo(z.x); sm[1] += bfhi(z.x); sm[2] += bflo(z.y); sm[3] += bfhi(z.y); sm[4] += bflo(z.z); sm[5] += bfhi(z.z); sm[6] += bflo(z.w); sm[7] += bfhi(z.w); }
            const v4u z = *(const v4u*)(zb + (size_t)pos * 256 + 16 * ks);
            v4u o; o.x = pk2(sm[0] * inv - bflo(z.x), sm[1] * inv - bfhi(z.x)); o.y = pk2(sm[2] * inv - bflo(z.y), sm[3] * inv - bfhi(z.y));
            o.z = pk2(sm[4] * inv - bflo(z.z), sm[5] * inv - bfhi(z.z)); o.w = pk2(sm[6] * inv - bflo(z.w), sm[7] * inv - bfhi(z.w));
            bfr[ks] = __builtin_bit_cast(bf16x8, o);
        }
#pragma unroll
        for (int ob = 0; ob < 2; ++ob) {
            f32x16 acc;
#pragma unroll
            for (int i = 0; i < 16; ++i) acc[i] = 0.f;
#pragma unroll
            for (int ks = 0; ks < 4; ++ks) { const bf16x8 af = *(const bf16x8*)(WPT + ((size_t)g * 64 + 32 * ob + pl) * 64 + 16 * ks + 8 * hh); acc = MFMA32(af, bfr[ks], acc); }
#pragma unroll
            for (int g4 = 0; g4 < 4; ++g4) {
                const int o0 = 32 * ob + 8 * g4 + 4 * hh;
                const f32x4 sc = *(const f32x4*)(psc + g * 64 + o0);
                v2u w; w.x = pk2(acc[4 * g4] * sc[0], acc[4 * g4 + 1] * sc[1]); w.y = pk2(acc[4 * g4 + 2] * sc[2], acc[4 * g4 + 3] * sc[3]);
                *(v2u*)(CC + ((size_t)b * S + pos) * D + 768 + g * 64 + o0) = w;
            }
        }
    }
}

__device__ __forceinline__ void route16(const float* logit, const float* __restrict__ rbias, int& e0, int& e1, float& g0, float& g1) {
    float sc[16], bi[16];
#pragma unroll
    for (int e = 0; e < 16; ++e) { sc[e] = 1.0f / (1.0f + expf(-logit[e])); bi[e] = sc[e] + rbias[e]; }
    int gsel = 0; float best = -1e30f;
#pragma unroll
    for (int g = 0; g < 4; ++g) {
        float m1 = -1e30f, m2 = -1e30f;
#pragma unroll
        for (int j = 0; j < 4; ++j) { const float v = bi[g * 4 + j]; if (v > m1) { m2 = m1; m1 = v; } else if (v > m2) m2 = v; }
        const float gs = m1 + m2;
        if (gs > best) { best = gs; gsel = g; }
    }
    float bg[4], sg[4];
#pragma unroll
    for (int j = 0; j < 4; ++j) { bg[j] = bi[j]; sg[j] = sc[j];
#pragma unroll
        for (int g = 1; g < 4; ++g) { bg[j] = (g == gsel) ? bi[g * 4 + j] : bg[j]; sg[j] = (g == gsel) ? sc[g * 4 + j] : sg[j]; } }
    int i1 = 0; float m1 = bg[0], s1 = sg[0];
#pragma unroll
    for (int j = 1; j < 4; ++j) if (bg[j] > m1) { m1 = bg[j]; i1 = j; s1 = sg[j]; }
    int i2 = -1; float m2 = -1e30f, s2 = 0.f;
#pragma unroll
    for (int j = 0; j < 4; ++j) if (j != i1 && bg[j] > m2) { m2 = bg[j]; i2 = j; s2 = sg[j]; }
    e0 = gsel * 4 + i1; e1 = gsel * 4 + i2;
    g0 = s1 / (s1 + s2); g1 = s2 / (s1 + s2);
}
__device__ __forceinline__ void p4_stats_router(const Ptrs& P, int l, LAS unsigned char* lds, int wave, int lane, int tid) {
    const bf16* Y1B = (const bf16*)(P.ws + WS_Y1B); float* STATS = (float*)(P.ws + WS_STATS);
    int* TOKE = (int*)(P.ws + WS_TOKE); float* TOKG = (float*)(P.ws + WS_TOKG); int* TOKP = (int*)(P.ws + WS_TOKP);
    int* TLIST = (int*)(P.ws + WS_TLIST); float* GLIST = (float*)(P.ws + WS_GLIST);
    unsigned* cnt = (unsigned*)(P.ws + WS_CTL) + CW_CNT + 16 * l;
    const float* RWQ = (const float*)(P.ws + WS_RWQ) + (size_t)l * 16384; const float* CR = (const float*)(P.ws + WS_CR) + l * 32;
    LAS float* rwq = (LAS float*)lds;
    for (int i = tid; i < 4096; i += NTHREADS) ((LAS f32x4*)rwq)[i] = ((const f32x4*)RWQ)[i];
    LAS float* dots = (LAS float*)(lds + 65536) + wave * 256;
    LAS int* s_cnt = (LAS int*)(lds + 65536 + 8192); LAS int* s_base = s_cnt + 16; LAS int* s_e = s_cnt + 32; LAS int* s_pos = s_e + 256; LAS float* s_g = (LAS float*)(s_pos + 256);
    if (tid < 16) s_cnt[tid] = 0;
    __syncthreads();
    const int row_l = lane & 15, q = lane >> 4;
    for (int blk_row = blockIdx.x * 128; blk_row < T; blk_row += gridDim.x * 128) {
        const int row = blk_row + wave * 16 + row_l;
        const bf16* yp = Y1B + (size_t)row * D + 8 * q;
        f32x4 acc = {0.f, 0.f, 0.f, 0.f}; float s1 = 0.f, s2 = 0.f;
#pragma unroll 1
        for (int jc = 0; jc < 4; ++jc) {
            v4u yv[8];
#pragma unroll
            for (int jj = 0; jj < 8; ++jj) yv[jj] = *(const v4u*)(yp + 32 * (8 * jc + jj));
#pragma unroll
            for (int jj = 0; jj < 8; ++jj) {
                const int jp = 8 * jc + jj;
                const float y0 = bflo(yv[jj].x), y1 = bfhi(yv[jj].x), y2 = bflo(yv[jj].y), y3 = bfhi(yv[jj].y), y4 = bflo(yv[jj].z), y5 = bfhi(yv[jj].z), y6 = bflo(yv[jj].w), y7 = bfhi(yv[jj].w);
                const LAS f32x4* bp = (const LAS f32x4*)rwq + (8 * jp + 2 * q) * 16 + row_l;
                const f32x4 b0 = bp[0], b1 = bp[16];
                acc = __builtin_amdgcn_mfma_f32_16x16x4f32(y0, b0[0], acc, 0, 0, 0); acc = __builtin_amdgcn_mfma_f32_16x16x4f32(y1, b0[1], acc, 0, 0, 0);
                acc = __builtin_amdgcn_mfma_f32_16x16x4f32(y2, b0[2], acc, 0, 0, 0); acc = __builtin_amdgcn_mfma_f32_16x16x4f32(y3, b0[3], acc, 0, 0, 0);
                acc = __builtin_amdgcn_mfma_f32_16x16x4f32(y4, b1[0], acc, 0, 0, 0); acc = __builtin_amdgcn_mfma_f32_16x16x4f32(y5, b1[1], acc, 0, 0, 0);
                acc = __builtin_amdgcn_mfma_f32_16x16x4f32(y6, b1[2], acc, 0, 0, 0); acc = __builtin_amdgcn_mfma_f32_16x16x4f32(y7, b1[3], acc, 0, 0, 0);
                s1 += ((y0 + y1) + (y2 + y3)) + ((y4 + y5) + (y6 + y7));
                s2 += ((y0 * y0 + y1 * y1) + (y2 * y2 + y3 * y3)) + ((y4 * y4 + y5 * y5) + (y6 * y6 + y7 * y7));
            }
        }
        s1 += __shfl_xor(s1, 16); s1 += __shfl_xor(s1, 32); s2 += __shfl_xor(s2, 16); s2 += __shfl_xor(s2, 32);
#pragma unroll
        for (int i = 0; i < 4; ++i) dots[(4 * q + i) * 16 + row_l] = acc[i];
        LDS_WAIT();
        if (lane < 16) {
            const int grow = blk_row + wave * 16 + lane;
            const float mu = s1 * (1.0f / D), var = s2 * (1.0f / D) - mu * mu, rstd = rsqrtf(var + LN_EPS);
            *(f32x2*)(STATS + 2 * (size_t)grow) = (f32x2){mu, rstd};
            float lg[16];
#pragma unroll
            for (int e4 = 0; e4 < 4; ++e4) { const f32x4 d = *(const LAS f32x4*)(dots + lane * 16 + 4 * e4);
#pragma unroll
                for (int e = 0; e < 4; ++e) lg[4 * e4 + e] = rstd * (d[e] - mu * CR[4 * e4 + e]) + CR[16 + 4 * e4 + e]; }
            int e0, e1; float g0, g1;
            route16(lg, P.rb, e0, e1, g0, g1);
            const int tl = wave * 16 + lane;
            const int p0 = __hip_atomic_fetch_add(s_cnt + e0, 1, __ATOMIC_RELAXED, __HIP_MEMORY_SCOPE_WORKGROUP);
            const int p1 = __hip_atomic_fetch_add(s_cnt + e1, 1, __ATOMIC_RELAXED, __HIP_MEMORY_SCOPE_WORKGROUP);
            s_e[2 * tl] = e0; s_e[2 * tl + 1] = e1; s_pos[2 * tl] = p0; s_pos[2 * tl + 1] = p1; s_g[2 * tl] = g0; s_g[2 * tl + 1] = g1;
            TOKE[2 * grow] = e0; TOKE[2 * grow + 1] = e1; TOKG[2 * grow] = g0; TOKG[2 * grow + 1] = g1;
        }
        __syncthreads();
        if (tid < 16) s_base[tid] = (int)__hip_atomic_fetch_add(cnt + tid, (unsigned)s_cnt[tid], RLX_AGENT);
        __syncthreads();
        if (tid < 256) { const int e = s_e[tid], p = s_base[e] + s_pos[tid]; TOKP[2 * blk_row + tid] = p;
            TLIST[(size_t)e * T + p] = blk_row + (tid >> 1); GLIST[(size_t)e * T + p] = s_g[tid]; }
        if (tid < 16) s_cnt[tid] = 0;
        __syncthreads();
    }
}
__device__ __forceinline__ int build_tables(const unsigned char* ws, int l, LAS unsigned char* lds, int tid) {
    LAS int* s_base = (LAS int*)(lds + TAB_OFF); LAS int* s_cntx = s_base + 32; LAS int* texp = s_base + 64;
    const unsigned* cnt = (const unsigned*)(ws + WS_CTL) + CW_CNT + 16 * l;
    if (tid == 0) {
        int base = 0;
        for (int e = 0; e < 16; ++e) { const int c = (int)__hip_atomic_load(cnt + e, RLX_AGENT); const int nt = (c + 255) >> 8;
            s_cntx[e] = c; s_base[e] = base; for (int t = 0; t < nt; ++t) texp[(base >> 8) + t] = e; base += nt << 8; }
        s_base[16] = base;
    }
    __syncthreads();
    return s_base[16] >> 8;
}
__device__ __forceinline__ void p8_ln2(const Ptrs& P, int l, bool last, LAS unsigned char* lds, int vcu, int G, int wave, int lane) {
    const LAS int* s_base = (const LAS int*)(lds + TAB_OFF);
    const bf16* Y1B = (const bf16*)(P.ws + WS_Y1B); const float* STATS = (const float*)(P.ws + WS_STATS); const bf16* YB = (const bf16*)(P.ws + WS_YB); bf16* XB = (bf16*)(P.ws + WS_HB);
    const int* TOKE = (const int*)(P.ws + WS_TOKE); const int* TOKP = (const int*)(P.ws + WS_TOKP);
    const float* g1p = P.ln1g + l * D; const float* b1p = P.ln1b + l * D; const float* g2p = P.ln2g + l * D; const float* b2p = P.ln2b + l * D;
    float g1[16], b1[16], g2[16], b2[16];
#pragma unroll
    for (int j = 0; j < 2; ++j)
#pragma unroll
        for (int h = 0; h < 2; ++h) { const int c = 8 * lane + 512 * j + 4 * h;
            const f32x4 a = *(const f32x4*)(g1p + c), b = *(const f32x4*)(b1p + c), cc = *(const f32x4*)(g2p + c), d = *(const f32x4*)(b2p + c);
#pragma unroll
            for (int e = 0; e < 4; ++e) { g1[8 * j + 4 * h + e] = a[e]; b1[8 * j + 4 * h + e] = b[e]; g2[8 * j + 4 * h + e] = cc[e]; b2[8 * j + 4 * h + e] = d[e]; } }
    const int gw = vcu * NWAVES + wave, NGW = G * NWAVES;
    for (int t = gw; t < T; t += NGW) {
        const int r0 = s_base[TOKE[2 * t]] + TOKP[2 * t], r1 = s_base[TOKE[2 * t + 1]] + TOKP[2 * t + 1];
        const f32x2 st = *(const f32x2*)(STATS + 2 * (size_t)t);
        float v[16]; float s = 0.f;
#pragma unroll
        for (int j = 0; j < 2; ++j) {
            const v4u y = *(const v4u*)(Y1B + (size_t)t * D + 8 * lane + 512 * j);
            const v4u a = *(const v4u*)(YB + (size_t)r0 * D + 8 * lane + 512 * j), b = *(const v4u*)(YB + (size_t)r1 * D + 8 * lane + 512 * j);
            const unsigned yw[4] = {y.x, y.y, y.z, y.w}, aw[4] = {a.x, a.y, a.z, a.w}, bw[4] = {b.x, b.y, b.z, b.w};
#pragma unroll
            for (int k = 0; k < 4; ++k) {
                const int i0 = 8 * j + 2 * k;
                v[i0] = ALPHA * ((bflo(yw[k]) - st.x) * st.y * g1[i0] + b1[i0]) + bflo(aw[k]) + bflo(bw[k]);
                v[i0 + 1] = ALPHA * ((bfhi(yw[k]) - st.x) * st.y * g1[i0 + 1] + b1[i0 + 1]) + bfhi(aw[k]) + bfhi(bw[k]);
                s += v[i0] + v[i0 + 1];
            }
        }
        const float mu = wave_sum(s) * (1.0f / D); float q = 0.f;
#pragma unroll
        for (int i = 0; i < 16; ++i) { v[i] -= mu; q += v[i] * v[i]; }
        const float rstd = rsqrtf(wave_sum(q) * (1.0f / D) + LN_EPS);
#pragma unroll
        for (int i = 0; i < 16; ++i) v[i] = v[i] * rstd * g2[i] + b2[i];
        if (last) {
#pragma unroll
            for (int j = 0; j < 2; ++j) { float* op = P.out + (size_t)t * D + 8 * lane + 512 * j;
                *(f32x4*)op = (f32x4){v[8 * j], v[8 * j + 1], v[8 * j + 2], v[8 * j + 3]}; *(f32x4*)(op + 4) = (f32x4){v[8 * j + 4], v[8 * j + 5], v[8 * j + 6], v[8 * j + 7]}; }
        } else {
#pragma unroll
            for (int j = 0; j < 2; ++j) { v4u w; w.x = pk2(v[8 * j], v[8 * j + 1]); w.y = pk2(v[8 * j + 2], v[8 * j + 3]); w.z = pk2(v[8 * j + 4], v[8 * j + 5]); w.w = pk2(v[8 * j + 6], v[8 * j + 7]);
                *(v4u*)(XB + (size_t)t * D + 8 * lane + 512 * j) = w; }
        }
    }
}

template <class Tp> __device__ __forceinline__ Tp* asg(Tp* p) { GAS Tp* g = (GAS Tp*)p; asm volatile("" : "+s"(g)); return (Tp*)g; }
__device__ __forceinline__ Ptrs load_ptrs(const Ptrs& q) {
    Ptrs P;
    P.x = asg(q.x); P.w_in = asg(q.w_in); P.w_out = asg(q.w_out); P.lg = asg(q.lg); P.lb = asg(q.lb); P.wsp = asg(q.wsp); P.bsp = asg(q.bsp); P.pw = asg(q.pw); P.psc = asg(q.psc);
    P.ln1g = asg(q.ln1g); P.ln1b = asg(q.ln1b); P.rw = asg(q.rw); P.rb = asg(q.rb); P.wg = asg(q.wg); P.wu = asg(q.wu); P.wd = asg(q.wd); P.ln2g = asg(q.ln2g); P.ln2b = asg(q.ln2b);
    P.out = asg(q.out); P.ws = asg(q.ws);
    return P;
}
struct Args { Ptrs p; int ph_lo, ph_hi, li, pad; };
constexpr int N_PHASES = 15;
__global__ void __launch_bounds__(NTHREADS, 2) mk_fwd(Args args_unused) {
    const Args* ka_ = (const Args*)__builtin_amdgcn_kernarg_segment_ptr();
#ifndef USE_KA
#define KA() (&args_unused)
#else
#define KA() ({ const Args* p_ = ka_; asm volatile("" : "+s"(p_)); p_; })
#endif
    extern __shared__ __attribute__((aligned(16))) unsigned char lds_raw[];
    LAS unsigned char* lds = (LAS unsigned char*)lds_raw;
    const int tid0 = threadIdx.x; const int wave0 = __builtin_amdgcn_readfirstlane(tid0 >> 6);
    const int G = gridDim.x; const int bx = blockIdx.x; const int vcu = (G % 8 == 0) ? (bx % 8) * (G / 8) + bx / 8 : bx;
    volatile LAS unsigned* MISC = (volatile LAS unsigned*)(lds + MISC_OFF);
    for (int u = tid0; u < (LDS_BYTES - RING_BYTES) / 4; u += NTHREADS) ((LAS unsigned*)(lds + RING_BYTES))[u] = 0u;
    __syncthreads();
    const int lo = KA()->ph_lo, hi = KA()->ph_hi;
    unsigned* ctl = (unsigned*)(asg(KA()->p.ws) + WS_CTL);
    XcdBarrier bar; bar.bar = ctl + CW_BAR + KA()->li * XCD_BAR_WORDS; bar.x = 0; bar.st = nullptr;
    if (hi - lo > 1) bar = xcd_barrier_post(ctl + CW_BAR + KA()->li * XCD_BAR_WORDS, MISC + 8, tid0);
#define IN(k) (lo <= (k) && (k) < hi)
#ifndef MK_REPEAT
#define MK_REPEAT -1
#endif
#define REP(k) for (int rep_ = 0; rep_ < ((MK_REPEAT == (k)) ? 2 : 1); ++rep_)
#define PHASE_IDS() int wave = wave0; asm volatile("" : "+s"(wave)); int lane; asm volatile("v_mbcnt_lo_u32_b32 %0, -1, 0\n\tv_mbcnt_hi_u32_b32 %0, -1, %0" : "=&v"(lane)); const int tid = wave * 64 + lane; (void)tid
#define SEAM(k) do { if (IN(k) && IN((k) + 1)) xcd_barrier(bar, tid); } while (0)
#ifndef PH_MASK
#define PH_MASK 0x1ff
#endif
    if ((PH_MASK & 1) && IN(0)) REP(0) { PHASE_IDS(); const Ptrs P = load_ptrs(KA()->p); p0_prologue(P, lds, vcu, G, wave, lane, tid); SEAM(0); }
    for (int l = 0; l < 2; ++l) {
        const int pb = 1 + 7 * l;
        if ((PH_MASK & 2) && IN(pb + 0)) REP(1) {
            PHASE_IDS(); const Ptrs P = load_ptrs(KA()->p);
            pg8::Gemm g{(const bf16*)(P.ws + WS_HB), (const bf16*)(P.ws + WS_WIN) + (size_t)l * NCOL * D, D};
            pg8::StaticOrder so; so.init(T / 256, NCOL / 256, G, bx);
            EpiProj E{P.ws, P.lg + l * 256, P.lb + l * 256};
            pg8::gemm_phase<EpiProj, pg8::StaticOrder>(lds, g, so, E, wave);
            SEAM(pb + 0);
        }
        if ((PH_MASK & 4) && IN(pb + 1)) REP(2) {
            PHASE_IDS(); const Ptrs P = load_ptrs(KA()->p);
            REP(21) p2_attention(P.ws, P.ws, lds, vcu, G, wave, lane, tid);
            REP(22) p2_gmlp(P, l, lds, vcu, G, wave, lane, tid);
            REP(23) p2_pool(P, l, vcu, G, wave, lane);
            SEAM(pb + 1);
        }
        if ((PH_MASK & 8) && IN(pb + 2)) REP(3) {
            PHASE_IDS(); const Ptrs P = load_ptrs(KA()->p);
            pg8::Gemm g{(const bf16*)(P.ws + WS_CC), (const bf16*)(P.ws + WS_WOUT) + (size_t)l * D * D, D};
            pg8::StaticOrder so; so.init(T / 256, D / 256, G, bx);
            EpiOutB E{(const bf16*)(P.ws + WS_HB), (bf16*)(P.ws + WS_Y1B)};
            pg8::gemm_phase<EpiOutB, pg8::StaticOrder>(lds, g, so, E, wave);
            SEAM(pb + 2);
        }
        if ((PH_MASK & 16) && IN(pb + 3)) { PHASE_IDS(); const Ptrs P = load_ptrs(KA()->p); p4_stats_router(P, l, lds, wave, lane, tid); SEAM(pb + 3); }
        if ((PH_MASK & 64) && IN(pb + 4)) REP(6) {
            PHASE_IDS(); const Ptrs P = load_ptrs(KA()->p);
            const int ntiles = build_tables(P.ws, l, lds, tid);
            pg8::Gemm g{(const bf16*)(P.ws + WS_Y1B), (const bf16*)(P.ws + WS_WGU) + (size_t)l * NE * 1024 * D, D};
            pg8::GroupOrder go; go.so.init(ntiles, 4, G, bx); go.s_base = (const LAS int*)(lds + TAB_OFF); go.tlist = (const int*)(P.ws + WS_TLIST); go.toks = (const LAS unsigned short*)(lds + TAB_OFF + 2048);
            go.stage_tokens((LAS unsigned short*)(lds + TAB_OFF + 2048), tid, NTHREADS); __syncthreads();
            EpiGU E{P.ws, (const LAS unsigned short*)(lds + TAB_OFF + 2048), l};
            pg8::gemm_phase<EpiGU, pg8::GroupOrder, true, true>(lds, g, go, E, wave);
            SEAM(pb + 4);
        }
        if ((PH_MASK & 128) && IN(pb + 5)) REP(7) {
            PHASE_IDS(); const Ptrs P = load_ptrs(KA()->p);
            const int ntiles = build_tables(P.ws, l, lds, tid);
            pg8::Gemm g{(const bf16*)(P.ws + WS_HB), (const bf16*)(P.ws + WS_WDN) + (size_t)l * NE * D * FF, FF};
            pg8::GroupOrder go; go.so.init(ntiles, 4, G, bx); go.s_base = (const LAS int*)(lds + TAB_OFF); go.tlist = nullptr; go.toks = nullptr;
            EpiDown E{(bf16*)(P.ws + WS_YB), (const float*)(P.ws + WS_GLIST), (const LAS int*)(lds + TAB_OFF) + 32};
            pg8::gemm_phase<EpiDown, pg8::GroupOrder>(lds, g, go, E, wave);
            SEAM(pb + 5);
        }
        if ((PH_MASK & 256) && IN(pb + 6)) REP(8) { PHASE_IDS(); const Ptrs P = load_ptrs(KA()->p); build_tables(P.ws, l, lds, tid); p8_ln2(P, l, l == 1, lds, vcu, G, wave, lane); SEAM(pb + 6); }
    }
#undef IN
#undef SEAM
}
}
#ifndef MK_CUT
#define MK_CUT 15
#endif
#if MK_CUT < 15
namespace glue {
using namespace mk;
__global__ void g1(const unsigned char* ws, int b, float* proj) {
    const int pos = blockIdx.x; const size_t row = (size_t)b * S + pos;
    for (int col = threadIdx.x; col < NCOL; col += blockDim.x) {
        float v;
        if (col < 1024) { const int c = col & 511, head = c >> 6, d = c & 63; const int t = d < 16 ? (d < 8 ? 2 * d : 2 * (d - 8) + 1) : d;
            const bf16* src = (const bf16*)(ws + (col < 512 ? WS_Q : WS_K)); v = bflo(src[row * 512 + head * 64 + t]); if (col < 512) v *= 8.0f; }
        else if (col < 1536) v = bflo(((const bf16*)(ws + WS_V))[row * 512 + col - 1024]);
        else if (col < 1792) v = bflo(((const bf16*)(ws + WS_U))[row * 256 + col - 1536]);
        else if (col < 2048) v = bflo(((const bf16*)(ws + WS_G))[row * 256 + col - 1792]);
        else v = bflo(((const bf16*)(ws + WS_Z))[row * 256 + col - 2048]);
        proj[(size_t)pos * NCOL + col] = v;
    }
}
__global__ void g2(const unsigned char* ws, int b, float* cc) {
    const int pos = blockIdx.x; const size_t row = (size_t)b * S + pos;
    for (int col = threadIdx.x; col < D; col += blockDim.x) cc[(size_t)pos * D + col] = bflo(((const bf16*)(ws + WS_CC))[row * D + col]);
}
}
#endif

static void mk_launch_range(const mk::Ptrs& p, int grid, int lo, int hi, int li, hipStream_t stream) {
    mk::Args a{};
    a.p = p; a.ph_lo = lo; a.ph_hi = hi; a.li = li; a.pad = 0;
    hipLaunchKernelGGL(mk::mk_fwd, dim3(grid), dim3(mk::NTHREADS), mk::LDS_BYTES, stream, a);
}

extern "C" void kernel_launch(void* const* d_in, const int* in_sizes, int n_in, void* d_out, int out_size, void* d_ws, size_t ws_size, hipStream_t stream) {
    using namespace mk;
    static int grid = 0;
    if (grid == 0) {
        if (n_in != 18 || ws_size < WS_END) { fprintf(stderr, "kernel_launch: unexpected n_in %d / ws_size %zu\n", n_in, ws_size); grid = -1; return; }
        int dev = 0, cus = 0;
        if (hipGetDevice(&dev) != hipSuccess || hipDeviceGetAttribute(&cus, hipDeviceAttributeMultiprocessorCount, dev) != hipSuccess) { grid = -1; return; }
        if (hipFuncSetAttribute((const void*)mk_fwd, hipFuncAttributeMaxDynamicSharedMemorySize, LDS_BYTES) != hipSuccess) { fprintf(stderr, "kernel_launch: hipFuncSetAttribute failed\n"); grid = -1; return; }
        grid = cus;
    }
    if (grid < 0) return;
    (void)hipMemsetAsync((char*)d_ws + WS_CTL, 0, CTL_ZERO_BYTES, stream);
    Ptrs p{};
    const float* const* in = (const float* const*)d_in;
    p.x = in[0]; p.w_in = in[1]; p.w_out = in[2]; p.lg = in[3]; p.lb = in[4]; p.wsp = in[5]; p.bsp = in[6]; p.pw = in[7]; p.psc = in[8];
    p.ln1g = in[9]; p.ln1b = in[10]; p.rw = in[11]; p.rb = in[12]; p.wg = in[13]; p.wu = in[14]; p.wd = in[15]; p.ln2g = in[16]; p.ln2b = in[17];
    p.out = (float*)d_out; p.ws = (unsigned char*)d_ws;
#if MK_CUT >= 15
    mk_launch_range(p, grid, 0, N_PHASES, 0, stream);
#else
    mk_launch_range(p, grid, 0, MK_CUT, 0, stream);
    nv::In I = nv::make_in(d_in);
    const unsigned char* ws = (const unsigned char*)d_ws;
    float* scr_base = (float*)((char*)d_ws + 509 * MiB) - nv::SCR_FLOATS - (size_t)T * D;
    (void)scr_base;
    float* nscr = (float*)((char*)d_ws + (MK_CUT <= 2 ? (size_t)357 * MiB : (size_t)261 * MiB));
    nv::Scr s = nv::carve(nscr);
    float* xcur = (float*)d_out;
    for (int b = 0; b < NB; ++b) {
        const float* xin = I.x + (size_t)b * S * D; float* xout = xcur + (size_t)b * S * D; const int l = 0;
#if MK_CUT == 2
        glue::g1<<<S, 256, 0, stream>>>(ws, b, s.proj);
#endif
#if MK_CUT <= 2
        nv::attn<<<dim3(S, 8), 64, 0, stream>>>(s.proj, s.cc);
        nv::gmlp_mix<<<S, 256, 0, stream>>>(s.proj, I.wsp + (size_t)l * 4 * 128 * 128, I.bsp + l * 4 * 128, s.cc);
        nv::pool1<<<S, 256, 0, stream>>>(s.proj, s.pooled);
        nv::pool2<<<S, 256, 0, stream>>>(s.pooled, I.pw + (size_t)l * 4 * 64 * 64, I.psc + l * 256, s.cc);
#endif
#if MK_CUT == 3
        glue::g2<<<S, 256, 0, stream>>>(ws, b, s.cc);
#endif
#if MK_CUT <= 3
        nv::gemm<<<dim3(D / 64, S / 64), 256, 0, stream>>>(s.cc, I.w_out + (size_t)l * D * D, s.h, S, D, D);
        nv::ln_res<<<S, 64, 0, stream>>>(xin, s.h, I.ln1g + l * D, I.ln1b + l * D, s.x1);
#endif
        nv::route<<<S, 64, 0, stream>>>(s.x1, I.rw, I.rb, s.eo, s.go);
        nv::moe<<<S, 256, 0, stream>>>(s.x1, s.eo, s.go, I.wg + (size_t)l * NE * D * FF, I.wu + (size_t)l * NE * D * FF, I.wd + (size_t)l * NE * FF * D, s.moe);
        nv::ln_res<<<S, 64, 0, stream>>>(s.x1, s.moe, I.ln2g + l * D, I.ln2b + l * D, xout);
    }
    for (int b = 0; b < NB; ++b) { float* xb = xcur + (size_t)b * S * D; nv::layer(I, 1, xb, xb, s, stream); }
#endif
}
```

```cpp
#define MK_CUT 13
#include <hip/hip_runtime.h>
#include <cstdio>
#ifndef MK_ALIGN
#define MK_ALIGN true
#endif
namespace pg8 {
#define PG8_LAS __attribute__((address_space(3)))
typedef unsigned short bf16_t;
typedef short bf16x8 __attribute__((ext_vector_type(8)));
typedef float f32x4 __attribute__((ext_vector_type(4)));
typedef unsigned u32x4 __attribute__((ext_vector_type(4)));
constexpr int BM = 256, BK = 64, HALF = 128, HTB = HALF * BK * 2  , STAGE_BYTES = 8 * HTB, NXCD = 8, WGM = 8;

__host__ __device__ __forceinline__ int lds_byte(int r, int c) { const int st = (r >> 4) * 2 + (c >> 5), rr = r & 15, cc = c & 31, ob = rr * 64 + cc * 2; return st * 1024 + (ob ^ (((ob >> 9) & 1) << 5)); }
__host__ __device__ __forceinline__ void stage_rc(int b, int& R, int& C) { const int st = b / 1024, sb = b % 1024, swz = sb ^ (((sb >> 9) & 1) << 5); R = (st >> 1) * 16 + swz / 64; C = (st & 1) * 32 + (swz % 64) / 2; }
__host__ __device__ __forceinline__ int perm32(int rho) { const int n = rho >> 4, i = rho & 15; return 8 * (i >> 2) + 4 * n + (i & 3); }

struct Unit { int pm, pn, pb, e, l0, ui; };
struct Gemm { const void* A; const void* Bt; int rb; };
typedef int v8i_t __attribute__((ext_vector_type(8)));
typedef int v4i_t __attribute__((ext_vector_type(4)));

struct StaticOrder {
    int nM, nN, nwg, G, c, pn_base, lo_c;
    __device__ void init(int nM_, int nN_, int G_, int c_) { nM = nM_; nN = nN_; nwg = nM * nN; G = G_; c = c_; pn_base = 0; lo_c = 0; }
    __device__ bool next(int i, Unit& u) const {
        long L = (long)i * G + c;
        if (lo_c > 0) { const int hi_n = G - lo_c; if (c >= lo_c) { if (i >= 4) return false; L = (long)(c - lo_c) + (long)hi_n * i; } else { if (i >= 2) return false; L = 4L * hi_n + c + (long)lo_c * i; } }
        return unit_of(L, i, u);
    }
    __device__ bool unit_of(long L, int i, Unit& u) const {
        if (L >= nwg) return false;
        int wgid = (int)L; { const int q = nwg / NXCD, r = nwg % NXCD, xcd = wgid % NXCD, off = wgid / NXCD; wgid = (xcd < r ? xcd * (q + 1) : r * (q + 1) + (xcd - r) * q) + off; }
        const int nig = WGM * nN, gid = wgid / nig, fm = gid * WGM, gsz = (nM - fm) < WGM ? (nM - fm) : WGM;
        u.pm = fm + ((wgid % nig) % gsz); u.pb = (wgid % nig) / gsz; u.pn = u.pb + pn_base; u.e = 0; u.l0 = 0; u.ui = i; return true;
    }
    __device__ __forceinline__ void a_ready(const Unit&, int, int) const {}
    __device__ __forceinline__ void done(const Unit&, int) const {}
    __device__ __forceinline__ void claim_issue(int, int, int, unsigned&) const {}
    __device__ __forceinline__ void claim_commit(int, int, int, unsigned) const {}
};
struct GroupOrder {
    StaticOrder so; const PG8_LAS int* s_base; const int* tlist; unsigned* ready; int mode;
    const PG8_LAS unsigned short* toks;
    __device__ bool next(int i, Unit& u) const { if (!so.next(i, u)) return false; const int e = s_base[64 + u.pm]; u.e = e; u.l0 = u.pm * 256 - s_base[e]; u.pb = e * so.nN + u.pn; return true; }
    __device__ __forceinline__ int row_token(int ui, int r) const { return (int)toks[ui * 256 + r]; }
    __device__ __forceinline__ void done(const Unit& u, int lane) const {
        if (mode == 1) {
            asm volatile("s_waitcnt vmcnt(0)" ::: "memory");
            if (lane == 0) __hip_atomic_fetch_add(ready + 64 * u.pm, 1u, __ATOMIC_RELAXED, __HIP_MEMORY_SCOPE_AGENT);
        }
    }
    __device__ __forceinline__ void a_ready(const Unit& u, int wid, int lane) const {
        if (mode == 2) {
            if (wid == 0) {
                unsigned spins = 0;
                while ((unsigned)__builtin_amdgcn_readfirstlane(__hip_atomic_load(ready + 64 * u.pm, __ATOMIC_RELAXED, __HIP_MEMORY_SCOPE_AGENT)) < 32u) {
                    __builtin_amdgcn_s_sleep(2);
                    if (++spins > (1u << 22)) break;
                }
                __builtin_amdgcn_fence(__ATOMIC_ACQUIRE, "agent");
                asm volatile("s_waitcnt vmcnt(0)" ::: "memory");
            }
            asm volatile("" ::: "memory"); __builtin_amdgcn_s_barrier(); asm volatile("" ::: "memory");
        }
    }
    __device__ __forceinline__ void stage_tokens(PG8_LAS unsigned short* dst, int tid, int nthreads) const {
        Unit u;
        for (int ui = 0; so.next(ui, u); ++ui) {
            const int e = s_base[64 + u.pm], l0 = u.pm * 256 - s_base[e], nval = s_base[32 + e] - l0;
            for (int r = tid; r < 256; r += nthreads) dst[ui * 256 + r] = (unsigned short)(r < nval ? tlist[(size_t)e * 32768 + l0 + r] : 0);
        }
    }
    __device__ __forceinline__ void stage_stats(PG8_LAS float* dst, const float* stats, int tid, int nthreads) const {
        Unit u;
        for (int ui = 0; so.next(ui, u); ++ui) {
            const int e = s_base[64 + u.pm], l0 = u.pm * 256 - s_base[e], nval = s_base[32 + e] - l0;
            for (int r = tid; r < 256; r += nthreads) { const int tok = r < nval ? tlist[(size_t)e * 32768 + l0 + r] : 0;
                dst[2 * (ui * 256 + r)] = stats[2 * (size_t)tok]; dst[2 * (ui * 256 + r) + 1] = stats[2 * (size_t)tok + 1]; }
        }
    }
    __device__ __forceinline__ void stage_gates(PG8_LAS float* dst, const float* glist, int tid, int nthreads) const {
        Unit u;
        for (int ui = 0; so.next(ui, u); ++ui) {
            const int e = s_base[64 + u.pm], l0 = u.pm * 256 - s_base[e], nval = s_base[32 + e] - l0;
            for (int r = tid; r < 256; r += nthreads) dst[ui * 256 + r] = r < nval ? glist[(size_t)e * 32768 + l0 + r] : 0.f;
        }
    }
    __device__ __forceinline__ void claim_issue(int, int, int, unsigned&) const {}
    __device__ __forceinline__ void claim_commit(int, int, int, unsigned) const {}
};
struct DynGroupOrder {
    StaticOrder so; const PG8_LAS int* s_base; unsigned* ready; unsigned* cnt; int x; PG8_LAS int* slot;
    __device__ bool next(int i, Unit& u) const {
        const int L = slot[i & 1];
        if (!so.unit_of((long)L, i, u)) return false;
        const int e = s_base[64 + u.pm]; u.e = e; u.l0 = u.pm * 256 - s_base[e]; u.pb = e * so.nN + u.pn; return true;
    }
    __device__ __forceinline__ unsigned claim_one() const { const unsigned k = __hip_atomic_fetch_add(cnt, 1u, __ATOMIC_RELAXED, __HIP_MEMORY_SCOPE_AGENT); return k * 8u + (unsigned)x; }
    __device__ __forceinline__ void claim_issue(int, int, int, unsigned&) const {}
    __device__ __forceinline__ void claim_commit(int, int, int, unsigned) const {}
    __device__ __forceinline__ void done(const Unit&, int) const {}
    __device__ __forceinline__ void a_ready(const Unit& u, int wid, int lane) const {
        if (wid == 0) {
            unsigned nxtL = 0u;
            if (u.ui >= 1 && lane == 0) nxtL = claim_one();
            unsigned spins = 0;
            while ((unsigned)__builtin_amdgcn_readfirstlane(__hip_atomic_load(ready + 64 * u.pm, __ATOMIC_RELAXED, __HIP_MEMORY_SCOPE_AGENT)) < 32u) {
                __builtin_amdgcn_s_sleep(2);
                if (++spins > (1u << 22)) break;
            }
            __builtin_amdgcn_fence(__ATOMIC_ACQUIRE, "agent");
            asm volatile("s_waitcnt vmcnt(0)" ::: "memory");
            if (u.ui >= 1 && lane == 0) slot[(u.ui + 1) & 1] = (int)(nxtL > 0x3fffffffu ? 0x3fffffffu : nxtL);
            asm volatile("s_waitcnt lgkmcnt(0)" ::: "memory");
        }
        asm volatile("" ::: "memory"); __builtin_amdgcn_s_barrier(); asm volatile("" ::: "memory");
    }
};

template <class Epi, class Sched, bool ALIGN_EPI = MK_ALIGN, bool GATHER = false, bool F8 = false>
__device__ __forceinline__ void gemm_phase(PG8_LAS unsigned char* lds, const Gemm g, const Sched& S, const Epi& E, const int wave_id) {
    int lane; asm volatile("v_mbcnt_lo_u32_b32 %0, -1, 0\n\tv_mbcnt_hi_u32_b32 %0, -1, %0" : "=&v"(lane));
    const int wid = wave_id, tid = wid * 64 + lane, wr = wid >> 2, wc = wid & 3, fr = lane & 15, fq = lane >> 4;
    const int RB = g.rb, nt = RB / 128;
    unsigned voffA[2], voffB[2];
#pragma unroll
    for (int i = 0; i < 2; ++i) { int R, C; stage_rc(tid * 16 + i * 8192, R, C); const int Rb = Epi::PERM ? ((R & ~31) + perm32(R & 31)) : R;
        voffA[i] = (unsigned)(R * RB + C * 2); voffB[i] = (unsigned)(Rb * RB + C * 2); }
    const size_t kstep = (size_t)(BK * 2);
    const size_t hstep = (size_t)HALF * RB;
    const size_t tstep = 2 * hstep;
    const unsigned ldsw = (unsigned)wid * 1024u;
    const int aoff = lds_byte(wr * 64 + fr, fq * 8), boff = lds_byte(wc * 32 + fr, fq * 8);
#define PG8_SA(b, h) (((b) * 2 + (h)) * HTB)
#define PG8_SB(b, h) ((4 + (b) * 2 + (h)) * HTB)
#define PG8_STAGE(bufoff, gbase, voff) do { _Pragma("unroll") for (int _i = 0; _i < 2; ++_i) \
        __builtin_amdgcn_global_load_lds((const unsigned*)((const char*)(gbase) + (voff)[_i]), (PG8_LAS unsigned*)(lds + (bufoff) + ldsw + _i * 8192), 16, 0, 0); } while (0)
#define PG8_STAGE_A(bufoff, gbase, half, usenext) do { if constexpr (GATHER) { _Pragma("unroll") for (int _i = 0; _i < 2; ++_i) \
        __builtin_amdgcn_global_load_lds((const unsigned*)((const char*)(gbase) + ((usenext) ? (((gnp[_i] >> (16 * (half))) & 0xffffu) * (unsigned)RB + (ga[half][_i] & (unsigned)(RB - 1))) : ga[half][_i])), (PG8_LAS unsigned*)(lds + (bufoff) + ldsw + _i * 8192), 16, 0, 0); } \
        else { PG8_STAGE(bufoff, (gbase) + (half) * hstep, voffA); } } while (0)
#define PG8_LD16(off) (*(const PG8_LAS v4i_t*)(lds + (off)))
#define PG8_LDA(dst, b, h) do { _Pragma("unroll") for (int m = 0; m < 4; ++m) { if constexpr (F8) dst##8[m] = __builtin_shufflevector(PG8_LD16(PG8_SA(b, h) + aoff + m * 2048), PG8_LD16(PG8_SA(b, h) + aoff + m * 2048 + 1024), 0, 1, 2, 3, 4, 5, 6, 7); \
        else { _Pragma("unroll") for (int k = 0; k < 2; ++k) dst[m][k] = *(const PG8_LAS bf16x8*)(lds + PG8_SA(b, h) + aoff + m * 2048 + k * 1024); } } } while (0)
#define PG8_LDB(dst, b, h) do { _Pragma("unroll") for (int n = 0; n < 2; ++n) { if constexpr (F8) dst##8[n] = __builtin_shufflevector(PG8_LD16(PG8_SB(b, h) + boff + n * 2048), PG8_LD16(PG8_SB(b, h) + boff + n * 2048 + 1024), 0, 1, 2, 3, 4, 5, 6, 7); \
        else { _Pragma("unroll") for (int k = 0; k < 2; ++k) dst[n][k] = *(const PG8_LAS bf16x8*)(lds + PG8_SB(b, h) + boff + n * 2048 + k * 1024); } } } while (0)
#define PG8_MMA(ai, bj, At, Bt) do { __builtin_amdgcn_s_setprio(1); _Pragma("unroll") for (int m = 0; m < 4; ++m) _Pragma("unroll") for (int n = 0; n < 2; ++n) { \
        if constexpr (F8) asm volatile("s_nop 1\n\tv_mfma_scale_f32_16x16x128_f8f6f4 %0, %1, %2, %0, %3, %3 op_sel_hi:[0,0,0]" : "+v"(acc[ai][bj][m][n]) : "v"(Bt##8[n]), "v"(At##8[m]), "v"(one8));   \
        else { _Pragma("unroll") for (int k = 0; k < 2; ++k) acc[ai][bj][m][n] = __builtin_amdgcn_mfma_f32_16x16x32_bf16(Bt[n][k], At[m][k], acc[ai][bj][m][n], 0, 0, 0); } } \
        __builtin_amdgcn_s_setprio(0); } while (0)
#define PG8_WAIT_V(n) asm volatile("s_waitcnt vmcnt(" #n ")" ::: "memory")
#define PG8_WAIT_L(n) asm volatile("s_waitcnt lgkmcnt(" #n ")" ::: "memory")
#define PG8_BAR __builtin_amdgcn_s_barrier()
#define PG8_SCHED __builtin_amdgcn_sched_barrier(0)
    Unit cur, nxt; int ui = 0;
    if (!S.next(0, cur)) return;
    S.a_ready(cur, wid, lane);
    f32x4 acc[2][2][4][2];
#pragma unroll
    for (int a = 0; a < 2; ++a)
#pragma unroll
        for (int b = 0; b < 2; ++b)
#pragma unroll
            for (int m = 0; m < 4; ++m)
#pragma unroll
                for (int n = 0; n < 2; ++n) acc[a][b][m][n] = (f32x4){0.f, 0.f, 0.f, 0.f};
    int one8 = 0x7f7f7f7f; asm volatile("" : "+v"(one8));
    bf16x8 At[4][2], B0[2][2], B1[2][2]; v8i_t At8[4], B08[2], B18[2];
    const char* cA = (const char*)g.A + (GATHER ? (size_t)0 : (size_t)cur.pm * tstep); const char* cB = (const char*)g.Bt + (size_t)cur.pb * tstep;
    unsigned ga[2][2], gnp[2];
    if constexpr (GATHER) {
#pragma unroll
        for (int i = 0; i < 2; ++i) { int R, C; stage_rc(tid * 16 + i * 8192, R, C);
            const unsigned t0 = (unsigned)S.row_token(0, R), t1 = (unsigned)S.row_token(0, 128 + R);
            ga[0][i] = t0 * (unsigned)RB + (unsigned)(C * 2); ga[1][i] = t1 * (unsigned)RB + (unsigned)(C * 2); gnp[i] = t0 | (t1 << 16); }
    }
    PG8_STAGE(PG8_SB(0, 0), cB, voffB); PG8_STAGE(PG8_SB(0, 1), cB + hstep, voffB); PG8_STAGE_A(PG8_SA(0, 0), cA, 0, false); PG8_STAGE_A(PG8_SA(0, 1), cA, 1, false);
    if (wr == 1) PG8_BAR;
    PG8_WAIT_V(2); PG8_BAR;
    PG8_STAGE(PG8_SB(1, 0), cB + kstep, voffB); PG8_STAGE_A(PG8_SA(1, 0), cA + kstep, 0, false); PG8_STAGE(PG8_SB(1, 1), cB + hstep + kstep, voffB);
    PG8_WAIT_V(6); PG8_BAR;
    for (;;) {
        const bool has_next = S.next(ui + 1, nxt);
        unsigned claim_ = 0u; S.claim_issue(ui + 2, wid, lane, claim_);
        if constexpr (GATHER) {
            if (has_next) {
                int ln2_; asm volatile("v_mbcnt_lo_u32_b32 %0, -1, 0\n\tv_mbcnt_hi_u32_b32 %0, -1, %0" : "=&v"(ln2_)); const int tid2_ = wid * 64 + ln2_;
#pragma unroll
                for (int i = 0; i < 2; ++i) { int R, C; stage_rc(tid2_ * 16 + i * 8192, R, C); gnp[i] = (unsigned)S.row_token(ui + 1, R) | ((unsigned)S.row_token(ui + 1, 128 + R) << 16); }
            }
        }
        const char* nA = (has_next && !GATHER) ? (const char*)g.A + (size_t)nxt.pm * tstep : cA; const char* nB = has_next ? (const char*)g.Bt + (size_t)nxt.pb * tstep : cB;
        for (int t = 0; t < nt; t += 2) {
            const bool last = (t == nt - 2);
            if (last) S.claim_commit(ui + 2, wid, lane, claim_);
            if (last && has_next) S.a_ready(nxt, wid, lane);
            const char* a1 = cA + (size_t)(t + 1) * kstep;
            const char* a2 = last ? nA : cA + (size_t)(t + 2) * kstep; const char* b2 = last ? nB : cB + (size_t)(t + 2) * kstep;
            const char* a3 = a2 + kstep; const char* b3 = b2 + kstep;
            PG8_LDB(B0, 0, 0); PG8_LDB(B1, 0, 1); PG8_SCHED; PG8_LDA(At, 0, 0); PG8_STAGE_A(PG8_SA(1, 1), a1, 1, false);
            PG8_WAIT_V(8); PG8_WAIT_L(0); PG8_BAR; PG8_MMA(0, 0, At, B0); PG8_MMA(0, 1, At, B1); PG8_BAR; PG8_SCHED;
            PG8_LDA(At, 0, 1); PG8_STAGE(PG8_SB(0, 0), b2, voffB); PG8_STAGE(PG8_SB(0, 1), b2 + hstep, voffB); PG8_STAGE_A(PG8_SA(0, 0), a2, 0, last);
            PG8_WAIT_V(8); PG8_WAIT_L(0); PG8_BAR; PG8_MMA(1, 0, At, B0); PG8_MMA(1, 1, At, B1); PG8_BAR; PG8_SCHED;
            PG8_LDB(B0, 1, 0); PG8_LDB(B1, 1, 1); PG8_SCHED; PG8_LDA(At, 1, 0); PG8_STAGE_A(PG8_SA(0, 1), a2, 1, last);
            PG8_WAIT_V(8); PG8_WAIT_L(0); PG8_BAR; PG8_MMA(0, 0, At, B0); PG8_MMA(0, 1, At, B1); PG8_BAR; PG8_SCHED;
            PG8_LDA(At, 1, 1); PG8_STAGE(PG8_SB(1, 0), b3, voffB); PG8_STAGE(PG8_SB(1, 1), b3 + hstep, voffB); PG8_STAGE_A(PG8_SA(1, 0), a3, 0, last);
            PG8_WAIT_V(8); PG8_WAIT_L(0); PG8_BAR; PG8_MMA(1, 0, At, B0); PG8_MMA(1, 1, At, B1); PG8_BAR; PG8_SCHED;
        }
        if constexpr (ALIGN_EPI) { if (wr == 0) PG8_BAR; }
        if constexpr (F8) asm volatile("s_nop 7\n\ts_nop 7" ::: "memory");
        { int ln_; asm volatile("v_mbcnt_lo_u32_b32 %0, -1, 0\n\tv_mbcnt_hi_u32_b32 %0, -1, %0" : "=&v"(ln_)); E(acc, cur, wr, wc, ln_ & 15, ln_ >> 4); S.done(cur, ln_); }
        if (!has_next) break;
#pragma unroll
        for (int a = 0; a < 2; ++a)
#pragma unroll
            for (int b = 0; b < 2; ++b)
#pragma unroll
                for (int m = 0; m < 4; ++m)
#pragma unroll
                    for (int n = 0; n < 2; ++n) acc[a][b][m][n] = (f32x4){0.f, 0.f, 0.f, 0.f};
        cur = nxt; cA = nA; cB = nB; ++ui;
        if constexpr (GATHER) {
#pragma unroll
            for (int h = 0; h < 2; ++h)
#pragma unroll
                for (int i = 0; i < 2; ++i) ga[h][i] = ((gnp[i] >> (16 * h)) & 0xffffu) * (unsigned)RB + (ga[h][i] & (unsigned)(RB - 1));
        }
        if constexpr (ALIGN_EPI) { if (wr == 1) PG8_BAR; }
    }
    PG8_WAIT_V(0);
    if constexpr (!ALIGN_EPI) { if (wr == 0) PG8_BAR; }
    PG8_BAR;
#undef PG8_SA
#undef PG8_SB
#undef PG8_STAGE
#undef PG8_STAGE_A
#undef PG8_LDA
#undef PG8_LDB
#undef PG8_MMA
#undef PG8_LD16
#undef PG8_WAIT_V
#undef PG8_WAIT_L
#undef PG8_BAR
#undef PG8_SCHED
}
}
#ifndef MK_REPEAT
#define MK_REPEAT -1
#endif
namespace mk {
constexpr int NB = 16, S = 2048, T = NB * S, D = 1024, NCOL = 2304, NE = 16, FF = 512;
constexpr float ALPHA = 1.4142135623730951f, LN_EPS = 1e-5f, LOG2E = 1.4426950408889634f;
constexpr int NWAVES = 8, NTHREADS = 512;
constexpr int MAXROWS = 69632;
constexpr int MAXTILES = 272;

constexpr size_t MiB = 1u << 20;
constexpr size_t WS_CTL = 0, CTL_ZERO_BYTES = 1 * MiB;
constexpr size_t WS_ROPE = 1 * MiB;
constexpr size_t WS_TOKE = WS_ROPE + 256 * 1024;
constexpr size_t WS_TOKG = WS_TOKE + 256 * 1024;
constexpr size_t WS_TOKP = WS_TOKG + 256 * 1024;
constexpr size_t WS_STATS = 2 * MiB;
constexpr size_t WS_LSE = 3 * MiB;
constexpr size_t WS_WPT = 6 * MiB;
constexpr size_t WS_WST = 6 * MiB + 64 * 1024;
constexpr size_t WS_RWQ = 6 * MiB + 512 * 1024;
constexpr size_t WS_CR = 6 * MiB + 768 * 1024;
constexpr size_t WS_C1P = 7 * MiB;
constexpr size_t WS_C2P = 7 * MiB + 256 * 1024;
constexpr size_t WS_WIN8 = 8 * MiB, WS_WINB = 12 * MiB, WS_WOUT = 17 * MiB, WS_WGU = 21 * MiB, WS_WDN = 85 * MiB;
constexpr size_t WS_XB8 = 445 * MiB;
constexpr size_t WS_Y1B = 117 * MiB;
constexpr size_t WS_TLIST = 181 * MiB;
constexpr size_t WS_GLIST = 183 * MiB;
constexpr size_t WS_Y1F = 185 * MiB;
constexpr size_t WS_YB = 245 * MiB;
constexpr size_t WS_HB = 381 * MiB;
constexpr size_t WS_Q = 117 * MiB, WS_K = 149 * MiB, WS_V = 181 * MiB, WS_U = 213 * MiB, WS_G = 229 * MiB, WS_Z = 245 * MiB;
constexpr size_t WS_PO = 261 * MiB;
constexpr size_t WS_CC = 445 * MiB;
constexpr size_t WS_END = 509 * MiB;
constexpr int CW_CNT = 64;
constexpr int CW_BAR = 4096;
constexpr int CW_Q = 128;
constexpr int CW_RDY = 65536;

constexpr int RING_BYTES = 131072;
constexpr int MISC_OFF = RING_BYTES + 320;
constexpr int TAB_OFF = RING_BYTES + 1024;
constexpr int LDS_BYTES = 147456;

#define GAS __attribute__((address_space(1)))
#define LAS __attribute__((address_space(3)))
typedef unsigned short bf16;
typedef unsigned v4u __attribute__((ext_vector_type(4)));
typedef unsigned v2u __attribute__((ext_vector_type(2)));
typedef float f32x4 __attribute__((ext_vector_type(4)));
typedef float f32x2 __attribute__((ext_vector_type(2)));
typedef float f32x16 __attribute__((ext_vector_type(16)));
typedef short bf16x8 __attribute__((ext_vector_type(8)));
typedef short s16x4 __attribute__((ext_vector_type(4)));
typedef __bf16 bf16x2_t __attribute__((ext_vector_type(2)));
typedef GAS unsigned gu32;
#define RLX_AGENT __ATOMIC_RELAXED, __HIP_MEMORY_SCOPE_AGENT
#define LDS_WAIT() asm volatile("s_waitcnt lgkmcnt(0)" ::: "memory")

__device__ __forceinline__ unsigned pk2(float lo, float hi) { f32x2 v = {lo, hi}; bf16x2_t r = __builtin_convertvector(v, bf16x2_t); return __builtin_bit_cast(unsigned, r); }
__device__ __forceinline__ unsigned pk4_fp8(float a, float b, float c, float d) { int r = 0; r = __builtin_amdgcn_cvt_pk_fp8_f32(a, b, r, false); r = __builtin_amdgcn_cvt_pk_fp8_f32(c, d, r, true); return (unsigned)r; }
__device__ __forceinline__ float fp8_rt(float a) { const int r = __builtin_amdgcn_cvt_pk_fp8_f32(a, a, 0, false); return __builtin_amdgcn_cvt_f32_fp8(r, 0); }
constexpr float W8_SCALE = 64.0f, H8_SCALE = 8.0f, Y8_SCALE = 16.0f;
__device__ __forceinline__ float bflo(unsigned u) { return __builtin_bit_cast(float, u << 16); }
__device__ __forceinline__ float bfhi(unsigned u) { return __builtin_bit_cast(float, u & 0xffff0000u); }
__device__ __forceinline__ float wave_sum(float v) {
#pragma unroll
    for (int o = 1; o < 64; o <<= 1) v += __shfl_xor(v, o);
    return v;
}
__device__ __forceinline__ float fast_exp2(float x) { return __builtin_amdgcn_exp2f(x); }
__device__ __forceinline__ float fast_rcp(float x) { return __builtin_amdgcn_rcpf(x); }
__device__ __forceinline__ float gelu_t(float x) {
    const float y = x * (1.5957691216057308f + 0.07135481627159498f * x * x);
    return x * fast_rcp(1.0f + fast_exp2(-LOG2E * y));
}
__device__ __forceinline__ float silu_f(float x) { return x * fast_rcp(1.0f + fast_exp2(-LOG2E * x)); }
__device__ __forceinline__ int crow(int reg, int h) { return (reg & 3) + 8 * (reg >> 2) + 4 * h; }

#define XB_TMO      128
#define XB_XCNT(j)  (256  + 64 * (j))
#define XB_XSUB(j)  (1280 + 64 * (j))
#define XB_XGEN(j)  (2304 + 64 * (j))
#define XB_TOP      3328
#define XB_TOPGEN   3392
#define XCD_BAR_WORDS 3456
#define XB_SPIN_CAP (1u << 22)
__device__ __forceinline__ unsigned xb_ld(unsigned* p)              { return __hip_atomic_load(p, __ATOMIC_RELAXED, __HIP_MEMORY_SCOPE_AGENT); }
__device__ __forceinline__ unsigned xb_add(unsigned* p, unsigned v) { return __hip_atomic_fetch_add(p, v, __ATOMIC_RELAXED, __HIP_MEMORY_SCOPE_AGENT); }
__device__ __forceinline__ unsigned xb_xcc_id() { return (unsigned)__builtin_amdgcn_s_getreg((3 << 11) | 20) & 0xFu; }
#define XB_SPIN(cond, bar) do { unsigned _sp = 0; while (cond) { __builtin_amdgcn_s_sleep(1); \
    if ((++_sp & 255u) == 0u) { if (xb_ld(&(bar)[XB_TMO])) break; if (_sp > XB_SPIN_CAP) { atomicAdd(&(bar)[XB_TMO], 1u); break; } } } } while (0)
struct XcdBarrier { unsigned* bar; unsigned x; volatile LAS unsigned* st; };
__device__ __forceinline__ XcdBarrier xcd_barrier_post(unsigned* bar, volatile LAS unsigned* st, int tid) {
    XcdBarrier b; b.bar = bar; b.x = xb_xcc_id(); b.st = st;
    if (tid == 0) (void)xb_add(&bar[XB_XCNT(b.x)], 1u);
    return b;
}
__device__ __forceinline__ void xcd_barrier_complete(unsigned* bar, unsigned x, unsigned& nloc, unsigned& nx) {
    const unsigned G = gridDim.x * gridDim.y * gridDim.z;
    unsigned sum, cnt, mine, sp = 0u;
    for (;;) {
        sum = 0u; cnt = 0u; mine = 0u;
#pragma unroll
        for (unsigned j = 0; j < 16; ++j) { const unsigned c = xb_ld(&bar[XB_XCNT(j)]); sum += c; cnt += (c > 0u) ? 1u : 0u; mine = (j == x) ? c : mine; }
        if (sum == G) break;
        __builtin_amdgcn_s_sleep(1);
        if ((++sp & 255u) == 0u) { if (xb_ld(&bar[XB_TMO])) break; if (sp > XB_SPIN_CAP) { atomicAdd(&bar[XB_TMO], 1u); break; } }
    }
    nloc = mine > 0u ? mine : 1u; nx = cnt > 0u ? cnt : 1u;
}
__device__ __forceinline__ void xcd_barrier(const XcdBarrier& b, int tid) {
    asm volatile("s_waitcnt vmcnt(0)" ::: "memory");
    __syncthreads();
    if (tid == 0) {
        unsigned* bar = b.bar;
        __builtin_amdgcn_s_waitcnt(0);
        unsigned nloc = b.st[0], nx = b.st[1];
        if (nloc == 0u) { xcd_barrier_complete(bar, b.x, nloc, nx); b.st[0] = nloc; b.st[1] = nx; }
        const unsigned old = xb_add(&bar[XB_XSUB(b.x)], 1u);
        const unsigned gen = old / nloc;
        if (old + 1u == (gen + 1u) * nloc) {
            __builtin_amdgcn_fence(__ATOMIC_RELEASE, "agent");
            asm volatile("s_waitcnt vmcnt(0)" ::: "memory");
            const unsigned og = xb_add(&bar[XB_TOP], 1u);
            const unsigned tg = og / nx;
            if (og + 1u == (tg + 1u) * nx) xb_add(&bar[XB_TOPGEN], 1u);
            else XB_SPIN(xb_ld(&bar[XB_TOPGEN]) == tg, bar);
            __builtin_amdgcn_fence(__ATOMIC_ACQUIRE, "agent");
            xb_add(&bar[XB_XGEN(b.x)], 1u);
            asm volatile("s_waitcnt vmcnt(0)" ::: "memory");
        } else {
            XB_SPIN(xb_ld(&bar[XB_XGEN(b.x)]) == gen, bar);
            __builtin_amdgcn_fence(__ATOMIC_ACQUIRE, "agent");
            asm volatile("s_waitcnt vmcnt(0)" ::: "memory");
        }
    }
    __syncthreads();
}

#ifdef NO_FENCE
#define EPI_FENCE() do {} while (0)
#else
#define EPI_FENCE() asm volatile("" ::: "memory")
#endif
using pg8::Unit;
struct EpiProj {
    static constexpr bool PERM = true;
    unsigned char* ws; const float *lg, *lb; float accscale;
    static __device__ __forceinline__ void store16(bf16* dst, const f32x4 (&v)[2]) {
        v4u w; w.x = pk2(v[0][0], v[0][1]); w.y = pk2(v[0][2], v[0][3]); w.z = pk2(v[1][0], v[1][1]); w.w = pk2(v[1][2], v[1][3]);
        *(v4u*)dst = w;
    }
    template <int MODE>
    __device__ __forceinline__ void run(const f32x4 (&acc)[2][2][4][2], const Unit& u, int wr, int wc, int fr, int fq) const {
        const int pn = u.pn;
        const int rowb = u.pm * 256 + wr * 64 + fr;
        bf16* dbase; int cstep = 128, rstride = 512;
        if (MODE == 0) dbase = nullptr;
        else if (MODE == 1) { if (pn < 6) dbase = (bf16*)(ws + WS_V) + (pn - 4) * 256 + wc * 32 + 8 * fq; else { dbase = (bf16*)(ws + WS_Z) + wc * 32 + 8 * fq; rstride = 256; } }
        else if (MODE == 2) { dbase = (bf16*)(ws + WS_U) + wc * 32 + 8 * fq; rstride = 256; }
        else { dbase = (bf16*)(ws + WS_G) + wc * 64 + 8 * fq; rstride = 256; cstep = 32; }
        const bool dorope = ((wc & 1) == 0) && (fq < 2);
        const float sc = accscale;
        const float* rope = (const float*)(ws + WS_ROPE) + (size_t)(4 * (fq & 1)) * 2;
        f32x4 rc[4][2];
        if (MODE == 0) {
#pragma unroll
            for (int g = 0; g < 4; ++g) { const int pos = (rowb + (g >> 2) * 128 + (g & 3) * 16) & (S - 1);
                rc[g][0] = *(const f32x4*)(rope + (size_t)pos * 16); rc[g][1] = *(const f32x4*)(rope + (size_t)pos * 16 + 4); }
        }
        f32x4 lgv[2][2], lbv[2][2];
        if (MODE == 3) {
#pragma unroll
            for (int bj = 0; bj < 2; ++bj)
#pragma unroll
                for (int n = 0; n < 2; ++n) { const int dim = wc * 64 + 32 * bj + 8 * fq + 4 * n; lgv[bj][n] = *(const f32x4*)(lg + dim); lbv[bj][n] = *(const f32x4*)(lb + dim); }
        }
#pragma unroll
        for (int g = 0; g < 8; ++g) {
            const int ai = g >> 2, m = g & 3;
            const int row = rowb + ai * 128 + m * 16;
            f32x4 v[2][2];
#pragma unroll
            for (int bj = 0; bj < 2; ++bj)
#pragma unroll
                for (int n = 0; n < 2; ++n) v[bj][n] = (MODE == 1) ? acc[ai][bj][m][n] * accscale : acc[ai][bj][m][n];
            if (MODE == 0) {
                const f32x4 cs0 = rc[g & 3][0], cs1 = rc[g & 3][1];
                if (g + 4 < 8) { const int pos = (rowb + ((g + 4) >> 2) * 128 + ((g + 4) & 3) * 16) & (S - 1);
                    rc[g & 3][0] = *(const f32x4*)(rope + (size_t)pos * 16); rc[g & 3][1] = *(const f32x4*)(rope + (size_t)pos * 16 + 4); }
                if (dorope) {
#pragma unroll
                    for (int bj = 0; bj < 2; ++bj) {
                        float a, b;
                        a = v[bj][0][0]; b = v[bj][0][1]; v[bj][0][0] = a * cs0[0] - b * cs0[1]; v[bj][0][1] = b * cs0[0] + a * cs0[1];
                        a = v[bj][0][2]; b = v[bj][0][3]; v[bj][0][2] = a * cs0[2] - b * cs0[3]; v[bj][0][3] = b * cs0[2] + a * cs0[3];
                        a = v[bj][1][0]; b = v[bj][1][1]; v[bj][1][0] = a * cs1[0] - b * cs1[1]; v[bj][1][1] = b * cs1[0] + a * cs1[1];
                        a = v[bj][1][2]; b = v[bj][1][3]; v[bj][1][2] = a * cs1[2] - b * cs1[3]; v[bj][1][3] = b * cs1[2] + a * cs1[3];
                    }
                }
#pragma unroll
                for (int bj = 0; bj < 2; ++bj)
#pragma unroll
                    for (int n = 0; n < 2; ++n) v[bj][n] = v[bj][n] * sc;
            }
            if (MODE == 2 || MODE == 3) {
#pragma unroll
                for (int bj = 0; bj < 2; ++bj)
#pragma unroll
                    for (int n = 0; n < 2; ++n)
#pragma unroll
                        for (int e = 0; e < 4; ++e) v[bj][n][e] = gelu_t(v[bj][n][e]);
            }
            if (MODE == 3) {
                float s = 0.f;
#pragma unroll
                for (int bj = 0; bj < 2; ++bj)
#pragma unroll
                    for (int n = 0; n < 2; ++n) s += (v[bj][n][0] + v[bj][n][1]) + (v[bj][n][2] + v[bj][n][3]);
                s += __shfl_xor(s, 16); s += __shfl_xor(s, 32);
                const float mu = s * (1.0f / 64.0f); float q = 0.f;
#pragma unroll
                for (int bj = 0; bj < 2; ++bj)
#pragma unroll
                    for (int n = 0; n < 2; ++n)
#pragma unroll
                        for (int e = 0; e < 4; ++e) { v[bj][n][e] -= mu; q += v[bj][n][e] * v[bj][n][e]; }
                q += __shfl_xor(q, 16); q += __shfl_xor(q, 32);
                const float rstd = rsqrtf(q * (1.0f / 64.0f) + LN_EPS);
#pragma unroll
                for (int bj = 0; bj < 2; ++bj)
#pragma unroll
                    for (int n = 0; n < 2; ++n) v[bj][n] = v[bj][n] * rstd * lgv[bj][n] + lbv[bj][n];
            }
            if (MODE == 0) {
                unsigned char* d8 = ws + (pn < 2 ? WS_Q : WS_K) + (size_t)row * 512 + (pn & 1) * 256 + wc * 32 + 8 * fq;
                v2u w0; w0.x = pk4_fp8(v[0][0][0], v[0][0][1], v[0][0][2], v[0][0][3]); w0.y = pk4_fp8(v[0][1][0], v[0][1][1], v[0][1][2], v[0][1][3]); *(v2u*)d8 = w0;
                v2u w1; w1.x = pk4_fp8(v[1][0][0], v[1][0][1], v[1][0][2], v[1][0][3]); w1.y = pk4_fp8(v[1][1][0], v[1][1][1], v[1][1][2], v[1][1][3]); *(v2u*)(d8 + 128) = w1;
            } else {
                bf16* dst = dbase + (size_t)row * rstride;
                store16(dst, v[0]); store16(dst + cstep, v[1]);
            }
            EPI_FENCE();
        }
    }
    __device__ __forceinline__ void operator()(const f32x4 (&acc)[2][2][4][2], const Unit& u, int wr, int wc, int fr, int fq) const {
        const int pn = u.pn;
        if (pn < 4) run<0>(acc, u, wr, wc, fr, fq);
        else if (pn == 6) run<2>(acc, u, wr, wc, fr, fq);
        else if (pn == 7) run<3>(acc, u, wr, wc, fr, fq);
        else run<1>(acc, u, wr, wc, fr, fq);
    }
};
struct EpiOutB {
    static constexpr bool PERM = true;
    const bf16* xres; bf16* Y; unsigned char* Y8;
    __device__ __forceinline__ void operator()(const f32x4 (&acc)[2][2][4][2], const Unit& u, int wr, int wc, int fr, int fq) const {
        const size_t off0 = (size_t)(u.pm * 256 + wr * 64 + fr) * D + u.pn * 256 + wc * 32 + 8 * fq;
        v4u xr[4][2];
#pragma unroll
        for (int g = 0; g < 4; ++g) { const size_t off = off0 + (size_t)((g >> 2) * 128 + (g & 3) * 16) * D; xr[g][0] = *(const v4u*)(xres + off); xr[g][1] = *(const v4u*)(xres + off + 128); }
#pragma unroll
        for (int g = 0; g < 8; ++g) {
            const int ai = g >> 2, m = g & 3;
            const size_t off = off0 + (size_t)(ai * 128 + m * 16) * D;
            const v4u x0 = xr[g & 3][0], x1 = xr[g & 3][1];
            if (g + 4 < 8) { const size_t offn = off0 + (size_t)(((g + 4) >> 2) * 128 + ((g + 4) & 3) * 16) * D; xr[g & 3][0] = *(const v4u*)(xres + offn); xr[g & 3][1] = *(const v4u*)(xres + offn + 128); }
#pragma unroll
            for (int bj = 0; bj < 2; ++bj) {
                const v4u x = bj ? x1 : x0;
                const f32x4 a = acc[ai][bj][m][0], b = acc[ai][bj][m][1];
                v4u w; w.x = pk2(a[0] + ALPHA * bflo(x.x), a[1] + ALPHA * bfhi(x.x)); w.y = pk2(a[2] + ALPHA * bflo(x.y), a[3] + ALPHA * bfhi(x.y));
                w.z = pk2(b[0] + ALPHA * bflo(x.z), b[1] + ALPHA * bfhi(x.z)); w.w = pk2(b[2] + ALPHA * bflo(x.w), b[3] + ALPHA * bfhi(x.w));
                *(v4u*)(Y + off + bj * 128) = w;
                v2u w8; w8.x = pk4_fp8(a[0] + ALPHA * bflo(x.x), a[1] + ALPHA * bfhi(x.x), a[2] + ALPHA * bflo(x.y), a[3] + ALPHA * bfhi(x.y));
                w8.y = pk4_fp8(b[0] + ALPHA * bflo(x.z), b[1] + ALPHA * bfhi(x.z), b[2] + ALPHA * bflo(x.w), b[3] + ALPHA * bfhi(x.w));
                *(v2u*)(Y8 + off + bj * 128) = w8;
            }
            EPI_FENCE();
        }
    }
};
struct EpiGU {
    static constexpr bool PERM = true;
    unsigned char* ws; const LAS float* meta; int l;
    __device__ __forceinline__ void operator()(const f32x4 (&acc)[2][2][4][2], const Unit& u, int wr, int wc, int fr, int fq) const {
        const int cb = u.e * 1024 + u.pn * 256 + wc * 32 + 8 * fq;
        unsigned char* H = ws + WS_HB;
        const float* c1a = (const float*)(ws + WS_C1P) + (size_t)l * 16 * 1024; const float* c1b = c1a + 32 * 1024; const float* c2a = c1a + 65536; const float* c2b = c2a + 32 * 1024;
        float c1[2][8], c2[2][8];
#pragma unroll
        for (int bj = 0; bj < 2; ++bj)
#pragma unroll
            for (int n = 0; n < 2; ++n) {
                const f32x4 a = *(const f32x4*)(c1a + cb + bj * 128 + 4 * n), b = *(const f32x4*)(c1b + cb + bj * 128 + 4 * n);
                const f32x4 c = *(const f32x4*)(c2a + cb + bj * 128 + 4 * n), d = *(const f32x4*)(c2b + cb + bj * 128 + 4 * n);
#pragma unroll
                for (int e = 0; e < 4; ++e) { c1[bj][4 * n + e] = a[e] + b[e]; c2[bj][4 * n + e] = c[e] + d[e]; }
            }
#pragma unroll
        for (int ai = 0; ai < 2; ++ai)
#pragma unroll
            for (int m = 0; m < 4; ++m) {
                const int rl = ai * 128 + wr * 64 + m * 16 + fr;
                const f32x2 st = *(const LAS f32x2*)(meta + 2 * (u.ui * 256 + rl));
                float hv[8];
#pragma unroll
                for (int n = 0; n < 2; ++n)
#pragma unroll
                    for (int e = 0; e < 4; ++e) {
                        const float g = st.y * (acc[ai][0][m][n][e] * (1.0f / W8_SCALE) - st.x * c1[0][4 * n + e]) + c2[0][4 * n + e];
                        const float up = st.y * (acc[ai][1][m][n][e] * (1.0f / W8_SCALE) - st.x * c1[1][4 * n + e]) + c2[1][4 * n + e];
                        hv[4 * n + e] = silu_f(g) * up * H8_SCALE;
                    }
                v2u w; w.x = pk4_fp8(hv[0], hv[1], hv[2], hv[3]); w.y = pk4_fp8(hv[4], hv[5], hv[6], hv[7]);
                { unsigned char* hp = H + (size_t)(u.pm * 256 + rl) * FF + u.pn * 128 + wc * 32 + 8 * fq;
                  asm volatile("global_store_dwordx2 %0, %1, off sc1" :: "v"(hp), "v"(w) : "memory"); }
                EPI_FENCE();
            }
    }
};
struct EpiDown {
    static constexpr bool PERM = true;
    unsigned char* Y;
    __device__ __forceinline__ void operator()(const f32x4 (&acc)[2][2][4][2], const Unit& u, int wr, int wc, int fr, int fq) const {
        constexpr float gs = Y8_SCALE / (W8_SCALE * H8_SCALE);
#pragma unroll
        for (int ai = 0; ai < 2; ++ai)
#pragma unroll
            for (int m = 0; m < 4; ++m) {
                const int rl = ai * 128 + wr * 64 + m * 16 + fr;
#pragma unroll
                for (int bj = 0; bj < 2; ++bj) {
                    const f32x4 a = acc[ai][bj][m][0] * gs, b = acc[ai][bj][m][1] * gs;
                    v2u w; w.x = pk4_fp8(a[0], a[1], a[2], a[3]); w.y = pk4_fp8(b[0], b[1], b[2], b[3]);
                    *(v2u*)(Y + (size_t)(u.pm * 256 + rl) * D + u.pn * 256 + bj * 128 + wc * 32 + 8 * fq) = w;
                }
                EPI_FENCE();
            }
    }
};

__device__ __forceinline__ int win_src_col(int n) {
    if (n < 1024) { int t = n & 63; const int hb = n & ~63; if (t < 16) t = (t & 1) ? 8 + (t >> 1) : (t >> 1); return hb + t; }
    if (n >= 1792 && n < 2048) { const int t = n - 1792, bj = t >> 7, wc = (t >> 5) & 3, j = t & 31; return 1792 + 64 * wc + 32 * bj + j; }
    return n;
}
__device__ __forceinline__ int cc_dim(int p, int kind) {
    if (kind == 1) { const int hh = p >> 5, j = p & 31; return (j < 16 ? 0 : 32) + 8 * ((j & 15) >> 2) + 4 * hh + (j & 3); }
    if (kind == 2) { const int db = p >> 5, hh = (p >> 4) & 1, g4 = (p >> 2) & 3, e = p & 3; return 32 * db + 8 * g4 + 4 * hh + e; }
    return p;
}
__device__ __forceinline__ void p0_tr_item(const float* cp, int ld, int K, bf16* WT, int k0, int n0, LAS float* scr, int lane, bool ntst = false, int kind = 0) {
    float v[32];
#pragma unroll
    for (int i = 0; i < 32; ++i) v[i] = __builtin_nontemporal_load(cp + (size_t)(k0 + cc_dim(2 * i + (lane >> 5), kind)) * ld);
#pragma unroll
    for (int i = 0; i < 32; ++i) scr[(2 * i + (lane >> 5)) * 33 + (lane & 31)] = v[i];
    LDS_WAIT(); asm volatile("" ::: "memory");
    const int c = lane & 7;
#pragma unroll
    for (int j = 0; j < 4; ++j) { const int n = (lane >> 3) + 8 * j; const LAS float* s = scr + (8 * c) * 33 + n;
        v4u o; o.x = pk2(s[0 * 33], s[1 * 33]); o.y = pk2(s[2 * 33], s[3 * 33]); o.z = pk2(s[4 * 33], s[5 * 33]); o.w = pk2(s[6 * 33], s[7 * 33]);
        if (ntst) __builtin_nontemporal_store(o, (v4u*)(WT + (size_t)(n0 + n) * K + k0 + 8 * c)); else *(v4u*)(WT + (size_t)(n0 + n) * K + k0 + 8 * c) = o; }
    LDS_WAIT(); asm volatile("" ::: "memory");
}
__device__ __forceinline__ void p0_gu_item(const float* cp, int ld, const float* gk, const float* bk, bf16* WT, int n0, int kh, float* c1p, float* c2p, LAS float* scr, int lane) {
    float c1 = 0.f, c2 = 0.f;
    for (int kb = kh * 8; kb < kh * 8 + 8; ++kb) {
        const int k0 = 64 * kb;
        float v[32];
#pragma unroll
        for (int i = 0; i < 32; ++i) v[i] = __builtin_nontemporal_load(cp + (size_t)(k0 + 2 * i + (lane >> 5)) * ld);
#pragma unroll
        for (int i = 0; i < 32; ++i) { const int kk = 2 * i + (lane >> 5); const float w = v[i];
            const float r = bflo(pk2(w * gk[k0 + kk], 0.f)); c1 += r; c2 += bk[k0 + kk] * w; scr[kk * 33 + (lane & 31)] = r; }
        LDS_WAIT(); asm volatile("" ::: "memory");
        const int c = lane & 7;
#pragma unroll
        for (int j = 0; j < 4; ++j) { const int n = (lane >> 3) + 8 * j; const LAS float* sp = scr + (8 * c) * 33 + n;
            v4u o; o.x = pk2(sp[0 * 33], sp[1 * 33]); o.y = pk2(sp[2 * 33], sp[3 * 33]); o.z = pk2(sp[4 * 33], sp[5 * 33]); o.w = pk2(sp[6 * 33], sp[7 * 33]);
            __builtin_nontemporal_store(o, (v4u*)(WT + (size_t)(n0 + n) * D + k0 + 8 * c)); }
        LDS_WAIT(); asm volatile("" ::: "memory");
    }
    c1 += __shfl_xor(c1, 32); c2 += __shfl_xor(c2, 32);
    if (lane < 32) { c1p[n0 + lane] = c1; c2p[n0 + lane] = c2; }
}
__device__ __forceinline__ void p0_out8(unsigned char* WT8, int K, int k0, int n0, const LAS float* scr, int lane) {
    const int c = lane & 3;
#pragma unroll
    for (int j = 0; j < 2; ++j) { const int n = (lane >> 2) + 16 * j; const LAS float* sp = scr + (16 * c) * 33 + n;
        v4u o; o.x = pk4_fp8(sp[0 * 33], sp[1 * 33], sp[2 * 33], sp[3 * 33]); o.y = pk4_fp8(sp[4 * 33], sp[5 * 33], sp[6 * 33], sp[7 * 33]);
        o.z = pk4_fp8(sp[8 * 33], sp[9 * 33], sp[10 * 33], sp[11 * 33]); o.w = pk4_fp8(sp[12 * 33], sp[13 * 33], sp[14 * 33], sp[15 * 33]);
        __builtin_nontemporal_store(o, (v4u*)(WT8 + (size_t)(n0 + n) * K + k0 + 16 * c)); }
}
__device__ __forceinline__ void p0_tr_item8(const float* cp, int ld, int K, unsigned char* WT8, int k0, int n0, LAS float* scr, int lane) {
    float v[32];
#pragma unroll
    for (int i = 0; i < 32; ++i) v[i] = __builtin_nontemporal_load(cp + (size_t)(k0 + 2 * i + (lane >> 5)) * ld);
#pragma unroll
    for (int i = 0; i < 32; ++i) scr[(2 * i + (lane >> 5)) * 33 + (lane & 31)] = v[i] * W8_SCALE;
    LDS_WAIT(); asm volatile("" ::: "memory");
    p0_out8(WT8, K, k0, n0, scr, lane);
    LDS_WAIT(); asm volatile("" ::: "memory");
}
__device__ __forceinline__ void p0_gu_item8(const float* cp, int ld, const float* gk, const float* bk, unsigned char* WT8, int n0, int kh, float* c1p, float* c2p, LAS float* scr, int lane) {
    float c1 = 0.f, c2 = 0.f;
    for (int kb = kh * 8; kb < kh * 8 + 8; ++kb) {
        const int k0 = 64 * kb;
        float v[32];
#pragma unroll
        for (int i = 0; i < 32; ++i) v[i] = __builtin_nontemporal_load(cp + (size_t)(k0 + 2 * i + (lane >> 5)) * ld);
#pragma unroll
        for (int i = 0; i < 32; ++i) { const int kk = 2 * i + (lane >> 5); const float w = v[i];
            const float r = fp8_rt(w * gk[k0 + kk] * W8_SCALE); c1 += r; c2 += bk[k0 + kk] * w; scr[kk * 33 + (lane & 31)] = r; }
        LDS_WAIT(); asm volatile("" ::: "memory");
        p0_out8(WT8, D, k0, n0, scr, lane);
        LDS_WAIT(); asm volatile("" ::: "memory");
    }
    c1 += __shfl_xor(c1, 32); c2 += __shfl_xor(c2, 32);
    if (lane < 32) { c1p[n0 + lane] = c1 * (1.0f / W8_SCALE); c2p[n0 + lane] = c2; }
}
struct Ptrs {
    const float *x, *w_in, *w_out, *lg, *lb, *wsp, *bsp, *pw, *psc, *ln1g, *ln1b, *rw, *rb, *wg, *wu, *wd, *ln2g, *ln2b;
    float* out; unsigned char* ws;
};
__device__ __forceinline__ void p0_weights(const Ptrs& P, int l, LAS unsigned char* lds, int wave, int lane, int widx, int nw) {
    LAS float* scr = (LAS float*)(lds + wave * 16384);
    bf16* WOUT = (bf16*)(P.ws + WS_WOUT); unsigned char* WGU = P.ws + WS_WGU; unsigned char* WDN = P.ws + WS_WDN;
    constexpr int I_IN = 16 * 72, I_OUT = 16 * 32, I_GU = 2 * 32, I_DN = 8 * 32, N_HEAVY = 16 * I_GU, N_LIGHT = I_IN + I_OUT + 16 * I_DN;
    const int nh = nw < N_HEAVY ? nw : N_HEAVY;
    if (widx < nh) {
        for (int r0 = widx; r0 < N_HEAVY; r0 += nh) { int r = r0; const int e = r / I_GU; r -= e * I_GU; const int le = l * 16 + e, kh = r / 32, nb = r % 32;
            const int n = 32 * nb + (lane & 31), pn = n >> 8, t = n & 255;
            const float* cp = (t < 128 ? P.wg : P.wu) + (size_t)le * D * FF + 128 * pn + (t & 127);
            p0_gu_item8(cp, FF, P.ln1g + l * D, P.ln1b + l * D, WGU + (size_t)le * 1024 * D, 32 * nb, kh,
                       (float*)(P.ws + WS_C1P) + ((size_t)kh * 32 + le) * 1024, (float*)(P.ws + WS_C2P) + ((size_t)kh * 32 + le) * 1024, scr, lane); }
    }
    const int lw0 = nw > N_HEAVY ? N_HEAVY : 0, nlw = nw - lw0;
    if (widx >= lw0) {
        for (int it = widx - lw0; it < N_LIGHT; it += nlw) {
            int r = it;
            if (r < I_IN) { const int kb = r / 72, nb = r % 72;
                const float* cp = P.w_in + (size_t)l * D * NCOL + win_src_col(32 * nb + (lane & 31));
                if (nb < 48) p0_tr_item8(cp, NCOL, D, P.ws + WS_WIN8 + (size_t)l * 1536 * D, 64 * kb, 32 * nb, scr, lane);
                else p0_tr_item(cp, NCOL, D, (bf16*)(P.ws + WS_WINB) + (size_t)l * 768 * D, 64 * kb, 32 * (nb - 48), scr, lane, l != 0);
                continue; }
            r -= I_IN;
            if (r < I_OUT) { const int kb = r / 32, nb = r % 32;
                const float* cp = P.w_out + (size_t)l * D * D + 32 * nb + (lane & 31);
                p0_tr_item(cp, D, D, WOUT + (size_t)l * D * D, 64 * kb, 32 * nb, scr, lane, true, (kb >= 8 && kb < 12) ? 2 : 1); continue; }
            r -= I_OUT;
            { const int e = r / I_DN; r -= e * I_DN; const int le = l * 16 + e, kb = r / 32, nb = r % 32;
                const float* cp = P.wd + (size_t)le * FF * D + 32 * nb + (lane & 31);
                p0_tr_item8(cp, D, FF, WDN + (size_t)le * D * FF, 64 * kb, 32 * nb, scr, lane); }
        }
    }
}
__device__ __forceinline__ void p0_prologue(const Ptrs& P, LAS unsigned char* lds, int vcu, int G, int wave, int lane, int tid) {
    const int gw = vcu * NWAVES + wave, NGW = G * NWAVES;
    for (int rep_ = 0; rep_ < ((MK_REPEAT == 31) ? 2 : 1); ++rep_) {
    p0_weights(P, 0, lds, wave, lane, gw, NGW);
    p0_weights(P, 1, lds, wave, lane, (gw + NGW / 2) % NGW, NGW);
    }
    bf16* XB = (bf16*)(P.ws + WS_HB);
    for (int rep_ = 0; rep_ < ((MK_REPEAT == 32) ? 2 : 1); ++rep_)
    for (size_t i0 = (size_t)gw * 64 + lane; i0 < (size_t)T * D / 8; i0 += (size_t)NGW * 64 * 8) {
        f32x4 a[8], b[8];
#pragma unroll
        for (int u = 0; u < 8; ++u) { const size_t i = i0 + (size_t)u * NGW * 64; a[u] = __builtin_nontemporal_load((const f32x4*)(P.x + i * 8)); b[u] = __builtin_nontemporal_load((const f32x4*)(P.x + i * 8 + 4)); }
#pragma unroll
        for (int u = 0; u < 8; ++u) { const size_t i = i0 + (size_t)u * NGW * 64;
            v4u w; w.x = pk2(a[u][0], a[u][1]); w.y = pk2(a[u][2], a[u][3]); w.z = pk2(b[u][0], b[u][1]); w.w = pk2(b[u][2], b[u][3]);
            *(v4u*)(XB + i * 8) = w;
            v2u w8; w8.x = pk4_fp8(a[u][0], a[u][1], a[u][2], a[u][3]); w8.y = pk4_fp8(b[u][0], b[u][1], b[u][2], b[u][3]); *(v2u*)(P.ws + WS_XB8 + i * 8) = w8; }
    }
    const int gt = vcu * NTHREADS + tid, NGT = G * NTHREADS;
    float* rope = (float*)(P.ws + WS_ROPE);
    for (int i = gt; i < S * 8; i += NGT) { const int pos = i >> 3, k = i & 7;
        const float inv = powf(500000.0f, -(float)k / 8.0f); const float ang = (float)pos * inv;
        rope[2 * i] = cosf(ang); rope[2 * i + 1] = sinf(ang); }
    bf16* WPT = (bf16*)(P.ws + WS_WPT);
    for (int i = gt; i < 2 * 4 * 64 * 64; i += NGT) { const int ii = i & 63, o = (i >> 6) & 63, lgi = i >> 12;
        WPT[i] = (bf16)(pk2(P.pw[((size_t)lgi * 64 + ii) * 64 + o], 0.f) & 0xffffu); }
    bf16* WST = (bf16*)(P.ws + WS_WST);
    for (int i = gt; i < 2 * 4 * 128 * 128; i += NGT) WST[i] = (bf16)(pk2(P.wsp[i], 0.f) & 0xffffu);
    v4u* RWB = (v4u*)(P.ws + WS_RWQ);
    for (int i = gt; i < 2 * 32 * 3 * 64; i += NGT) { const int ln = i & 63, rest = i >> 6, term = rest % 3, j = (rest / 3) & 31, l = rest / 96; const int e = ln & 15, q = ln >> 4;
        unsigned w[4];
#pragma unroll
        for (int p = 0; p < 4; ++p) { unsigned hb[2];
#pragma unroll
            for (int h = 0; h < 2; ++h) { const int k = 32 * j + 8 * q + 2 * p + h; const float v = P.ln1g[l * D + k] * P.rw[(size_t)k * 16 + e];
                const unsigned b0 = pk2(v, 0.f) & 0xffffu; const float r1 = v - bflo(b0); const unsigned b1 = pk2(r1, 0.f) & 0xffffu; const float r2 = r1 - bflo(b1); const unsigned b2 = pk2(r2, 0.f) & 0xffffu;
                hb[h] = term == 0 ? b0 : (term == 1 ? b1 : b2); }
            w[p] = hb[0] | (hb[1] << 16); }
        RWB[i] = (v4u){w[0], w[1], w[2], w[3]}; }
    float* CR = (float*)(P.ws + WS_CR);
    if (gw < 32) { const int l = gw >> 4, e = gw & 15; float a = 0.f, b = 0.f;
        for (int j = 0; j < 16; ++j) { const int k = lane + 64 * j; const float w = P.rw[(size_t)k * 16 + e]; a += P.ln1g[l * D + k] * w; b += P.ln1b[l * D + k] * w; }
        a = wave_sum(a); b = wave_sum(b);
        if (lane == 0) { CR[l * 32 + e] = a; CR[l * 32 + 16 + e] = b; } }
}

#ifdef MK_PROBE
#ifndef MK_PSCALE
#define MK_PSCALE 2e-6f
#endif
#define PROBE_DECL() unsigned long long pt_ = 0; unsigned pacc_ = 0
#define PROBE_T0(id) do { if (MK_PROBE == (id)) pt_ = __builtin_amdgcn_s_memrealtime(); } while (0)
#define PROBE_T1(id) do { if (MK_PROBE == (id)) pacc_ += (unsigned)(__builtin_amdgcn_s_memrealtime() - pt_); } while (0)
#define PROBE_END(ws, cond) do { if (cond) atomicAdd((unsigned*)((ws) + WS_CTL) + 32, pacc_); } while (0)
#else
#define PROBE_DECL() do {} while (0)
#define PROBE_T0(id) do {} while (0)
#define PROBE_T1(id) do {} while (0)
#define PROBE_END(ws, cond) do {} while (0)
#endif
constexpr int KT_STRIDE = 144, VT_STRIDE = 192;
constexpr int ATT_WAVE_LDS = 32 * KT_STRIDE + 32 * VT_STRIDE;
using pg8::v8i_t; using pg8::v4i_t;
constexpr float ASCL = LOG2E * 0.125f;
#define MFMA32(a, b, c) __builtin_amdgcn_mfma_f32_32x32x16_bf16((a), (b), (c), 0, 0, 0)
__device__ __forceinline__ s16x4 tr16(LAS unsigned char* p) { return __builtin_amdgcn_ds_read_tr16_b64_v4i16((LAS s16x4*)p); }

constexpr int VT_ROW = 128, KT_ROW = 64, KT_OFF = 0, VTL_OFF = 65536;
struct AttItem { int dsh, r, j0, rbase; };
__device__ __forceinline__ AttItem att_item(int it, int sp, int wave) {
    AttItem a;
    if (it < 4)      { a.dsh = 0; a.r = 0;      const int js = 1024 * sp + 256 * it; a.j0 = js + 32 * wave; a.rbase = 64 - js; }
    else if (it < 8) { a.dsh = 2; a.r = it - 4; const int js = 256 * sp;             a.j0 = js + 32 * wave; a.rbase = 64 - js; }
    else             { a.dsh = 4; a.r = 4 * (it - 8) + (wave >> 1); a.j0 = 64 * sp + 32 * (wave & 1); a.rbase = 128 * (wave >> 1); }
    return a;
}
template <int RB>
__device__ __forceinline__ const unsigned char* att_src(const unsigned char* Xb, int it, int sp, size_t brow, int h, int rho, int ch) {
    if (it < 8) {
        const int dsh = it < 4 ? 0 : 2, r = it < 4 ? 0 : it - 4, js = it < 4 ? 1024 * sp + 256 * it : 256 * sp;
        int j = js - 64 + rho; j = j < 0 ? 0 : j; const int L = S >> dsh; j = j >= L ? L - 1 : j;
        return Xb + (brow + ((size_t)j << dsh) + r) * RB + h * (RB / 8) + ch * 16;
    }
    const int sl = (rho >> 7) & 3, j = rho & 127, r = 4 * (it - 8) + sl;
    return Xb + (brow + (size_t)j * 16 + r) * RB + h * (RB / 8) + ch * 16;
}
template <bool KSW>
__device__ __forceinline__ void att_fill(const unsigned char* Xb, int it, int sp, size_t brow, int h, LAS unsigned char* tile, int wave, int lane) {
    const int n = KSW ? (it < 8 ? 3 : 4) : (it < 8 ? 6 : 8);
    for (int k = 0; k < n; ++k) {
        const int ins = wave + 8 * k;
        const int rho = KSW ? 16 * ins + (lane >> 2) : 8 * ins + (lane >> 3);
        const int ch = KSW ? ((lane & 3) ^ ((rho >> 2) & 3)) : ((lane & 7) ^ (((rho >> 1) & 1) << 2));
        const unsigned char* src = KSW ? att_src<512>(Xb, it, sp, brow, h, rho, ch) : att_src<1024>(Xb, it, sp, brow, h, rho, ch);
        { unsigned keep_; const unsigned dst_ = (unsigned)(size_t)(tile + ins * 1024);
          asm volatile("s_mov_b32 %0, m0\n\ts_mov_b32 m0, %2\n\ts_nop 0\n\tglobal_load_lds_dwordx4 %1, off\n\ts_mov_b32 m0, %0" : "=&s"(keep_) : "v"(src), "s"(__builtin_amdgcn_readfirstlane(dst_)) : "memory"); }
    }
}
__device__ __forceinline__ void attn_scores(const v8i_t& qf, const AttItem& a, const LAS unsigned char* kt, int lane, const f32x16& m0, const f32x16& m4, f32x16 (&st)[5], int& kb_lo, int& kb_hi) {
    const int L = S >> a.dsh;
    const int qi = lane & 31, hh = lane >> 5;
    kb_lo = 2 - (a.j0 >> 5); if (kb_lo < 0) kb_lo = 0;
    kb_hi = ((L - a.j0) >> 5) + 1; if (kb_hi > 4) kb_hi = 4;
    const int row0 = a.rbase + a.j0 - 64 + qi;
    const int sw = (qi >> 2) & 3;
    f32x16 zero;
#pragma unroll
    for (int i = 0; i < 16; ++i) zero[i] = 0.f;
#pragma unroll
    for (int kb = 0; kb < 5; ++kb) {
        if (__builtin_expect(kb < kb_lo || kb > kb_hi, 0)) {
#pragma unroll
            for (int i = 0; i < 16; ++i) st[kb][i] = -1e30f;
        } else {
            const LAS unsigned char* kr = kt + (row0 + 32 * kb) * KT_ROW;
            const v4i_t k0 = *(const LAS v4i_t*)(kr + (((2 * hh) ^ sw) << 4)), k1 = *(const LAS v4i_t*)(kr + (((2 * hh + 1) ^ sw) << 4));
            const v8i_t kf = __builtin_shufflevector(k0, k1, 0, 1, 2, 3, 4, 5, 6, 7);
            st[kb] = __builtin_amdgcn_mfma_scale_f32_32x32x64_f8f6f4(kf, qf, kb == 0 ? m0 : (kb == 4 ? m4 : zero), 0, 0, 0, 0x7f7f7f7f, 0, 0x7f7f7f7f);
        }
    }
}
struct AttPart { v4u a[2], b[2]; float la, lb; };
constexpr float PO8_SCALE = 16.0f;
__device__ __forceinline__ float f8at(unsigned w, int e) { return e == 0 ? __builtin_amdgcn_cvt_f32_fp8((int)w, 0) : e == 1 ? __builtin_amdgcn_cvt_f32_fp8((int)w, 1) : e == 2 ? __builtin_amdgcn_cvt_f32_fp8((int)w, 2) : __builtin_amdgcn_cvt_f32_fp8((int)w, 3); }
__device__ __forceinline__ void attn_softmax_pv(f32x16 (&st)[5], const AttItem& a, int kb_lo, int kb_hi, const LAS unsigned char* vt, int lane,
                                                f32x16& o0, f32x16& o1, float& l_out, float& mxs_out) {
    const int qi = lane & 31, hh = lane >> 5;
    float mx = -1e30f;
#pragma unroll
    for (int kb = 0; kb < 5; ++kb)
#pragma unroll
        for (int i = 0; i < 16; ++i) mx = fmaxf(mx, st[kb][i]);
    mx = fmaxf(mx, __shfl_xor(mx, 32));
    const float mxs = mx * ASCL;
    float l = 0.f;
    bf16x8 pf[5][2];
#pragma unroll
    for (int kb = 0; kb < 5; ++kb) {
#pragma unroll
        for (int i = 0; i < 16; ++i) { const float pe = fast_exp2(st[kb][i] * ASCL - mxs); l += pe; st[kb][i] = pe; }
#pragma unroll
        for (int sx = 0; sx < 2; ++sx) { v4u w; w.x = pk2(st[kb][8 * sx], st[kb][8 * sx + 1]); w.y = pk2(st[kb][8 * sx + 2], st[kb][8 * sx + 3]); w.z = pk2(st[kb][8 * sx + 4], st[kb][8 * sx + 5]); w.w = pk2(st[kb][8 * sx + 6], st[kb][8 * sx + 7]);
            pf[kb][sx] = __builtin_bit_cast(bf16x8, w); }
    }
#pragma unroll
    for (int i = 0; i < 16; ++i) { o0[i] = 0.f; o1[i] = 0.f; }
    const int q4 = (lane & 15) >> 2, p4 = lane & 3, blk = (lane >> 4) & 1, sw = (q4 >> 1) & 1;
    const LAS unsigned char* vrow = vt + (a.rbase + a.j0 - 64 + 4 * hh + q4) * VT_ROW + 32 * blk + 8 * p4;
    const int c0 = sw ? 64 : 0, c1 = sw ? 0 : 64;
#pragma unroll
    for (int kb = 0; kb < 5; ++kb) {
        const int kbc = kb < kb_lo ? kb_lo : (kb > kb_hi ? kb_hi : kb);
        LAS unsigned char* vr = (LAS unsigned char*)vrow + (32 * kbc) * VT_ROW;
#pragma unroll
        for (int sx = 0; sx < 2; ++sx) {
            { const s16x4 lo = tr16(vr + (16 * sx) * VT_ROW + c0), hi = tr16(vr + (16 * sx + 8) * VT_ROW + c0);
              const bf16x8 vf = __builtin_shufflevector(lo, hi, 0, 1, 2, 3, 4, 5, 6, 7); o0 = MFMA32(vf, pf[kb][sx], o0); }
            { const s16x4 lo = tr16(vr + (16 * sx) * VT_ROW + c1), hi = tr16(vr + (16 * sx + 8) * VT_ROW + c1);
              const bf16x8 vf = __builtin_shufflevector(lo, hi, 0, 1, 2, 3, 4, 5, 6, 7); o1 = MFMA32(vf, pf[kb][sx], o1); }
        }
    }
    l += __shfl_xor(l, 32);
    l_out = l; mxs_out = mxs;
}
__device__ __forceinline__ void attn_store(unsigned char* __restrict__ POc, float* __restrict__ LSEc, const f32x16& o0, const f32x16& o1, float l, float mxs, int b, int h, const AttItem& a, int lane) {
    const int qi = lane & 31, hh = lane >> 5;
    const size_t qrow = (size_t)b * S + ((size_t)(a.j0 + qi) << a.dsh) + a.r;
    const float inv = PO8_SCALE / l;
    unsigned char* op = POc + qrow * 512 + h * 64 + 32 * hh;
    v4u w0, w1;
    w0.x = pk4_fp8(o0[0] * inv, o0[1] * inv, o0[2] * inv, o0[3] * inv);     w0.y = pk4_fp8(o0[4] * inv, o0[5] * inv, o0[6] * inv, o0[7] * inv);
    w0.z = pk4_fp8(o0[8] * inv, o0[9] * inv, o0[10] * inv, o0[11] * inv);   w0.w = pk4_fp8(o0[12] * inv, o0[13] * inv, o0[14] * inv, o0[15] * inv);
    w1.x = pk4_fp8(o1[0] * inv, o1[1] * inv, o1[2] * inv, o1[3] * inv);     w1.y = pk4_fp8(o1[4] * inv, o1[5] * inv, o1[6] * inv, o1[7] * inv);
    w1.z = pk4_fp8(o1[8] * inv, o1[9] * inv, o1[10] * inv, o1[11] * inv);   w1.w = pk4_fp8(o1[12] * inv, o1[13] * inv, o1[14] * inv, o1[15] * inv);
    *(v4u*)op = w0; *(v4u*)(op + 16) = w1;
    if (hh == 0) LSEc[qrow * 8 + h] = mxs + __log2f(l);
}

__device__ __forceinline__ void attn_store_fused(bf16* __restrict__ CC, const unsigned char* __restrict__ PO, const float* __restrict__ LSE, const f32x16& o0, const f32x16& o1, float l, float mxs, int b, int h, const AttItem& a, int lane) {
    const int qi = lane & 31, hh = lane >> 5;
    const size_t qrow = (size_t)b * S + ((size_t)(a.j0 + qi) << a.dsh) + a.r;
    AttPart part;
    { const unsigned char* po0 = PO + qrow * 512 + h * 64 + 32 * hh;
      part.a[0] = *(const v4u*)po0; part.a[1] = *(const v4u*)(po0 + 16);
      part.b[0] = *(const v4u*)(po0 + (size_t)T * 512); part.b[1] = *(const v4u*)(po0 + (size_t)T * 512 + 16);
      part.la = LSE[qrow * 8 + h]; part.lb = LSE[((size_t)T + qrow) * 8 + h]; }
    const float l2 = mxs + __log2f(l);
    const float mx = fmaxf(part.la, fmaxf(part.lb, l2));
    float w0 = fast_exp2(part.la - mx), w1 = fast_exp2(part.lb - mx), w2 = fast_exp2(l2 - mx);
    const float inv = 1.0f / (w0 + w1 + w2); w0 *= inv * (1.0f / PO8_SCALE); w1 *= inv * (1.0f / PO8_SCALE); w2 *= inv / l;
    bf16* op = CC + qrow * D + h * 64 + 32 * hh;
#pragma unroll
    for (int g2 = 0; g2 < 2; ++g2) {
        v4u wlo, whi;
#pragma unroll
        for (int s2 = 0; s2 < 2; ++s2) { const int g4 = 2 * g2 + s2;
            { const unsigned pa = part.a[0][g4], pb = part.b[0][g4];
              const unsigned x = pk2(w0 * f8at(pa, 0) + w1 * f8at(pb, 0) + w2 * o0[4 * g4], w0 * f8at(pa, 1) + w1 * f8at(pb, 1) + w2 * o0[4 * g4 + 1]);
              const unsigned y = pk2(w0 * f8at(pa, 2) + w1 * f8at(pb, 2) + w2 * o0[4 * g4 + 2], w0 * f8at(pa, 3) + w1 * f8at(pb, 3) + w2 * o0[4 * g4 + 3]);
              if (s2 == 0) { wlo.x = x; wlo.y = y; } else { wlo.z = x; wlo.w = y; } }
            { const unsigned pa = part.a[1][g4], pb = part.b[1][g4];
              const unsigned x = pk2(w0 * f8at(pa, 0) + w1 * f8at(pb, 0) + w2 * o1[4 * g4], w0 * f8at(pa, 1) + w1 * f8at(pb, 1) + w2 * o1[4 * g4 + 1]);
              const unsigned y = pk2(w0 * f8at(pa, 2) + w1 * f8at(pb, 2) + w2 * o1[4 * g4 + 2], w0 * f8at(pa, 3) + w1 * f8at(pb, 3) + w2 * o1[4 * g4 + 3]);
              if (s2 == 0) { whi.x = x; whi.y = y; } else { whi.z = x; whi.w = y; } }
        }
        *(v4u*)(op + 8 * g2) = wlo; *(v4u*)(op + 16 + 8 * g2) = whi;
    }
}

__device__ __forceinline__ void p2_attention(const unsigned char* ws, unsigned char* wsw, LAS unsigned char* lds, int vcu, int G, int wave, int lane_in, int tid) {
    const unsigned char* Qb = ws + WS_Q; const unsigned char* Kb = ws + WS_K; const unsigned char* Vb = ws + WS_V;
    unsigned char* PO = wsw + WS_PO; float* LSE = (float*)(wsw + WS_LSE); bf16* CC = (bf16*)(wsw + WS_CC);
    LAS unsigned char* ktile = lds + KT_OFF; LAS unsigned char* vtile = lds + VTL_OFF;
    PROBE_DECL(); PROBE_T0(1);
    f32x16 m0, m4;
    { const int qi0 = lane_in & 31, hh0 = lane_in >> 5;
#pragma unroll
      for (int i = 0; i < 16; ++i) { const int kl = crow(i, hh0); m0[i] = kl < qi0 ? -1e30f : 0.f; m4[i] = kl > qi0 ? -1e30f : 0.f; } }
    for (int item = vcu; item < NB * 8 * 2; item += G) {
        const int sp = item & 1, h = (item >> 1) & 7, b = item >> 4;
        const size_t brow = (size_t)b * S;
        v4i_t qn[2];
#pragma unroll 1
        for (int it = -1; it < 12; ++it) {
            int lane = lane_in; asm volatile("" : "+v"(lane));
            const int qi = lane & 31, hh = lane >> 5;
            f32x16 st[5]; int kb_lo = 0, kb_hi = 4;
            AttItem a = att_item(it < 0 ? 0 : it, sp, wave);
            const int c = it >> 2;
            if (it >= 0) {
                PROBE_T0(2);
                if (it < 8) asm volatile("s_waitcnt vmcnt(6)" ::: "memory"); else asm volatile("s_waitcnt vmcnt(8)" ::: "memory");
                PROBE_T1(2); PROBE_T0(6);
                __builtin_amdgcn_s_barrier(); asm volatile("" ::: "memory");
                PROBE_T1(6);
                asm volatile("" : "+v"(qn[0]), "+v"(qn[1]));
                const v8i_t qf = __builtin_shufflevector(qn[0], qn[1], 0, 1, 2, 3, 4, 5, 6, 7);
                PROBE_T0(3);
                attn_scores(qf, a, ktile, lane, m0, m4, st, kb_lo, kb_hi);
                asm volatile("s_waitcnt vmcnt(0) lgkmcnt(0)" ::: "memory");
                __builtin_amdgcn_s_barrier(); asm volatile("" ::: "memory");
            }
            if (it < 11) {
                att_fill<true>(Kb, it + 1, sp, brow, h, ktile, wave, lane);
                const AttItem an = att_item(it + 1, sp, wave); const unsigned char* qp = Qb + (brow + ((size_t)(an.j0 + qi) << an.dsh) + an.r) * 512 + h * 64 + 32 * hh;
#pragma unroll
                for (int ks = 0; ks < 2; ++ks) asm volatile("global_load_dwordx4 %0, %1, off" : "=v"(qn[ks]) : "v"(qp + 16 * ks) : "memory");
            }
            if (it >= 0) {
                f32x16 o0, o1; float lsum, mxs;
                attn_softmax_pv(st, a, kb_lo, kb_hi, vtile, lane, o0, o1, lsum, mxs);
                PROBE_T1(3); PROBE_T0(4);
                asm volatile("s_waitcnt lgkmcnt(0)" ::: "memory");
                __builtin_amdgcn_s_barrier(); asm volatile("" ::: "memory");
                if (c == 2) attn_store_fused(CC, PO, LSE, o0, o1, lsum, mxs, b, h, a, lane);
                else attn_store(PO + (size_t)c * T * 512, LSE + (size_t)c * T * 8, o0, o1, lsum, mxs, b, h, a, lane);
                asm volatile("" ::: "memory");
            }
            if (it < 11) att_fill<false>(Vb, it + 1, sp, brow, h, vtile, wave, lane);
            PROBE_T1(4);
        }
        PROBE_T0(5);
        asm volatile("s_waitcnt vmcnt(0)" ::: "memory");
        __syncthreads();
        PROBE_T1(5);
    }
    PROBE_T1(1);
    PROBE_END(ws, vcu == 0 && tid == 0);
}
__device__ __forceinline__ void p2_gmlp(const Ptrs& P, int l, LAS unsigned char* lds, int vcu, int G, int wave, int lane, int tid) {
    const bf16* Gb = (const bf16*)(P.ws + WS_G); const bf16* Ub = (const bf16*)(P.ws + WS_U); bf16* CC = (bf16*)(P.ws + WS_CC);
    const bf16* WST = (const bf16*)(P.ws + WS_WST) + (size_t)l * 4 * 128 * 128;
    const float* bs = P.bsp + l * 4 * 128;
    const int hh = lane >> 5, q4 = (lane & 15) >> 2, p4 = lane & 3, blk = (lane >> 4) & 1;
    const int pb = wave & 3, db = wave >> 2;
    const int p = 32 * pb + (lane & 31);
    constexpr int GT_BYTES = 128 * VT_STRIDE;
    v4u treg[2]; v2u uun[4];
    if (vcu < NB * 16 * 4) { const int g = vcu & 3, cch = (vcu >> 2) & 15, b = vcu >> 6; const size_t row0 = (size_t)b * S + cch * 128;
#pragma unroll
        for (int i = 0; i < 2; ++i) { const int idx = tid + NTHREADS * i; treg[i] = *(const v4u*)(Gb + (row0 + (idx >> 3)) * 256 + g * 64 + (idx & 7) * 8); }
#pragma unroll
        for (int g4 = 0; g4 < 4; ++g4) uun[g4] = *(const v2u*)(Ub + (row0 + p) * 256 + g * 64 + 32 * db + 8 * g4 + 4 * hh); }
    bf16x8 wf[8]; float bsv = 0.f; int gcur = -1, par = 0;
    for (int item = vcu; item < NB * 16 * 4; item += G, par ^= 1) {
        const int g = item & 3, cch = (item >> 2) & 15, b = item >> 6;
        const size_t row0 = (size_t)b * S + cch * 128;
        LAS unsigned char* tl = lds + par * GT_BYTES;
#pragma unroll
        for (int i = 0; i < 2; ++i) { const int idx = tid + NTHREADS * i; *(LAS v4u*)(tl + (idx >> 3) * VT_STRIDE + (idx & 7) * 16) = treg[i]; }
        v2u uu[4];
#pragma unroll
        for (int g4 = 0; g4 < 4; ++g4) uu[g4] = uun[g4];
        __syncthreads();
        if (g != gcur) { gcur = g;
            const bf16* wp = WST + ((size_t)g * 128 + p) * 128 + 8 * hh;
#pragma unroll
            for (int s8 = 0; s8 < 8; ++s8) wf[s8] = *(const bf16x8*)(wp + 16 * s8);
            bsv = bs[g * 128 + p]; }
        if (item + G < NB * 16 * 4) { const int it2 = item + G, g2 = it2 & 3, c2 = (it2 >> 2) & 15, b2 = it2 >> 6; const size_t rown = (size_t)b2 * S + c2 * 128;
#pragma unroll
            for (int i = 0; i < 2; ++i) { const int idx = tid + NTHREADS * i; treg[i] = *(const v4u*)(Gb + (rown + (idx >> 3)) * 256 + g2 * 64 + (idx & 7) * 8); }
#pragma unroll
            for (int g4 = 0; g4 < 4; ++g4) uun[g4] = *(const v2u*)(Ub + (rown + p) * 256 + g2 * 64 + 32 * db + 8 * g4 + 4 * hh); }
        f32x16 acc;
#pragma unroll
        for (int i = 0; i < 16; ++i) acc[i] = 0.f;
        LAS unsigned char* vrd = tl + (8 * hh + q4) * VT_STRIDE + (32 * db + 16 * blk + 4 * p4) * 2;
#pragma unroll
        for (int s8 = 0; s8 < 8; ++s8) {
            const s16x4 lo = tr16(vrd + (16 * s8) * VT_STRIDE), hi = tr16(vrd + (16 * s8 + 4) * VT_STRIDE);
            const bf16x8 vf = __builtin_shufflevector(lo, hi, 0, 1, 2, 3, 4, 5, 6, 7);
            acc = MFMA32(vf, wf[s8], acc);
        }
        { unsigned w[8];
#pragma unroll
          for (int g4 = 0; g4 < 4; ++g4) { w[2 * g4] = pk2(bflo(uu[g4].x) * (acc[4 * g4] + bsv), bfhi(uu[g4].x) * (acc[4 * g4 + 1] + bsv)); w[2 * g4 + 1] = pk2(bflo(uu[g4].y) * (acc[4 * g4 + 2] + bsv), bfhi(uu[g4].y) * (acc[4 * g4 + 3] + bsv)); }
          bf16* op = CC + (row0 + p) * D + 512 + g * 64 + 32 * db + 16 * hh;
          *(v4u*)op = (v4u){w[0], w[1], w[2], w[3]}; *(v4u*)(op + 8) = (v4u){w[4], w[5], w[6], w[7]}; }
    }
    __syncthreads();
}
constexpr int PL_ROWB = 144, PL_WAVE_LDS = 48 * PL_ROWB;
template <int W>
__device__ __forceinline__ void pool_task(const bf16* __restrict__ Zb, bf16* __restrict__ CC, const bf16* __restrict__ WPT, const float* __restrict__ psc, int b, int g, int tile, int lane, LAS unsigned char* wl) {
    const int hh = lane >> 5, pl = lane & 31;
    const int pos = 32 * tile + pl;
    constexpr int left = W / 2, right = W - 1 - left, NR = 32 + W - 1;
    int lo = pos - left; if (lo < 0) lo = 0;
    int hi = pos + right + 1; if (hi > S) hi = S;
    const float inv = 1.0f / (float)(hi - lo);
    const bf16* zb = Zb + (size_t)b * S * 256 + g * 64;
    { constexpr int NL = (NR * 8 + 63) / 64;
      v4u zr[NL];
#pragma unroll
      for (int k = 0; k < NL; ++k) { const int idx = lane + 64 * k, r = idx >> 3, c = idx & 7; int q = 32 * tile - left + r; q = q < 0 ? 0 : (q >= S ? S - 1 : q);
          zr[k] = *(const v4u*)(zb + (size_t)q * 256 + 8 * c); }
#pragma unroll
      for (int k = 0; k < NL; ++k) { const int idx = lane + 64 * k, r = idx >> 3, c = idx & 7; if (NR * 8 % 64 == 0 || idx < NR * 8) *(LAS v4u*)(wl + r * PL_ROWB + 16 * c) = zr[k]; }
      asm volatile("s_waitcnt lgkmcnt(0)" ::: "memory"); }
    bf16x8 bfr[4];
#pragma unroll
    for (int ks = 0; ks < 4; ++ks) {
        float sm[8];
#pragma unroll
        for (int e = 0; e < 8; ++e) sm[e] = 0.f;
        v4u zc;
#pragma unroll
        for (int t = 0; t < W; ++t) { const int q = pos - left + t; const float f = (q >= 0 && q < S) ? 1.0f : 0.0f; const v4u z = *(const LAS v4u*)(wl + (pl + t) * PL_ROWB + 32 * ks + 16 * hh);
            if (t == left) zc = z;
            sm[0] += f * bflo(z.x); sm[1] += f * bfhi(z.x); sm[2] += f * bflo(z.y); sm[3] += f * bfhi(z.y); sm[4] += f * bflo(z.z); sm[5] += f * bfhi(z.z); sm[6] += f * bflo(z.w); sm[7] += f * bfhi(z.w); }
        const v4u z = zc;
        v4u o; o.x = pk2(sm[0] * inv - bflo(z.x), sm[1] * inv - bfhi(z.x)); o.y = pk2(sm[2] * inv - bflo(z.y), sm[3] * inv - bfhi(z.y));
        o.z = pk2(sm[4] * inv - bflo(z.z), sm[5] * inv - bfhi(z.z)); o.w = pk2(sm[6] * inv - bflo(z.w), sm[7] * inv - bfhi(z.w));
        bfr[ks] = __builtin_bit_cast(bf16x8, o);
    }
    asm volatile("s_waitcnt lgkmcnt(0)" ::: "memory");
#pragma unroll
    for (int ob = 0; ob < 2; ++ob) {
        f32x16 acc;
#pragma unroll
        for (int i = 0; i < 16; ++i) acc[i] = 0.f;
#pragma unroll
        for (int ks = 0; ks < 4; ++ks) { const bf16x8 af = *(const bf16x8*)(WPT + ((size_t)g * 64 + 32 * ob + pl) * 64 + 16 * ks + 8 * hh); acc = MFMA32(af, bfr[ks], acc); }
        unsigned w[8];
#pragma unroll
        for (int g4 = 0; g4 < 4; ++g4) {
            const int o0 = 32 * ob + 8 * g4 + 4 * hh;
            const f32x4 sc = *(const f32x4*)(psc + g * 64 + o0);
            w[2 * g4] = pk2(acc[4 * g4] * sc[0], acc[4 * g4 + 1] * sc[1]); w[2 * g4 + 1] = pk2(acc[4 * g4 + 2] * sc[2], acc[4 * g4 + 3] * sc[3]);
        }
        bf16* op = CC + ((size_t)b * S + pos) * D + 768 + g * 64 + 32 * hh + 16 * ob;
        *(v4u*)op = (v4u){w[0], w[1], w[2], w[3]}; *(v4u*)(op + 8) = (v4u){w[4], w[5], w[6], w[7]};
    }
}
__device__ __forceinline__ void p2_pool(const Ptrs& P, int l, LAS unsigned char* lds, int vcu, int G, int wave, int lane) {
    LAS unsigned char* wl = lds + 65536 + wave * PL_WAVE_LDS;
    const bf16* Zb = (const bf16*)(P.ws + WS_Z); bf16* CC = (bf16*)(P.ws + WS_CC);
    const bf16* WPT = (const bf16*)(P.ws + WS_WPT) + (size_t)l * 4 * 64 * 64;
    const float* psc = P.psc + l * 256;
    const int gw = vcu * NWAVES + wave, NGW = G * NWAVES;
    for (int task = gw; task < NB * 4 * 64; task += NGW) {
        const int gr = task & 3, idx = (task >> 2), tile = idx & 63, b = idx >> 6, g = ((task >> 11) & 1) ? 3 - gr : gr;
        if (g == 0) pool_task<2>(Zb, CC, WPT, psc, b, g, tile, lane, wl);
        else if (g == 1) pool_task<4>(Zb, CC, WPT, psc, b, g, tile, lane, wl);
        else if (g == 2) pool_task<8>(Zb, CC, WPT, psc, b, g, tile, lane, wl);
        else pool_task<16>(Zb, CC, WPT, psc, b, g, tile, lane, wl);
    }
}

__device__ __forceinline__ void route16(const float* logit, const float* __restrict__ rbias, int& e0, int& e1, float& g0, float& g1) {
    float sc[16], bi[16];
#pragma unroll
    for (int e = 0; e < 16; ++e) { sc[e] = 1.0f / (1.0f + expf(-logit[e])); bi[e] = sc[e] + rbias[e]; }
    int gsel = 0; float best = -1e30f;
#pragma unroll
    for (int g = 0; g < 4; ++g) {
        float m1 = -1e30f, m2 = -1e30f;
#pragma unroll
        for (int j = 0; j < 4; ++j) { const float v = bi[g * 4 + j]; if (v > m1) { m2 = m1; m1 = v; } else if (v > m2) m2 = v; }
        const float gs = m1 + m2;
        if (gs > best) { best = gs; gsel = g; }
    }
    float bg[4], sg[4];
#pragma unroll
    for (int j = 0; j < 4; ++j) { bg[j] = bi[j]; sg[j] = sc[j];
#pragma unroll
        for (int g = 1; g < 4; ++g) { bg[j] = (g == gsel) ? bi[g * 4 + j] : bg[j]; sg[j] = (g == gsel) ? sc[g * 4 + j] : sg[j]; } }
    int i1 = 0; float m1 = bg[0], s1 = sg[0];
#pragma unroll
    for (int j = 1; j < 4; ++j) if (bg[j] > m1) { m1 = bg[j]; i1 = j; s1 = sg[j]; }
    int i2 = -1; float m2 = -1e30f, s2 = 0.f;
#pragma unroll
    for (int j = 0; j < 4; ++j) if (j != i1 && bg[j] > m2) { m2 = bg[j]; i2 = j; s2 = sg[j]; }
    e0 = gsel * 4 + i1; e1 = gsel * 4 + i2;
    g0 = s1 / (s1 + s2); g1 = s2 / (s1 + s2);
}
__device__ __forceinline__ void p4_stats_router(const Ptrs& P, int l, LAS unsigned char* lds, int vcu, int G, int wave, int lane, int tid) {
    const bf16* Y1B = (const bf16*)(P.ws + WS_Y1B); float* STATS = (float*)(P.ws + WS_STATS);
    int* TOKE = (int*)(P.ws + WS_TOKE); float* TOKG = (float*)(P.ws + WS_TOKG); int* TOKP = (int*)(P.ws + WS_TOKP);
    int* TLIST = (int*)(P.ws + WS_TLIST); float* GLIST = (float*)(P.ws + WS_GLIST);
    unsigned* cnt = (unsigned*)(P.ws + WS_CTL) + CW_CNT + 16 * l;
    const v4u* RWB = (const v4u*)(P.ws + WS_RWQ) + (size_t)l * 6144; const float* CR = (const float*)(P.ws + WS_CR) + l * 32;
    LAS unsigned char* rwb = lds;
    LAS float* dots = (LAS float*)(lds + 98304) + wave * 256;
    LAS int* s_cnt = (LAS int*)(lds + 98304 + 8192); LAS int* s_base = s_cnt + 16; LAS int* s_e = s_cnt + 32; LAS int* s_pos = s_e + 256; LAS float* s_g = (LAS float*)(s_pos + 256);
    const int row_l = lane & 15, q = lane >> 4;
    bool filled = false;
    for (int blk_row = vcu * 128; blk_row < T; blk_row += G * 128) {
        const int row = blk_row + wave * 16 + row_l;
        const bf16* yp = Y1B + (size_t)row * D + 8 * q;
        v4u yv[16];
#pragma unroll
        for (int jj = 0; jj < 16; ++jj) yv[jj] = *(const v4u*)(yp + 32 * jj);
        if (!filled) { filled = true;
            for (int i = tid; i < 6144; i += NTHREADS) ((LAS v4u*)rwb)[i] = RWB[i];
            if (tid < 16) s_cnt[tid] = 0;
            __syncthreads(); }
        f32x4 acc = {0.f, 0.f, 0.f, 0.f}; float s1 = 0.f, s2 = 0.f;
#pragma unroll 1
        for (int jc = 0; jc < 2; ++jc) {
            if (jc == 1) {
#pragma unroll
                for (int jj = 0; jj < 16; ++jj) yv[jj] = *(const v4u*)(yp + 32 * (16 + jj));
            }
#pragma unroll
            for (int jj = 0; jj < 16; ++jj) {
                const int jp = 16 * jc + jj;
                const float y0 = bflo(yv[jj].x), y1 = bfhi(yv[jj].x), y2 = bflo(yv[jj].y), y3 = bfhi(yv[jj].y), y4 = bflo(yv[jj].z), y5 = bfhi(yv[jj].z), y6 = bflo(yv[jj].w), y7 = bfhi(yv[jj].w);
                const bf16x8 af = __builtin_bit_cast(bf16x8, yv[jj]);
#pragma unroll
                for (int term = 0; term < 3; ++term) { const bf16x8 bfr = *(const LAS bf16x8*)(rwb + ((jp * 3 + term) * 64 + lane) * 16); acc = __builtin_amdgcn_mfma_f32_16x16x32_bf16(af, bfr, acc, 0, 0, 0); }
                s1 += ((y0 + y1) + (y2 + y3)) + ((y4 + y5) + (y6 + y7));
                s2 += ((y0 * y0 + y1 * y1) + (y2 * y2 + y3 * y3)) + ((y4 * y4 + y5 * y5) + (y6 * y6 + y7 * y7));
            }
        }
        s1 += __shfl_xor(s1, 16); s1 += __shfl_xor(s1, 32); s2 += __shfl_xor(s2, 16); s2 += __shfl_xor(s2, 32);
#pragma unroll
        for (int i = 0; i < 4; ++i) dots[(4 * q + i) * 16 + row_l] = acc[i];
        LDS_WAIT();
        if (lane < 16) {
            const int grow = blk_row + wave * 16 + lane;
            const float mu = s1 * (1.0f / D), var = s2 * (1.0f / D) - mu * mu, rstd = rsqrtf(var + LN_EPS);
            *(f32x2*)(STATS + 2 * (size_t)grow) = (f32x2){mu, rstd};
            float lg[16];
#pragma unroll
            for (int e4 = 0; e4 < 4; ++e4) { const f32x4 d = *(const LAS f32x4*)(dots + lane * 16 + 4 * e4);
#pragma unroll
                for (int e = 0; e < 4; ++e) lg[4 * e4 + e] = rstd * (d[e] - mu * CR[4 * e4 + e]) + CR[16 + 4 * e4 + e]; }
            int e0, e1; float g0, g1;
            route16(lg, P.rb, e0, e1, g0, g1);
            const int tl = wave * 16 + lane;
            const int p0 = __hip_atomic_fetch_add(s_cnt + e0, 1, __ATOMIC_RELAXED, __HIP_MEMORY_SCOPE_WORKGROUP);
            const int p1 = __hip_atomic_fetch_add(s_cnt + e1, 1, __ATOMIC_RELAXED, __HIP_MEMORY_SCOPE_WORKGROUP);
            s_e[2 * tl] = e0; s_e[2 * tl + 1] = e1; s_pos[2 * tl] = p0; s_pos[2 * tl + 1] = p1; s_g[2 * tl] = g0; s_g[2 * tl + 1] = g1;
            TOKE[2 * grow] = e0; TOKE[2 * grow + 1] = e1; TOKG[2 * grow] = g0; TOKG[2 * grow + 1] = g1;
        }
        __syncthreads();
        if (tid < 16) s_base[tid] = (int)__hip_atomic_fetch_add(cnt + tid, (unsigned)s_cnt[tid], RLX_AGENT);
        __syncthreads();
        if (tid < 256) { const int e = s_e[tid], p = s_base[e] + s_pos[tid]; TOKP[2 * blk_row + tid] = p;
            TLIST[(size_t)e * T + p] = blk_row + (tid >> 1); GLIST[(size_t)e * T + p] = s_g[tid]; }
        if (tid < 16) s_cnt[tid] = 0;
        __syncthreads();
    }
}
__device__ __forceinline__ int build_tables(const unsigned char* ws, int l, LAS unsigned char* lds, int tid) {
    LAS int* s_base = (LAS int*)(lds + TAB_OFF); LAS int* s_cntx = s_base + 32; LAS int* texp = s_base + 64;
    const unsigned* cnt = (const unsigned*)(ws + WS_CTL) + CW_CNT + 16 * l;
    if (tid == 0) {
        int base = 0;
#pragma unroll 1
        for (int e = 0; e < 16; ++e) { const int c = (int)__hip_atomic_load(cnt + e, RLX_AGENT); const int nt = (c + 255) >> 8;
            s_cntx[e] = c; s_base[e] = base;
#pragma clang loop vectorize(disable) unroll(disable)
            for (int t = 0; t < nt; ++t) texp[(base >> 8) + t] = e;
            base += nt << 8; }
        s_base[16] = base;
    }
    __syncthreads();
    return s_base[16] >> 8;
}
__device__ __forceinline__ void p8_ln2(const Ptrs& P, int l, bool last, LAS unsigned char* lds, int vcu, int G, int wave, int lane) {
    const LAS int* s_base = (const LAS int*)(lds + TAB_OFF);
    const bf16* Y1B = (const bf16*)(P.ws + WS_Y1B); const float* STATS = (const float*)(P.ws + WS_STATS); const unsigned char* YB = P.ws + WS_YB; bf16* XB = (bf16*)(P.ws + WS_HB);
    const int* TOKE = (const int*)(P.ws + WS_TOKE); const int* TOKP = (const int*)(P.ws + WS_TOKP); const float* TOKG = (const float*)(P.ws + WS_TOKG);
    const float* g1p = P.ln1g + l * D; const float* b1p = P.ln1b + l * D; const float* g2p = P.ln2g + l * D; const float* b2p = P.ln2b + l * D;
    float g1[16], b1[16], g2[16], b2[16];
#pragma unroll
    for (int j = 0; j < 2; ++j)
#pragma unroll
        for (int h = 0; h < 2; ++h) { const int c = 8 * lane + 512 * j + 4 * h;
            const f32x4 a = *(const f32x4*)(g1p + c), b = *(const f32x4*)(b1p + c), cc = *(const f32x4*)(g2p + c), d = *(const f32x4*)(b2p + c);
#pragma unroll
            for (int e = 0; e < 4; ++e) { g1[8 * j + 4 * h + e] = a[e]; b1[8 * j + 4 * h + e] = b[e]; g2[8 * j + 4 * h + e] = cc[e]; b2[8 * j + 4 * h + e] = d[e]; } }
    const int gw = vcu * NWAVES + wave, NGW = G * NWAVES;
    for (int t0 = gw; t0 < T; t0 += 2 * NGW) {
        v4u yv[2][2]; v2u av[2][2], bv[2][2]; f32x2 stv[2], gtv[2];
#pragma unroll
        for (int u = 0; u < 2; ++u) {
            const int t = (t0 + u * NGW < T) ? t0 + u * NGW : t0;
            const int r0 = s_base[TOKE[2 * t]] + TOKP[2 * t], r1 = s_base[TOKE[2 * t + 1]] + TOKP[2 * t + 1];
            stv[u] = *(const f32x2*)(STATS + 2 * (size_t)t); gtv[u] = *(const f32x2*)(TOKG + 2 * (size_t)t);
#pragma unroll
            for (int j = 0; j < 2; ++j) {
                yv[u][j] = *(const v4u*)(Y1B + (size_t)t * D + 8 * lane + 512 * j);
                av[u][j] = *(const v2u*)(YB + (size_t)r0 * D + 8 * lane + 512 * j); bv[u][j] = *(const v2u*)(YB + (size_t)r1 * D + 8 * lane + 512 * j);
            }
        }
#pragma unroll
        for (int u = 0; u < 2; ++u) {
            const int t = t0 + u * NGW;
            if (t < T) {
                const f32x2 st = stv[u]; const float ga = gtv[u].x * (1.0f / Y8_SCALE), gb = gtv[u].y * (1.0f / Y8_SCALE);
                float v[16]; float s = 0.f;
#pragma unroll
                for (int j = 0; j < 2; ++j) {
                    const v4u y = yv[u][j]; const v2u a = av[u][j], b = bv[u][j];
                    const unsigned yw[4] = {y.x, y.y, y.z, y.w}, aw[2] = {a.x, a.y}, bw[2] = {b.x, b.y};
#pragma unroll
                    for (int k = 0; k < 4; ++k) {
                        const int i0 = 8 * j + 2 * k;
                        const float m0 = ga * f8at(aw[k >> 1], 2 * (k & 1)) + gb * f8at(bw[k >> 1], 2 * (k & 1)), m1 = ga * f8at(aw[k >> 1], 2 * (k & 1) + 1) + gb * f8at(bw[k >> 1], 2 * (k & 1) + 1);
                        v[i0] = ALPHA * ((bflo(yw[k]) - st.x) * st.y * g1[i0] + b1[i0]) + m0;
                        v[i0 + 1] = ALPHA * ((bfhi(yw[k]) - st.x) * st.y * g1[i0 + 1] + b1[i0 + 1]) + m1;
                        s += v[i0] + v[i0 + 1];
                    }
                }
                const float mu = wave_sum(s) * (1.0f / D); float q = 0.f;
#pragma unroll
                for (int i = 0; i < 16; ++i) { v[i] -= mu; q += v[i] * v[i]; }
                const float rstd = rsqrtf(wave_sum(q) * (1.0f / D) + LN_EPS);
#pragma unroll
                for (int i = 0; i < 16; ++i) v[i] = v[i] * rstd * g2[i] + b2[i];
                if (last) {
#ifdef MK_PROBE
                    { const float pscale = 1.0f + (float)__hip_atomic_load((const unsigned*)(P.ws + WS_CTL) + 32, RLX_AGENT) * (MK_PSCALE);
#pragma unroll
                      for (int i = 0; i < 16; ++i) v[i] *= pscale; }
#endif
#pragma unroll
                    for (int j = 0; j < 2; ++j) { float* op = P.out + (size_t)t * D + 8 * lane + 512 * j;
                        __builtin_nontemporal_store((f32x4){v[8 * j], v[8 * j + 1], v[8 * j + 2], v[8 * j + 3]}, (f32x4*)op); __builtin_nontemporal_store((f32x4){v[8 * j + 4], v[8 * j + 5], v[8 * j + 6], v[8 * j + 7]}, (f32x4*)(op + 4)); }
                } else {
#pragma unroll
                    for (int j = 0; j < 2; ++j) { v4u w; w.x = pk2(v[8 * j], v[8 * j + 1]); w.y = pk2(v[8 * j + 2], v[8 * j + 3]); w.z = pk2(v[8 * j + 4], v[8 * j + 5]); w.w = pk2(v[8 * j + 6], v[8 * j + 7]);
                        *(v4u*)(XB + (size_t)t * D + 8 * lane + 512 * j) = w;
                        v2u w8; w8.x = pk4_fp8(v[8 * j], v[8 * j + 1], v[8 * j + 2], v[8 * j + 3]); w8.y = pk4_fp8(v[8 * j + 4], v[8 * j + 5], v[8 * j + 6], v[8 * j + 7]); *(v2u*)(P.ws + WS_XB8 + (size_t)t * D + 8 * lane + 512 * j) = w8; }
                }
            }
        }
    }
}

template <class Tp> __device__ __forceinline__ Tp* asg(Tp* p) { GAS Tp* g = (GAS Tp*)p; asm volatile("" : "+s"(g)); return (Tp*)g; }
__device__ __forceinline__ Ptrs load_ptrs(const Ptrs& q) {
    Ptrs P;
    P.x = asg(q.x); P.w_in = asg(q.w_in); P.w_out = asg(q.w_out); P.lg = asg(q.lg); P.lb = asg(q.lb); P.wsp = asg(q.wsp); P.bsp = asg(q.bsp); P.pw = asg(q.pw); P.psc = asg(q.psc);
    P.ln1g = asg(q.ln1g); P.ln1b = asg(q.ln1b); P.rw = asg(q.rw); P.rb = asg(q.rb); P.wg = asg(q.wg); P.wu = asg(q.wu); P.wd = asg(q.wd); P.ln2g = asg(q.ln2g); P.ln2b = asg(q.ln2b);
    P.out = asg(q.out); P.ws = asg(q.ws);
    return P;
}
struct Args { Ptrs p; int ph_lo, ph_hi, li, pad; };
constexpr int N_PHASES = 13;
__global__ void __launch_bounds__(NTHREADS, 2) mk_fwd(Args args_unused) {
    const Args* ka_ = (const Args*)__builtin_amdgcn_kernarg_segment_ptr();
#ifndef USE_KA
#define KA() (&args_unused)
#else
#define KA() ({ const Args* p_ = ka_; asm volatile("" : "+s"(p_)); p_; })
#endif
    extern __shared__ __attribute__((aligned(16))) unsigned char lds_raw[];
    LAS unsigned char* lds = (LAS unsigned char*)lds_raw;
    const int tid0 = threadIdx.x; const int wave0 = __builtin_amdgcn_readfirstlane(tid0 >> 6);
    const int G = gridDim.x; const int bx = blockIdx.x; const int vcu = (G % 8 == 0) ? (bx % 8) * (G / 8) + bx / 8 : bx;
    volatile LAS unsigned* MISC = (volatile LAS unsigned*)(lds + MISC_OFF);
    for (int u = tid0; u < (LDS_BYTES - RING_BYTES) / 4; u += NTHREADS) ((LAS unsigned*)(lds + RING_BYTES))[u] = 0u;
    __syncthreads();
    const int lo = KA()->ph_lo, hi = KA()->ph_hi;
    unsigned* ctl = (unsigned*)(asg(KA()->p.ws) + WS_CTL);
    XcdBarrier bar; bar.bar = ctl + CW_BAR + KA()->li * XCD_BAR_WORDS; bar.x = 0; bar.st = nullptr;
    if (hi - lo > 1) bar = xcd_barrier_post(ctl + CW_BAR + KA()->li * XCD_BAR_WORDS, MISC + 8, tid0);
#define IN(k) (lo <= (k) && (k) < hi)
#ifndef MK_REPEAT
#define MK_REPEAT -1
#endif
#define REP(k) for (int rep_ = 0; rep_ < ((MK_REPEAT == (k)) ? 2 : 1); ++rep_)
#define PHASE_IDS() int wave = wave0; asm volatile("" : "+s"(wave)); int lane; asm volatile("v_mbcnt_lo_u32_b32 %0, -1, 0\n\tv_mbcnt_hi_u32_b32 %0, -1, %0" : "=&v"(lane)); const int tid = wave * 64 + lane; (void)tid
#define SEAM(k) do { if (IN(k) && IN((k) + 1)) xcd_barrier(bar, tid); } while (0)
    PROBE_DECL();
#ifndef PH_MASK
#define PH_MASK 0x1ff
#endif
    if ((PH_MASK & 1) && IN(0)) REP(0) { PHASE_IDS(); PROBE_T0(100); const Ptrs P = load_ptrs(KA()->p); p0_prologue(P, lds, vcu, G, wave, lane, tid); SEAM(0); PROBE_T1(100); }
    for (int l = 0; l < 2; ++l) {
        const int pb = 1 + 6 * l;
        if ((PH_MASK & 2) && IN(pb + 0)) REP(1) {
            PHASE_IDS(); PROBE_T0(101); const Ptrs P = load_ptrs(KA()->p);
            { pg8::Gemm g{P.ws + WS_HB, P.ws + WS_WINB + (size_t)l * 768 * D * 2, 2 * D};
              pg8::StaticOrder so; so.init(T / 256, 3, G, bx); so.pn_base = 6;
              EpiProj E{P.ws, P.lg + l * 256, P.lb + l * 256, 1.0f};
              pg8::gemm_phase<EpiProj, pg8::StaticOrder>(lds, g, so, E, wave); }
            { pg8::Gemm g{P.ws + WS_XB8, P.ws + WS_WIN8 + (size_t)l * 1536 * D, D};
              pg8::StaticOrder so; so.init(T / 256, 6, G, bx); if (G == 256) so.lo_c = 128;
              EpiProj E{P.ws, P.lg + l * 256, P.lb + l * 256, 1.0f / W8_SCALE};
              pg8::gemm_phase<EpiProj, pg8::StaticOrder, MK_ALIGN, false, true>(lds, g, so, E, wave); }
            SEAM(pb + 0); PROBE_T1(101);
        }
        if ((PH_MASK & 4) && IN(pb + 1)) {
            PHASE_IDS(); PROBE_T0(102); const Ptrs P = load_ptrs(KA()->p);
            PROBE_T0(21); REP(21) p2_attention(P.ws, P.ws, lds, vcu, G, wave, lane, tid); PROBE_T1(21);
            PROBE_T0(22); p2_gmlp(P, l, lds, vcu, G, wave, lane, tid); PROBE_T1(22);
            PROBE_T0(23); p2_pool(P, l, lds, vcu, G, wave, lane); PROBE_T1(23);
            SEAM(pb + 1); PROBE_T1(102);
        }
        if ((PH_MASK & 8) && IN(pb + 2)) REP(3) {
            PHASE_IDS(); PROBE_T0(103); const Ptrs P = load_ptrs(KA()->p);
            pg8::Gemm g{(const bf16*)(P.ws + WS_CC), (const bf16*)(P.ws + WS_WOUT) + (size_t)l * D * D, 2 * D};
            pg8::StaticOrder so; so.init(T / 256, D / 256, G, bx);
            EpiOutB E{(const bf16*)(P.ws + WS_HB), (bf16*)(P.ws + WS_Y1B), P.ws + WS_Y1F};
            pg8::gemm_phase<EpiOutB, pg8::StaticOrder>(lds, g, so, E, wave);
            SEAM(pb + 2); PROBE_T1(103);
        }
        if ((PH_MASK & 16) && IN(pb + 3)) { PHASE_IDS(); PROBE_T0(104); const Ptrs P = load_ptrs(KA()->p); p4_stats_router(P, l, lds, vcu, G, wave, lane, tid); SEAM(pb + 3); PROBE_T1(104); }
        if ((PH_MASK & 64) && IN(pb + 4)) {
            PHASE_IDS(); PROBE_T0(105); const Ptrs P = load_ptrs(KA()->p);
            const int ntiles = build_tables(P.ws, l, lds, tid);
            unsigned* rdy = (unsigned*)(P.ws + WS_CTL) + CW_RDY + l * 32768;
            {
                pg8::Gemm g{P.ws + WS_Y1F, P.ws + WS_WGU + (size_t)l * NE * 1024 * D, D};
                pg8::GroupOrder go; go.so.init(ntiles, 4, G, bx); go.s_base = (const LAS int*)(lds + TAB_OFF); go.tlist = (const int*)(P.ws + WS_TLIST); go.toks = (const LAS unsigned short*)(lds + TAB_OFF + 2048);
                go.ready = rdy; go.mode = 1;
                go.stage_tokens((LAS unsigned short*)(lds + TAB_OFF + 2048), tid, NTHREADS); go.stage_stats((LAS float*)(lds + TAB_OFF + 5120), (const float*)(P.ws + WS_STATS), tid, NTHREADS); __syncthreads();
                EpiGU E{P.ws, (const LAS float*)(lds + TAB_OFF + 5120), l};
                pg8::gemm_phase<EpiGU, pg8::GroupOrder, MK_ALIGN, true, true>(lds, g, go, E, wave);
            }
            __syncthreads();
            {
                pg8::Gemm g{P.ws + WS_HB, P.ws + WS_WDN + (size_t)l * NE * D * FF, FF};
                pg8::GroupOrder go; go.so.init(ntiles, 4, G, G - 1 - bx); go.s_base = (const LAS int*)(lds + TAB_OFF); go.tlist = nullptr; go.toks = nullptr;
                go.ready = rdy; go.mode = 2;
                EpiDown E{P.ws + WS_YB};
                pg8::gemm_phase<EpiDown, pg8::GroupOrder, MK_ALIGN, false, true>(lds, g, go, E, wave);
            }
            if (l == 1) PROBE_END(P.ws, bx == 0 && tid == 0);
            SEAM(pb + 4); PROBE_T1(105);
        }
        if ((PH_MASK & 256) && IN(pb + 5)) REP(8) { PHASE_IDS(); PROBE_T0(107); const Ptrs P = load_ptrs(KA()->p); build_tables(P.ws, l, lds, tid); p8_ln2(P, l, l == 1, lds, vcu, G, wave, lane); SEAM(pb + 5); PROBE_T1(107); }
    }
#undef IN
#undef SEAM
}
}
#ifndef MK_CUT
#define MK_CUT 13
#endif
#if MK_CUT < 13
namespace glue {
using namespace mk;
__global__ void g1(const unsigned char* ws, int b, float* proj) {
    const int pos = blockIdx.x; const size_t row = (size_t)b * S + pos;
    for (int col = threadIdx.x; col < NCOL; col += blockDim.x) {
        float v;
        if (col < 1024) { const int c = col & 511, head = c >> 6, d = c & 63; const int t = d < 16 ? (d < 8 ? 2 * d : 2 * (d - 8) + 1) : d;
            const bf16* src = (const bf16*)(ws + (col < 512 ? WS_Q : WS_K)); v = bflo(src[row * 512 + head * 64 + t]); if (col < 512) v *= 8.0f; }
        else if (col < 1536) v = bflo(((const bf16*)(ws + WS_V))[row * 512 + col - 1024]);
        else if (col < 1792) v = bflo(((const bf16*)(ws + WS_U))[row * 256 + col - 1536]);
        else if (col < 2048) v = bflo(((const bf16*)(ws + WS_G))[row * 256 + col - 1792]);
        else v = bflo(((const bf16*)(ws + WS_Z))[row * 256 + col - 2048]);
        proj[(size_t)pos * NCOL + col] = v;
    }
}
__global__ void g2(const unsigned char* ws, int b, float* cc) {
    const int pos = blockIdx.x; const size_t row = (size_t)b * S + pos;
    for (int col = threadIdx.x; col < D; col += blockDim.x) cc[(size_t)pos * D + col] = bflo(((const bf16*)(ws + WS_CC))[row * D + col]);
}
}
#endif

static void mk_launch_range(const mk::Ptrs& p, int grid, int lo, int hi, int li, hipStream_t stream) {
    mk::Args a{};
    a.p = p; a.ph_lo = lo; a.ph_hi = hi; a.li = li; a.pad = 0;
    hipLaunchKernelGGL(mk::mk_fwd, dim3(grid), dim3(mk::NTHREADS), mk::LDS_BYTES, stream, a);
}

extern "C" void kernel_launch(void* const* d_in, const int* in_sizes, int n_in, void* d_out, int out_size, void* d_ws, size_t ws_size, hipStream_t stream) {
    using namespace mk;
    static int grid = 0;
    if (grid == 0) {
        if (n_in != 18 || ws_size < WS_END) { fprintf(stderr, "kernel_launch: unexpected n_in %d / ws_size %zu\n", n_in, ws_size); grid = -1; return; }
        int dev = 0, cus = 0;
        if (hipGetDevice(&dev) != hipSuccess || hipDeviceGetAttribute(&cus, hipDeviceAttributeMultiprocessorCount, dev) != hipSuccess) { grid = -1; return; }
        if (hipFuncSetAttribute((const void*)mk_fwd, hipFuncAttributeMaxDynamicSharedMemorySize, LDS_BYTES) != hipSuccess) { fprintf(stderr, "kernel_launch: hipFuncSetAttribute failed\n"); grid = -1; return; }
        grid = cus;
    }
    if (grid < 0) return;
    (void)hipMemsetAsync((char*)d_ws + WS_CTL, 0, CTL_ZERO_BYTES, stream);
    Ptrs p{};
    const float* const* in = (const float* const*)d_in;
    p.x = in[0]; p.w_in = in[1]; p.w_out = in[2]; p.lg = in[3]; p.lb = in[4]; p.wsp = in[5]; p.bsp = in[6]; p.pw = in[7]; p.psc = in[8];
    p.ln1g = in[9]; p.ln1b = in[10]; p.rw = in[11]; p.rb = in[12]; p.wg = in[13]; p.wu = in[14]; p.wd = in[15]; p.ln2g = in[16]; p.ln2b = in[17];
    p.out = (float*)d_out; p.ws = (unsigned char*)d_ws;
#if MK_CUT >= 13
    mk_launch_range(p, grid, 0, N_PHASES, 0, stream);
#else
    mk_launch_range(p, grid, 0, MK_CUT, 0, stream);
    nv::In I = nv::make_in(d_in);
    const unsigned char* ws = (const unsigned char*)d_ws;
    float* scr_base = (float*)((char*)d_ws + 509 * MiB) - nv::SCR_FLOATS - (size_t)T * D;
    (void)scr_base;
    float* nscr = (float*)((char*)d_ws + (MK_CUT <= 2 ? (size_t)357 * MiB : (size_t)261 * MiB));
    nv::Scr s = nv::carve(nscr);
    float* xcur = (float*)d_out;
    for (int b = 0; b < NB; ++b) {
        const float* xin = I.x + (size_t)b * S * D; float* xout = xcur + (size_t)b * S * D; const int l = 0;
#if MK_CUT == 2
        glue::g1<<<S, 256, 0, stream>>>(ws, b, s.proj);
#endif
#if MK_CUT <= 2
        nv::attn<<<dim3(S, 8), 64, 0, stream>>>(s.proj, s.cc);
        nv::gmlp_mix<<<S, 256, 0, stream>>>(s.proj, I.wsp + (size_t)l * 4 * 128 * 128, I.bsp + l * 4 * 128, s.cc);
        nv::pool1<<<S, 256, 0, stream>>>(s.proj, s.pooled);
        nv::pool2<<<S, 256, 0, stream>>>(s.pooled, I.pw + (size_t)l * 4 * 64 * 64, I.psc + l * 256, s.cc);
#endif
#if MK_CUT == 3
        glue::g2<<<S, 256, 0, stream>>>(ws, b, s.cc);
#endif
#if MK_CUT <= 3
        nv::gemm<<<dim3(D / 64, S / 64), 256, 0, stream>>>(s.cc, I.w_out + (size_t)l * D * D, s.h, S, D, D);
        nv::ln_res<<<S, 64, 0, stream>>>(xin, s.h, I.ln1g + l * D, I.ln1b + l * D, s.x1);
#endif
        nv::route<<<S, 64, 0, stream>>>(s.x1, I.rw, I.rb, s.eo, s.go);
        nv::moe<<<S, 256, 0, stream>>>(s.x1, s.eo, s.go, I.wg + (size_t)l * NE * D * FF, I.wu + (size_t)l * NE * D * FF, I.wd + (size_t)l * NE * FF * D, s.moe);
        nv::ln_res<<<S, 64, 0, stream>>>(s.x1, s.moe, I.ln2g + l * D, I.ln2b + l * D, xout);
    }
    for (int b = 0; b < NB; ++b) { float* xb = xcur + (size_t)b * S * D; nv::layer(I, 1, xb, xb, s, stream); }
#endif
}
```

```cpp
#define MK_CUT 13
#include <hip/hip_runtime.h>
#include <cstdio>
#ifndef MK_ALIGN
#define MK_ALIGN true
#endif
namespace pg8 {
#define PG8_LAS __attribute__((address_space(3)))
typedef unsigned short bf16_t;
typedef short bf16x8 __attribute__((ext_vector_type(8)));
typedef float f32x4 __attribute__((ext_vector_type(4)));
typedef unsigned u32x4 __attribute__((ext_vector_type(4)));
constexpr int BM = 256, BK = 64, HALF = 128, HTB = HALF * BK * 2  , STAGE_BYTES = 8 * HTB, NXCD = 8, WGM = 8;

__host__ __device__ __forceinline__ int lds_byte(int r, int c) { const int st = (r >> 4) * 2 + (c >> 5), rr = r & 15, cc = c & 31, ob = rr * 64 + cc * 2; return st * 1024 + (ob ^ (((ob >> 9) & 1) << 5)); }
__host__ __device__ __forceinline__ void stage_rc(int b, int& R, int& C) { const int st = b / 1024, sb = b % 1024, swz = sb ^ (((sb >> 9) & 1) << 5); R = (st >> 1) * 16 + swz / 64; C = (st & 1) * 32 + (swz % 64) / 2; }
__host__ __device__ __forceinline__ int perm32(int rho) { const int n = rho >> 4, i = rho & 15; return 8 * (i >> 2) + 4 * n + (i & 3); }

struct Unit { int pm, pn, pb, e, l0, ui; };
struct Gemm { const void* A; const void* Bt; int rb; };
typedef int v8i_t __attribute__((ext_vector_type(8)));
typedef int v4i_t __attribute__((ext_vector_type(4)));

struct StaticOrder {
    int nM, nN, nwg, G, c, pn_base, lo_c;
    __device__ void init(int nM_, int nN_, int G_, int c_) { nM = nM_; nN = nN_; nwg = nM * nN; G = G_; c = c_; pn_base = 0; lo_c = 0; }
    __device__ bool next(int i, Unit& u) const {
        long L = (long)i * G + c;
        if (lo_c > 0) { const int hi_n = G - lo_c; if (c >= lo_c) { if (i >= 4) return false; L = (long)(c - lo_c) + (long)hi_n * i; } else { if (i >= 2) return false; L = 4L * hi_n + c + (long)lo_c * i; } }
        return unit_of(L, i, u);
    }
    __device__ bool unit_of(long L, int i, Unit& u) const {
        if (L >= nwg) return false;
        int wgid = (int)L; { const int q = nwg / NXCD, r = nwg % NXCD, xcd = wgid % NXCD, off = wgid / NXCD; wgid = (xcd < r ? xcd * (q + 1) : r * (q + 1) + (xcd - r) * q) + off; }
        const int nig = WGM * nN, gid = wgid / nig, fm = gid * WGM, gsz = (nM - fm) < WGM ? (nM - fm) : WGM;
        u.pm = fm + ((wgid % nig) % gsz); u.pb = (wgid % nig) / gsz; u.pn = u.pb + pn_base; u.e = 0; u.l0 = 0; u.ui = i; return true;
    }
    __device__ __forceinline__ void a_ready(const Unit&, int, int) const {}
    __device__ __forceinline__ void done(const Unit&, int) const {}
    __device__ __forceinline__ void claim_issue(int, int, int, unsigned&) const {}
    __device__ __forceinline__ void claim_commit(int, int, int, unsigned) const {}
};
struct GroupOrder {
    StaticOrder so; const PG8_LAS int* s_base; const int* tlist; unsigned* ready; int mode;
    const PG8_LAS unsigned short* toks;
    __device__ bool next(int i, Unit& u) const { if (!so.next(i, u)) return false; const int e = s_base[64 + u.pm]; u.e = e; u.l0 = u.pm * 256 - s_base[e]; u.pb = e * so.nN + u.pn; return true; }
    __device__ __forceinline__ int row_token(int ui, int r) const { return (int)toks[ui * 256 + r]; }
    __device__ __forceinline__ void done(const Unit& u, int lane) const {
        if (mode == 1) {
            asm volatile("s_waitcnt vmcnt(0)" ::: "memory");
            if (lane == 0) __hip_atomic_fetch_add(ready + 64 * u.pm, 1u, __ATOMIC_RELAXED, __HIP_MEMORY_SCOPE_AGENT);
        }
    }
    __device__ __forceinline__ void a_ready(const Unit& u, int wid, int lane) const {
        if (mode == 2) {
            if (wid == 0) {
                unsigned spins = 0;
                while ((unsigned)__builtin_amdgcn_readfirstlane(__hip_atomic_load(ready + 64 * u.pm, __ATOMIC_RELAXED, __HIP_MEMORY_SCOPE_AGENT)) < 32u) {
                    __builtin_amdgcn_s_sleep(2);
                    if (++spins > (1u << 22)) break;
                }
                __builtin_amdgcn_fence(__ATOMIC_ACQUIRE, "agent");
                asm volatile("s_waitcnt vmcnt(0)" ::: "memory");
            }
            asm volatile("" ::: "memory"); __builtin_amdgcn_s_barrier(); asm volatile("" ::: "memory");
        }
    }
    __device__ __forceinline__ void stage_tokens(PG8_LAS unsigned short* dst, int tid, int nthreads) const {
        Unit u;
        for (int ui = 0; so.next(ui, u); ++ui) {
            const int e = s_base[64 + u.pm], l0 = u.pm * 256 - s_base[e], nval = s_base[32 + e] - l0;
            for (int r = tid; r < 256; r += nthreads) dst[ui * 256 + r] = (unsigned short)(r < nval ? tlist[(size_t)e * 32768 + l0 + r] : 0);
        }
    }
    __device__ __forceinline__ void stage_stats(PG8_LAS float* dst, const float* stats, int tid, int nthreads) const {
        Unit u;
        for (int ui = 0; so.next(ui, u); ++ui) {
            const int e = s_base[64 + u.pm], l0 = u.pm * 256 - s_base[e], nval = s_base[32 + e] - l0;
            for (int r = tid; r < 256; r += nthreads) { const int tok = r < nval ? tlist[(size_t)e * 32768 + l0 + r] : 0;
                dst[2 * (ui * 256 + r)] = stats[2 * (size_t)tok]; dst[2 * (ui * 256 + r) + 1] = stats[2 * (size_t)tok + 1]; }
        }
    }
    __device__ __forceinline__ void stage_gates(PG8_LAS float* dst, const float* glist, int tid, int nthreads) const {
        Unit u;
        for (int ui = 0; so.next(ui, u); ++ui) {
            const int e = s_base[64 + u.pm], l0 = u.pm * 256 - s_base[e], nval = s_base[32 + e] - l0;
            for (int r = tid; r < 256; r += nthreads) dst[ui * 256 + r] = r < nval ? glist[(size_t)e * 32768 + l0 + r] : 0.f;
        }
    }
    __device__ __forceinline__ void claim_issue(int, int, int, unsigned&) const {}
    __device__ __forceinline__ void claim_commit(int, int, int, unsigned) const {}
};
struct DynGroupOrder {
    StaticOrder so; const PG8_LAS int* s_base; unsigned* ready; unsigned* cnt; int x; PG8_LAS int* slot;
    __device__ bool next(int i, Unit& u) const {
        const int L = slot[i & 1];
        if (!so.unit_of((long)L, i, u)) return false;
        const int e = s_base[64 + u.pm]; u.e = e; u.l0 = u.pm * 256 - s_base[e]; u.pb = e * so.nN + u.pn; return true;
    }
    __device__ __forceinline__ unsigned claim_one() const { const unsigned k = __hip_atomic_fetch_add(cnt, 1u, __ATOMIC_RELAXED, __HIP_MEMORY_SCOPE_AGENT); return k * 8u + (unsigned)x; }
    __device__ __forceinline__ void claim_issue(int, int, int, unsigned&) const {}
    __device__ __forceinline__ void claim_commit(int, int, int, unsigned) const {}
    __device__ __forceinline__ void done(const Unit&, int) const {}
    __device__ __forceinline__ void a_ready(const Unit& u, int wid, int lane) const {
        if (wid == 0) {
            unsigned nxtL = 0u;
            if (u.ui >= 1 && lane == 0) nxtL = claim_one();
            unsigned spins = 0;
            while ((unsigned)__builtin_amdgcn_readfirstlane(__hip_atomic_load(ready + 64 * u.pm, __ATOMIC_RELAXED, __HIP_MEMORY_SCOPE_AGENT)) < 32u) {
                __builtin_amdgcn_s_sleep(2);
                if (++spins > (1u << 22)) break;
            }
            __builtin_amdgcn_fence(__ATOMIC_ACQUIRE, "agent");
            asm volatile("s_waitcnt vmcnt(0)" ::: "memory");
            if (u.ui >= 1 && lane == 0) slot[(u.ui + 1) & 1] = (int)(nxtL > 0x3fffffffu ? 0x3fffffffu : nxtL);
            asm volatile("s_waitcnt lgkmcnt(0)" ::: "memory");
        }
        asm volatile("" ::: "memory"); __builtin_amdgcn_s_barrier(); asm volatile("" ::: "memory");
    }
};

template <class Epi, class Sched, bool ALIGN_EPI = MK_ALIGN, bool GATHER = false, bool F8 = false>
__device__ __forceinline__ void gemm_phase(PG8_LAS unsigned char* lds, const Gemm g, const Sched& S, const Epi& E, const int wave_id) {
    int lane; asm volatile("v_mbcnt_lo_u32_b32 %0, -1, 0\n\tv_mbcnt_hi_u32_b32 %0, -1, %0" : "=&v"(lane));
    const int wid = wave_id, tid = wid * 64 + lane, wr = wid >> 2, wc = wid & 3, fr = lane & 15, fq = lane >> 4;
    const int RB = g.rb, nt = RB / 128;
    unsigned voffA[2], voffB[2];
#pragma unroll
    for (int i = 0; i < 2; ++i) { int R, C; stage_rc(tid * 16 + i * 8192, R, C); const int Rb = Epi::PERM ? ((R & ~31) + perm32(R & 31)) : R;
        voffA[i] = (unsigned)(R * RB + C * 2); voffB[i] = (unsigned)(Rb * RB + C * 2); }
    const size_t kstep = (size_t)(BK * 2);
    const size_t hstep = (size_t)HALF * RB;
    const size_t tstep = 2 * hstep;
    const unsigned ldsw = (unsigned)wid * 1024u;
    const int aoff = lds_byte(wr * 64 + fr, fq * 8), boff = lds_byte(wc * 32 + fr, fq * 8);
#define PG8_SA(b, h) (((b) * 2 + (h)) * HTB)
#define PG8_SB(b, h) ((4 + (b) * 2 + (h)) * HTB)
#define PG8_STAGE(bufoff, gbase, voff) do { _Pragma("unroll") for (int _i = 0; _i < 2; ++_i) \
        __builtin_amdgcn_global_load_lds((const unsigned*)((const char*)(gbase) + (voff)[_i]), (PG8_LAS unsigned*)(lds + (bufoff) + ldsw + _i * 8192), 16, 0, 0); } while (0)
#define PG8_STAGE_A(bufoff, gbase, half, usenext) do { if constexpr (GATHER) { _Pragma("unroll") for (int _i = 0; _i < 2; ++_i) \
        __builtin_amdgcn_global_load_lds((const unsigned*)((const char*)(gbase) + ((usenext) ? (((gnp[_i] >> (16 * (half))) & 0xffffu) * (unsigned)RB + (ga[half][_i] & (unsigned)(RB - 1))) : ga[half][_i])), (PG8_LAS unsigned*)(lds + (bufoff) + ldsw + _i * 8192), 16, 0, 0); } \
        else { PG8_STAGE(bufoff, (gbase) + (half) * hstep, voffA); } } while (0)
#define PG8_LD16(off) (*(const PG8_LAS v4i_t*)(lds + (off)))
#define PG8_LDA(dst, b, h) do { _Pragma("unroll") for (int m = 0; m < 4; ++m) { if constexpr (F8) dst##8[m] = __builtin_shufflevector(PG8_LD16(PG8_SA(b, h) + aoff + m * 2048), PG8_LD16(PG8_SA(b, h) + aoff + m * 2048 + 1024), 0, 1, 2, 3, 4, 5, 6, 7); \
        else { _Pragma("unroll") for (int k = 0; k < 2; ++k) dst[m][k] = *(const PG8_LAS bf16x8*)(lds + PG8_SA(b, h) + aoff + m * 2048 + k * 1024); } } } while (0)
#define PG8_LDB(dst, b, h) do { _Pragma("unroll") for (int n = 0; n < 2; ++n) { if constexpr (F8) dst##8[n] = __builtin_shufflevector(PG8_LD16(PG8_SB(b, h) + boff + n * 2048), PG8_LD16(PG8_SB(b, h) + boff + n * 2048 + 1024), 0, 1, 2, 3, 4, 5, 6, 7); \
        else { _Pragma("unroll") for (int k = 0; k < 2; ++k) dst[n][k] = *(const PG8_LAS bf16x8*)(lds + PG8_SB(b, h) + boff + n * 2048 + k * 1024); } } } while (0)
#define PG8_MMA(ai, bj, At, Bt) do { __builtin_amdgcn_s_setprio(1); _Pragma("unroll") for (int m = 0; m < 4; ++m) _Pragma("unroll") for (int n = 0; n < 2; ++n) { \
        if constexpr (F8) asm volatile("s_nop 1\n\tv_mfma_scale_f32_16x16x128_f8f6f4 %0, %1, %2, %0, %3, %3 op_sel_hi:[0,0,0]" : "+v"(acc[ai][bj][m][n]) : "v"(Bt##8[n]), "v"(At##8[m]), "v"(one8));   \
        else { _Pragma("unroll") for (int k = 0; k < 2; ++k) acc[ai][bj][m][n] = __builtin_amdgcn_mfma_f32_16x16x32_bf16(Bt[n][k], At[m][k], acc[ai][bj][m][n], 0, 0, 0); } } \
        __builtin_amdgcn_s_setprio(0); } while (0)
#define PG8_WAIT_V(n) asm volatile("s_waitcnt vmcnt(" #n ")" ::: "memory")
#define PG8_WAIT_L(n) asm volatile("s_waitcnt lgkmcnt(" #n ")" ::: "memory")
#define PG8_BAR __builtin_amdgcn_s_barrier()
#define PG8_SCHED __builtin_amdgcn_sched_barrier(0)
    Unit cur, nxt; int ui = 0;
    if (!S.next(0, cur)) return;
    S.a_ready(cur, wid, lane);
    f32x4 acc[2][2][4][2];
#pragma unroll
    for (int a = 0; a < 2; ++a)
#pragma unroll
        for (int b = 0; b < 2; ++b)
#pragma unroll
            for (int m = 0; m < 4; ++m)
#pragma unroll
                for (int n = 0; n < 2; ++n) acc[a][b][m][n] = (f32x4){0.f, 0.f, 0.f, 0.f};
    int one8 = 0x7f7f7f7f; asm volatile("" : "+v"(one8));
    bf16x8 At[4][2], B0[2][2], B1[2][2]; v8i_t At8[4], B08[2], B18[2];
    const char* cA = (const char*)g.A + (GATHER ? (size_t)0 : (size_t)cur.pm * tstep); const char* cB = (const char*)g.Bt + (size_t)cur.pb * tstep;
    unsigned ga[2][2], gnp[2];
    if constexpr (GATHER) {
#pragma unroll
        for (int i = 0; i < 2; ++i) { int R, C; stage_rc(tid * 16 + i * 8192, R, C);
            const unsigned t0 = (unsigned)S.row_token(0, R), t1 = (unsigned)S.row_token(0, 128 + R);
            ga[0][i] = t0 * (unsigned)RB + (unsigned)(C * 2); ga[1][i] = t1 * (unsigned)RB + (unsigned)(C * 2); gnp[i] = t0 | (t1 << 16); }
    }
    PG8_STAGE(PG8_SB(0, 0), cB, voffB); PG8_STAGE(PG8_SB(0, 1), cB + hstep, voffB); PG8_STAGE_A(PG8_SA(0, 0), cA, 0, false); PG8_STAGE_A(PG8_SA(0, 1), cA, 1, false);
    if (wr == 1) PG8_BAR;
    PG8_WAIT_V(2); PG8_BAR;
    PG8_STAGE(PG8_SB(1, 0), cB + kstep, voffB); PG8_STAGE_A(PG8_SA(1, 0), cA + kstep, 0, false); PG8_STAGE(PG8_SB(1, 1), cB + hstep + kstep, voffB);
    PG8_WAIT_V(6); PG8_BAR;
    for (;;) {
        const bool has_next = S.next(ui + 1, nxt);
        unsigned claim_ = 0u; S.claim_issue(ui + 2, wid, lane, claim_);
        if constexpr (GATHER) {
            if (has_next) {
                int ln2_; asm volatile("v_mbcnt_lo_u32_b32 %0, -1, 0\n\tv_mbcnt_hi_u32_b32 %0, -1, %0" : "=&v"(ln2_)); const int tid2_ = wid * 64 + ln2_;
#pragma unroll
                for (int i = 0; i < 2; ++i) { int R, C; stage_rc(tid2_ * 16 + i * 8192, R, C); gnp[i] = (unsigned)S.row_token(ui + 1, R) | ((unsigned)S.row_token(ui + 1, 128 + R) << 16); }
            }
        }
        const char* nA = (has_next && !GATHER) ? (const char*)g.A + (size_t)nxt.pm * tstep : cA; const char* nB = has_next ? (const char*)g.Bt + (size_t)nxt.pb * tstep : cB;
        for (int t = 0; t < nt; t += 2) {
            const bool last = (t == nt - 2);
            if (last) S.claim_commit(ui + 2, wid, lane, claim_);
            if (last && has_next) S.a_ready(nxt, wid, lane);
            const char* a1 = cA + (size_t)(t + 1) * kstep;
            const char* a2 = last ? nA : cA + (size_t)(t + 2) * kstep; const char* b2 = last ? nB : cB + (size_t)(t + 2) * kstep;
            const char* a3 = a2 + kstep; const char* b3 = b2 + kstep;
            PG8_LDB(B0, 0, 0); PG8_LDB(B1, 0, 1); PG8_SCHED; PG8_LDA(At, 0, 0); PG8_STAGE_A(PG8_SA(1, 1), a1, 1, false);
            PG8_WAIT_V(8); PG8_WAIT_L(0); PG8_BAR; PG8_MMA(0, 0, At, B0); PG8_MMA(0, 1, At, B1); PG8_BAR; PG8_SCHED;
            PG8_LDA(At, 0, 1); PG8_STAGE(PG8_SB(0, 0), b2, voffB); PG8_STAGE(PG8_SB(0, 1), b2 + hstep, voffB); PG8_STAGE_A(PG8_SA(0, 0), a2, 0, last);
            PG8_WAIT_V(8); PG8_WAIT_L(0); PG8_BAR; PG8_MMA(1, 0, At, B0); PG8_MMA(1, 1, At, B1); PG8_BAR; PG8_SCHED;
            PG8_LDB(B0, 1, 0); PG8_LDB(B1, 1, 1); PG8_SCHED; PG8_LDA(At, 1, 0); PG8_STAGE_A(PG8_SA(0, 1), a2, 1, last);
            PG8_WAIT_V(8); PG8_WAIT_L(0); PG8_BAR; PG8_MMA(0, 0, At, B0); PG8_MMA(0, 1, At, B1); PG8_BAR; PG8_SCHED;
            PG8_LDA(At, 1, 1); PG8_STAGE(PG8_SB(1, 0), b3, voffB); PG8_STAGE(PG8_SB(1, 1), b3 + hstep, voffB); PG8_STAGE_A(PG8_SA(1, 0), a3, 0, last);
            PG8_WAIT_V(8); PG8_WAIT_L(0); PG8_BAR; PG8_MMA(1, 0, At, B0); PG8_MMA(1, 1, At, B1); PG8_BAR; PG8_SCHED;
        }
        if constexpr (ALIGN_EPI) { if (wr == 0) PG8_BAR; }
        if constexpr (F8) asm volatile("s_nop 7\n\ts_nop 7" ::: "memory");
        { int ln_; asm volatile("v_mbcnt_lo_u32_b32 %0, -1, 0\n\tv_mbcnt_hi_u32_b32 %0, -1, %0" : "=&v"(ln_)); E(acc, cur, wr, wc, ln_ & 15, ln_ >> 4); S.done(cur, ln_); }
        if (!has_next) break;
#pragma unroll
        for (int a = 0; a < 2; ++a)
#pragma unroll
            for (int b = 0; b < 2; ++b)
#pragma unroll
                for (int m = 0; m < 4; ++m)
#pragma unroll
                    for (int n = 0; n < 2; ++n) acc[a][b][m][n] = (f32x4){0.f, 0.f, 0.f, 0.f};
        cur = nxt; cA = nA; cB = nB; ++ui;
        if constexpr (GATHER) {
#pragma unroll
            for (int h = 0; h < 2; ++h)
#pragma unroll
                for (int i = 0; i < 2; ++i) ga[h][i] = ((gnp[i] >> (16 * h)) & 0xffffu) * (unsigned)RB + (ga[h][i] & (unsigned)(RB - 1));
        }
        if constexpr (ALIGN_EPI) { if (wr == 1) PG8_BAR; }
    }
    PG8_WAIT_V(0);
    if constexpr (!ALIGN_EPI) { if (wr == 0) PG8_BAR; }
    PG8_BAR;
#undef PG8_SA
#undef PG8_SB
#undef PG8_STAGE
#undef PG8_STAGE_A
#undef PG8_LDA
#undef PG8_LDB
#undef PG8_MMA
#undef PG8_LD16
#undef PG8_WAIT_V
#undef PG8_WAIT_L
#undef PG8_BAR
#undef PG8_SCHED
}
}
#ifndef MK_REPEAT
#define MK_REPEAT -1
#endif
namespace mk {
constexpr int NB = 16, S = 2048, T = NB * S, D = 1024, NCOL = 2304, NE = 16, FF = 512;
constexpr float ALPHA = 1.4142135623730951f, LN_EPS = 1e-5f, LOG2E = 1.4426950408889634f;
constexpr int NWAVES = 8, NTHREADS = 512;
constexpr int MAXROWS = 69632;
constexpr int MAXTILES = 272;

constexpr size_t MiB = 1u << 20;
constexpr size_t WS_CTL = 0, CTL_ZERO_BYTES = 1 * MiB;
constexpr size_t WS_ROPE = 1 * MiB;
constexpr size_t WS_TOKE = WS_ROPE + 256 * 1024;
constexpr size_t WS_TOKG = WS_TOKE + 256 * 1024;
constexpr size_t WS_TOKP = WS_TOKG + 256 * 1024;
constexpr size_t WS_STATS = 2 * MiB;
constexpr size_t WS_LSE = 3 * MiB;
constexpr size_t WS_WPT = 6 * MiB;
constexpr size_t WS_WST = 6 * MiB + 64 * 1024;
constexpr size_t WS_RWQ = 6 * MiB + 512 * 1024;
constexpr size_t WS_CR = 6 * MiB + 768 * 1024;
constexpr size_t WS_C1P = 7 * MiB;
constexpr size_t WS_C2P = 7 * MiB + 256 * 1024;
constexpr size_t WS_WIN8 = 8 * MiB, WS_WINB = 12 * MiB, WS_WOUT = 17 * MiB, WS_WGU = 21 * MiB, WS_WDN = 85 * MiB;
constexpr size_t WS_XB8 = 445 * MiB;
constexpr size_t WS_Y1B = 117 * MiB;
constexpr size_t WS_TLIST = 181 * MiB;
constexpr size_t WS_GLIST = 183 * MiB;
constexpr size_t WS_Y1F = 185 * MiB;
constexpr size_t WS_YB = 245 * MiB;
constexpr size_t WS_HB = 381 * MiB;
constexpr size_t WS_Q = 117 * MiB, WS_K = 149 * MiB, WS_V = 181 * MiB, WS_U = 213 * MiB, WS_G = 229 * MiB, WS_Z = 245 * MiB;
constexpr size_t WS_PO = 261 * MiB;
constexpr size_t WS_CC = 445 * MiB;
constexpr size_t WS_END = 509 * MiB;
constexpr int CW_CNT = 64;
constexpr int CW_BAR = 4096;
constexpr int CW_Q = 128;
constexpr int CW_RDY = 65536;

constexpr int RING_BYTES = 131072;
constexpr int MISC_OFF = RING_BYTES + 320;
constexpr int TAB_OFF = RING_BYTES + 1024;
constexpr int LDS_BYTES = 147456;

#define GAS __attribute__((address_space(1)))
#define LAS __attribute__((address_space(3)))
typedef unsigned short bf16;
typedef unsigned v4u __attribute__((ext_vector_type(4)));
typedef unsigned v2u __attribute__((ext_vector_type(2)));
typedef float f32x4 __attribute__((ext_vector_type(4)));
typedef float f32x2 __attribute__((ext_vector_type(2)));
typedef float f32x16 __attribute__((ext_vector_type(16)));
typedef short bf16x8 __attribute__((ext_vector_type(8)));
typedef short s16x4 __attribute__((ext_vector_type(4)));
typedef __bf16 bf16x2_t __attribute__((ext_vector_type(2)));
typedef GAS unsigned gu32;
#define RLX_AGENT __ATOMIC_RELAXED, __HIP_MEMORY_SCOPE_AGENT
#define LDS_WAIT() asm volatile("s_waitcnt lgkmcnt(0)" ::: "memory")

__device__ __forceinline__ unsigned pk2(float lo, float hi) { f32x2 v = {lo, hi}; bf16x2_t r = __builtin_convertvector(v, bf16x2_t); return __builtin_bit_cast(unsigned, r); }
__device__ __forceinline__ unsigned pk4_fp8(float a, float b, float c, float d) { int r = 0; r = __builtin_amdgcn_cvt_pk_fp8_f32(a, b, r, false); r = __builtin_amdgcn_cvt_pk_fp8_f32(c, d, r, true); return (unsigned)r; }
__device__ __forceinline__ float fp8_rt(float a) { const int r = __builtin_amdgcn_cvt_pk_fp8_f32(a, a, 0, false); return __builtin_amdgcn_cvt_f32_fp8(r, 0); }
constexpr float W8_SCALE = 64.0f, H8_SCALE = 8.0f, Y8_SCALE = 16.0f;
__device__ __forceinline__ float bflo(unsigned u) { return __builtin_bit_cast(float, u << 16); }
__device__ __forceinline__ float bfhi(unsigned u) { return __builtin_bit_cast(float, u & 0xffff0000u); }
__device__ __forceinline__ float wave_sum(float v) {
#pragma unroll
    for (int o = 1; o < 64; o <<= 1) v += __shfl_xor(v, o);
    return v;
}
__device__ __forceinline__ float fast_exp2(float x) { return __builtin_amdgcn_exp2f(x); }
__device__ __forceinline__ float fast_rcp(float x) { return __builtin_amdgcn_rcpf(x); }
__device__ __forceinline__ float gelu_t(float x) {
    const float y = x * (1.5957691216057308f + 0.07135481627159498f * x * x);
    return x * fast_rcp(1.0f + fast_exp2(-LOG2E * y));
}
__device__ __forceinline__ float silu_f(float x) { return x * fast_rcp(1.0f + fast_exp2(-LOG2E * x)); }
__device__ __forceinline__ int crow(int reg, int h) { return (reg & 3) + 8 * (reg >> 2) + 4 * h; }

#define XB_TMO      128
#define XB_XCNT(j)  (256  + 64 * (j))
#define XB_XSUB(j)  (1280 + 64 * (j))
#define XB_XGEN(j)  (2304 + 64 * (j))
#define XB_TOP      3328
#define XB_TOPGEN   3392
#define XCD_BAR_WORDS 3456
#define XB_SPIN_CAP (1u << 22)
__device__ __forceinline__ unsigned xb_ld(unsigned* p)              { return __hip_atomic_load(p, __ATOMIC_RELAXED, __HIP_MEMORY_SCOPE_AGENT); }
__device__ __forceinline__ unsigned xb_add(unsigned* p, unsigned v) { return __hip_atomic_fetch_add(p, v, __ATOMIC_RELAXED, __HIP_MEMORY_SCOPE_AGENT); }
__device__ __forceinline__ unsigned xb_xcc_id() { return (unsigned)__builtin_amdgcn_s_getreg((3 << 11) | 20) & 0xFu; }
#define XB_SPIN(cond, bar) do { unsigned _sp = 0; while (cond) { __builtin_amdgcn_s_sleep(1); \
    if ((++_sp & 255u) == 0u) { if (xb_ld(&(bar)[XB_TMO])) break; if (_sp > XB_SPIN_CAP) { atomicAdd(&(bar)[XB_TMO], 1u); break; } } } } while (0)
struct XcdBarrier { unsigned* bar; unsigned x; volatile LAS unsigned* st; };
__device__ __forceinline__ XcdBarrier xcd_barrier_post(unsigned* bar, volatile LAS unsigned* st, int tid) {
    XcdBarrier b; b.bar = bar; b.x = xb_xcc_id(); b.st = st;
    if (tid == 0) (void)xb_add(&bar[XB_XCNT(b.x)], 1u);
    return b;
}
__device__ __forceinline__ void xcd_barrier_complete(unsigned* bar, unsigned x, unsigned& nloc, unsigned& nx) {
    const unsigned G = gridDim.x * gridDim.y * gridDim.z;
    unsigned sum, cnt, mine, sp = 0u;
    for (;;) {
        sum = 0u; cnt = 0u; mine = 0u;
#pragma unroll
        for (unsigned j = 0; j < 16; ++j) { const unsigned c = xb_ld(&bar[XB_XCNT(j)]); sum += c; cnt += (c > 0u) ? 1u : 0u; mine = (j == x) ? c : mine; }
        if (sum == G) break;
        __builtin_amdgcn_s_sleep(1);
        if ((++sp & 255u) == 0u) { if (xb_ld(&bar[XB_TMO])) break; if (sp > XB_SPIN_CAP) { atomicAdd(&bar[XB_TMO], 1u); break; } }
    }
    nloc = mine > 0u ? mine : 1u; nx = cnt > 0u ? cnt : 1u;
}
__device__ __forceinline__ void xcd_barrier(const XcdBarrier& b, int tid) {
    asm volatile("s_waitcnt vmcnt(0)" ::: "memory");
    __syncthreads();
    if (tid == 0) {
        unsigned* bar = b.bar;
        __builtin_amdgcn_s_waitcnt(0);
        unsigned nloc = b.st[0], nx = b.st[1];
        if (nloc == 0u) { xcd_barrier_complete(bar, b.x, nloc, nx); b.st[0] = nloc; b.st[1] = nx; }
        const unsigned old = xb_add(&bar[XB_XSUB(b.x)], 1u);
        const unsigned gen = old / nloc;
        if (old + 1u == (gen + 1u) * nloc) {
            __builtin_amdgcn_fence(__ATOMIC_RELEASE, "agent");
            asm volatile("s_waitcnt vmcnt(0)" ::: "memory");
            const unsigned og = xb_add(&bar[XB_TOP], 1u);
            const unsigned tg = og / nx;
            if (og + 1u == (tg + 1u) * nx) xb_add(&bar[XB_TOPGEN], 1u);
            else XB_SPIN(xb_ld(&bar[XB_TOPGEN]) == tg, bar);
            __builtin_amdgcn_fence(__ATOMIC_ACQUIRE, "agent");
            xb_add(&bar[XB_XGEN(b.x)], 1u);
            asm volatile("s_waitcnt vmcnt(0)" ::: "memory");
        } else {
            XB_SPIN(xb_ld(&bar[XB_XGEN(b.x)]) == gen, bar);
            __builtin_amdgcn_fence(__ATOMIC_ACQUIRE, "agent");
            asm volatile("s_waitcnt vmcnt(0)" ::: "memory");
        }
    }
    __syncthreads();
}

#ifdef NO_FENCE
#define EPI_FENCE() do {} while (0)
#else
#define EPI_FENCE() asm volatile("" ::: "memory")
#endif
using pg8::Unit;
struct EpiProj {
    static constexpr bool PERM = true;
    unsigned char* ws; const float *lg, *lb; float accscale;
    static __device__ __forceinline__ void store16(bf16* dst, const f32x4 (&v)[2]) {
        v4u w; w.x = pk2(v[0][0], v[0][1]); w.y = pk2(v[0][2], v[0][3]); w.z = pk2(v[1][0], v[1][1]); w.w = pk2(v[1][2], v[1][3]);
        *(v4u*)dst = w;
    }
    template <int MODE>
    __device__ __forceinline__ void run(const f32x4 (&acc)[2][2][4][2], const Unit& u, int wr, int wc, int fr, int fq) const {
        const int pn = u.pn;
        const int rowb = u.pm * 256 + wr * 64 + fr;
        bf16* dbase; int cstep = 128, rstride = 512;
        if (MODE == 0) dbase = nullptr;
        else if (MODE == 1) { if (pn < 6) dbase = (bf16*)(ws + WS_V) + (pn - 4) * 256 + wc * 32 + 8 * fq; else { dbase = (bf16*)(ws + WS_Z) + wc * 32 + 8 * fq; rstride = 256; } }
        else if (MODE == 2) { dbase = (bf16*)(ws + WS_U) + wc * 32 + 8 * fq; rstride = 256; }
        else { dbase = (bf16*)(ws + WS_G) + wc * 64 + 8 * fq; rstride = 256; cstep = 32; }
        const bool dorope = ((wc & 1) == 0) && (fq < 2);
        const float sc = accscale;
        const float* rope = (const float*)(ws + WS_ROPE) + (size_t)(4 * (fq & 1)) * 2;
        f32x4 rc[4][2];
        if (MODE == 0) {
#pragma unroll
            for (int g = 0; g < 4; ++g) { const int pos = (rowb + (g >> 2) * 128 + (g & 3) * 16) & (S - 1);
                rc[g][0] = *(const f32x4*)(rope + (size_t)pos * 16); rc[g][1] = *(const f32x4*)(rope + (size_t)pos * 16 + 4); }
        }
        f32x4 lgv[2][2], lbv[2][2];
        if (MODE == 3) {
#pragma unroll
            for (int bj = 0; bj < 2; ++bj)
#pragma unroll
                for (int n = 0; n < 2; ++n) { const int dim = wc * 64 + 32 * bj + 8 * fq + 4 * n; lgv[bj][n] = *(const f32x4*)(lg + dim); lbv[bj][n] = *(const f32x4*)(lb + dim); }
        }
#pragma unroll
        for (int g = 0; g < 8; ++g) {
            const int ai = g >> 2, m = g & 3;
            const int row = rowb + ai * 128 + m * 16;
            f32x4 v[2][2];
#pragma unroll
            for (int bj = 0; bj < 2; ++bj)
#pragma unroll
                for (int n = 0; n < 2; ++n) v[bj][n] = (MODE == 1) ? acc[ai][bj][m][n] * accscale : acc[ai][bj][m][n];
            if (MODE == 0) {
                const f32x4 cs0 = rc[g & 3][0], cs1 = rc[g & 3][1];
                if (g + 4 < 8) { const int pos = (rowb + ((g + 4) >> 2) * 128 + ((g + 4) & 3) * 16) & (S - 1);
                    rc[g & 3][0] = *(const f32x4*)(rope + (size_t)pos * 16); rc[g & 3][1] = *(const f32x4*)(rope + (size_t)pos * 16 + 4); }
                if (dorope) {
#pragma unroll
                    for (int bj = 0; bj < 2; ++bj) {
                        float a, b;
                        a = v[bj][0][0]; b = v[bj][0][1]; v[bj][0][0] = a * cs0[0] - b * cs0[1]; v[bj][0][1] = b * cs0[0] + a * cs0[1];
                        a = v[bj][0][2]; b = v[bj][0][3]; v[bj][0][2] = a * cs0[2] - b * cs0[3]; v[bj][0][3] = b * cs0[2] + a * cs0[3];
                        a = v[bj][1][0]; b = v[bj][1][1]; v[bj][1][0] = a * cs1[0] - b * cs1[1]; v[bj][1][1] = b * cs1[0] + a * cs1[1];
                        a = v[bj][1][2]; b = v[bj][1][3]; v[bj][1][2] = a * cs1[2] - b * cs1[3]; v[bj][1][3] = b * cs1[2] + a * cs1[3];
                    }
                }
#pragma unroll
                for (int bj = 0; bj < 2; ++bj)
#pragma unroll
                    for (int n = 0; n < 2; ++n) v[bj][n] = v[bj][n] * sc;
            }
            if (MODE == 2 || MODE == 3) {
#pragma unroll
                for (int bj = 0; bj < 2; ++bj)
#pragma unroll
                    for (int n = 0; n < 2; ++n)
#pragma unroll
                        for (int e = 0; e < 4; ++e) v[bj][n][e] = gelu_t(v[bj][n][e]);
            }
            if (MODE == 3) {
                float s = 0.f;
#pragma unroll
                for (int bj = 0; bj < 2; ++bj)
#pragma unroll
                    for (int n = 0; n < 2; ++n) s += (v[bj][n][0] + v[bj][n][1]) + (v[bj][n][2] + v[bj][n][3]);
                s += __shfl_xor(s, 16); s += __shfl_xor(s, 32);
                const float mu = s * (1.0f / 64.0f); float q = 0.f;
#pragma unroll
                for (int bj = 0; bj < 2; ++bj)
#pragma unroll
                    for (int n = 0; n < 2; ++n)
#pragma unroll
                        for (int e = 0; e < 4; ++e) { v[bj][n][e] -= mu; q += v[bj][n][e] * v[bj][n][e]; }
                q += __shfl_xor(q, 16); q += __shfl_xor(q, 32);
                const float rstd = rsqrtf(q * (1.0f / 64.0f) + LN_EPS);
#pragma unroll
                for (int bj = 0; bj < 2; ++bj)
#pragma unroll
                    for (int n = 0; n < 2; ++n) v[bj][n] = v[bj][n] * rstd * lgv[bj][n] + lbv[bj][n];
            }
            if (MODE == 0) {
                unsigned char* d8 = ws + (pn < 2 ? WS_Q : WS_K) + (size_t)row * 512 + (pn & 1) * 256 + wc * 32 + 8 * fq;
                v2u w0; w0.x = pk4_fp8(v[0][0][0], v[0][0][1], v[0][0][2], v[0][0][3]); w0.y = pk4_fp8(v[0][1][0], v[0][1][1], v[0][1][2], v[0][1][3]); *(v2u*)d8 = w0;
                v2u w1; w1.x = pk4_fp8(v[1][0][0], v[1][0][1], v[1][0][2], v[1][0][3]); w1.y = pk4_fp8(v[1][1][0], v[1][1][1], v[1][1][2], v[1][1][3]); *(v2u*)(d8 + 128) = w1;
            } else {
                bf16* dst = dbase + (size_t)row * rstride;
                store16(dst, v[0]); store16(dst + cstep, v[1]);
            }
            EPI_FENCE();
        }
    }
    __device__ __forceinline__ void operator()(const f32x4 (&acc)[2][2][4][2], const Unit& u, int wr, int wc, int fr, int fq) const {
        const int pn = u.pn;
        if (pn < 4) run<0>(acc, u, wr, wc, fr, fq);
        else if (pn == 6) run<2>(acc, u, wr, wc, fr, fq);
        else if (pn == 7) run<3>(acc, u, wr, wc, fr, fq);
        else run<1>(acc, u, wr, wc, fr, fq);
    }
};
struct EpiOutB {
    static constexpr bool PERM = true;
    const bf16* xres; bf16* Y; unsigned char* Y8;
    __device__ __forceinline__ void operator()(const f32x4 (&acc)[2][2][4][2], const Unit& u, int wr, int wc, int fr, int fq) const {
        const size_t off0 = (size_t)(u.pm * 256 + wr * 64 + fr) * D + u.pn * 256 + wc * 32 + 8 * fq;
        v4u xr[4][2];
#pragma unroll
        for (int g = 0; g < 4; ++g) { const size_t off = off0 + (size_t)((g >> 2) * 128 + (g & 3) * 16) * D; xr[g][0] = *(const v4u*)(xres + off); xr[g][1] = *(const v4u*)(xres + off + 128); }
#pragma unroll
        for (int g = 0; g < 8; ++g) {
            const int ai = g >> 2, m = g & 3;
            const size_t off = off0 + (size_t)(ai * 128 + m * 16) * D;
            const v4u x0 = xr[g & 3][0], x1 = xr[g & 3][1];
            if (g + 4 < 8) { const size_t offn = off0 + (size_t)(((g + 4) >> 2) * 128 + ((g + 4) & 3) * 16) * D; xr[g & 3][0] = *(const v4u*)(xres + offn); xr[g & 3][1] = *(const v4u*)(xres + offn + 128); }
#pragma unroll
            for (int bj = 0; bj < 2; ++bj) {
                const v4u x = bj ? x1 : x0;
                const f32x4 a = acc[ai][bj][m][0], b = acc[ai][bj][m][1];
                v4u w; w.x = pk2(a[0] + ALPHA * bflo(x.x), a[1] + ALPHA * bfhi(x.x)); w.y = pk2(a[2] + ALPHA * bflo(x.y), a[3] + ALPHA * bfhi(x.y));
                w.z = pk2(b[0] + ALPHA * bflo(x.z), b[1] + ALPHA * bfhi(x.z)); w.w = pk2(b[2] + ALPHA * bflo(x.w), b[3] + ALPHA * bfhi(x.w));
                *(v4u*)(Y + off + bj * 128) = w;
                v2u w8; w8.x = pk4_fp8(a[0] + ALPHA * bflo(x.x), a[1] + ALPHA * bfhi(x.x), a[2] + ALPHA * bflo(x.y), a[3] + ALPHA * bfhi(x.y));
                w8.y = pk4_fp8(b[0] + ALPHA * bflo(x.z), b[1] + ALPHA * bfhi(x.z), b[2] + ALPHA * bflo(x.w), b[3] + ALPHA * bfhi(x.w));
                *(v2u*)(Y8 + off + bj * 128) = w8;
            }
            EPI_FENCE();
        }
    }
};
struct EpiGU {
    static constexpr bool PERM = true;
    unsigned char* ws; const LAS float* meta; int l;
    __device__ __forceinline__ void operator()(const f32x4 (&acc)[2][2][4][2], const Unit& u, int wr, int wc, int fr, int fq) const {
        const int cb = u.e * 1024 + u.pn * 256 + wc * 32 + 8 * fq;
        unsigned char* H = ws + WS_HB;
        const float* c1a = (const float*)(ws + WS_C1P) + (size_t)l * 16 * 1024; const float* c1b = c1a + 32 * 1024; const float* c2a = c1a + 65536; const float* c2b = c2a + 32 * 1024;
        float c1[2][8], c2[2][8];
#pragma unroll
        for (int bj = 0; bj < 2; ++bj)
#pragma unroll
            for (int n = 0; n < 2; ++n) {
                const f32x4 a = *(const f32x4*)(c1a + cb + bj * 128 + 4 * n), b = *(const f32x4*)(c1b + cb + bj * 128 + 4 * n);
                const f32x4 c = *(const f32x4*)(c2a + cb + bj * 128 + 4 * n), d = *(const f32x4*)(c2b + cb + bj * 128 + 4 * n);
#pragma unroll
                for (int e = 0; e < 4; ++e) { c1[bj][4 * n + e] = a[e] + b[e]; c2[bj][4 * n + e] = c[e] + d[e]; }
            }
#pragma unroll
        for (int ai = 0; ai < 2; ++ai)
#pragma unroll
            for (int m = 0; m < 4; ++m) {
                const int rl = ai * 128 + wr * 64 + m * 16 + fr;
                const f32x2 st = *(const LAS f32x2*)(meta + 2 * (u.ui * 256 + rl));
                float hv[8];
#pragma unroll
                for (int n = 0; n < 2; ++n)
#pragma unroll
                    for (int e = 0; e < 4; ++e) {
                        const float g = st.y * (acc[ai][0][m][n][e] * (1.0f / W8_SCALE) - st.x * c1[0][4 * n + e]) + c2[0][4 * n + e];
                        const float up = st.y * (acc[ai][1][m][n][e] * (1.0f / W8_SCALE) - st.x * c1[1][4 * n + e]) + c2[1][4 * n + e];
                        hv[4 * n + e] = silu_f(g) * up * H8_SCALE;
                    }
                v2u w; w.x = pk4_fp8(hv[0], hv[1], hv[2], hv[3]); w.y = pk4_fp8(hv[4], hv[5], hv[6], hv[7]);
                { unsigned char* hp = H + (size_t)(u.pm * 256 + rl) * FF + u.pn * 128 + wc * 32 + 8 * fq;
                  asm volatile("global_store_dwordx2 %0, %1, off sc1" :: "v"(hp), "v"(w) : "memory"); }
                EPI_FENCE();
            }
    }
};
struct EpiDown {
    static constexpr bool PERM = true;
    unsigned char* Y;
    __device__ __forceinline__ void operator()(const f32x4 (&acc)[2][2][4][2], const Unit& u, int wr, int wc, int fr, int fq) const {
        constexpr float gs = Y8_SCALE / (W8_SCALE * H8_SCALE);
#pragma unroll
        for (int ai = 0; ai < 2; ++ai)
#pragma unroll
            for (int m = 0; m < 4; ++m) {
                const int rl = ai * 128 + wr * 64 + m * 16 + fr;
#pragma unroll
                for (int bj = 0; bj < 2; ++bj) {
                    const f32x4 a = acc[ai][bj][m][0] * gs, b = acc[ai][bj][m][1] * gs;
                    v2u w; w.x = pk4_fp8(a[0], a[1], a[2], a[3]); w.y = pk4_fp8(b[0], b[1], b[2], b[3]);
                    *(v2u*)(Y + (size_t)(u.pm * 256 + rl) * D + u.pn * 256 + bj * 128 + wc * 32 + 8 * fq) = w;
                }
                EPI_FENCE();
            }
    }
};

__device__ __forceinline__ int win_src_col(int n) {
    if (n < 1024) { int t = n & 63; const int hb = n & ~63; if (t < 16) t = (t & 1) ? 8 + (t >> 1) : (t >> 1); return hb + t; }
    if (n >= 1792 && n < 2048) { const int t = n - 1792, bj = t >> 7, wc = (t >> 5) & 3, j = t & 31; return 1792 + 64 * wc + 32 * bj + j; }
    return n;
}
__device__ __forceinline__ int cc_dim(int p, int kind) {
    if (kind == 1) { const int hh = p >> 5, j = p & 31; return (j < 16 ? 0 : 32) + 8 * ((j & 15) >> 2) + 4 * hh + (j & 3); }
    if (kind == 2) { const int db = p >> 5, hh = (p >> 4) & 1, g4 = (p >> 2) & 3, e = p & 3; return 32 * db + 8 * g4 + 4 * hh + e; }
    return p;
}
__device__ __forceinline__ void p0_tr_item(const float* cp, int ld, int K, bf16* WT, int k0, int n0, LAS float* scr, int lane, bool ntst = false, int kind = 0) {
    float v[32];
#pragma unroll
    for (int i = 0; i < 32; ++i) v[i] = __builtin_nontemporal_load(cp + (size_t)(k0 + cc_dim(2 * i + (lane >> 5), kind)) * ld);
#pragma unroll
    for (int i = 0; i < 32; ++i) scr[(2 * i + (lane >> 5)) * 33 + (lane & 31)] = v[i];
    LDS_WAIT(); asm volatile("" ::: "memory");
    const int c = lane & 7;
#pragma unroll
    for (int j = 0; j < 4; ++j) { const int n = (lane >> 3) + 8 * j; const LAS float* s = scr + (8 * c) * 33 + n;
        v4u o; o.x = pk2(s[0 * 33], s[1 * 33]); o.y = pk2(s[2 * 33], s[3 * 33]); o.z = pk2(s[4 * 33], s[5 * 33]); o.w = pk2(s[6 * 33], s[7 * 33]);
        if (ntst) __builtin_nontemporal_store(o, (v4u*)(WT + (size_t)(n0 + n) * K + k0 + 8 * c)); else *(v4u*)(WT + (size_t)(n0 + n) * K + k0 + 8 * c) = o; }
    LDS_WAIT(); asm volatile("" ::: "memory");
}
__device__ __forceinline__ void p0_gu_item(const float* cp, int ld, const float* gk, const float* bk, bf16* WT, int n0, int kh, float* c1p, float* c2p, LAS float* scr, int lane) {
    float c1 = 0.f, c2 = 0.f;
    for (int kb = kh * 8; kb < kh * 8 + 8; ++kb) {
        const int k0 = 64 * kb;
        float v[32];
#pragma unroll
        for (int i = 0; i < 32; ++i) v[i] = __builtin_nontemporal_load(cp + (size_t)(k0 + 2 * i + (lane >> 5)) * ld);
#pragma unroll
        for (int i = 0; i < 32; ++i) { const int kk = 2 * i + (lane >> 5); const float w = v[i];
            const float r = bflo(pk2(w * gk[k0 + kk], 0.f)); c1 += r; c2 += bk[k0 + kk] * w; scr[kk * 33 + (lane & 31)] = r; }
        LDS_WAIT(); asm volatile("" ::: "memory");
        const int c = lane & 7;
#pragma unroll
        for (int j = 0; j < 4; ++j) { const int n = (lane >> 3) + 8 * j; const LAS float* sp = scr + (8 * c) * 33 + n;
            v4u o; o.x = pk2(sp[0 * 33], sp[1 * 33]); o.y = pk2(sp[2 * 33], sp[3 * 33]); o.z = pk2(sp[4 * 33], sp[5 * 33]); o.w = pk2(sp[6 * 33], sp[7 * 33]);
            __builtin_nontemporal_store(o, (v4u*)(WT + (size_t)(n0 + n) * D + k0 + 8 * c)); }
        LDS_WAIT(); asm volatile("" ::: "memory");
    }
    c1 += __shfl_xor(c1, 32); c2 += __shfl_xor(c2, 32);
    if (lane < 32) { c1p[n0 + lane] = c1; c2p[n0 + lane] = c2; }
}
__device__ __forceinline__ void p0_out8(unsigned char* WT8, int K, int k0, int n0, const LAS float* scr, int lane) {
    const int c = lane & 3;
#pragma unroll
    for (int j = 0; j < 2; ++j) { const int n = (lane >> 2) + 16 * j; const LAS float* sp = scr + (16 * c) * 33 + n;
        v4u o; o.x = pk4_fp8(sp[0 * 33], sp[1 * 33], sp[2 * 33], sp[3 * 33]); o.y = pk4_fp8(sp[4 * 33], sp[5 * 33], sp[6 * 33], sp[7 * 33]);
        o.z = pk4_fp8(sp[8 * 33], sp[9 * 33], sp[10 * 33], sp[11 * 33]); o.w = pk4_fp8(sp[12 * 33], sp[13 * 33], sp[14 * 33], sp[15 * 33]);
        __builtin_nontemporal_store(o, (v4u*)(WT8 + (size_t)(n0 + n) * K + k0 + 16 * c)); }
}
__device__ __forceinline__ void p0_tr_item8(const float* cp, int ld, int K, unsigned char* WT8, int k0, int n0, LAS float* scr, int lane) {
    float v[32];
#pragma unroll
    for (int i = 0; i < 32; ++i) v[i] = __builtin_nontemporal_load(cp + (size_t)(k0 + 2 * i + (lane >> 5)) * ld);
#pragma unroll
    for (int i = 0; i < 32; ++i) scr[(2 * i + (lane >> 5)) * 33 + (lane & 31)] = v[i] * W8_SCALE;
    LDS_WAIT(); asm volatile("" ::: "memory");
    p0_out8(WT8, K, k0, n0, scr, lane);
    LDS_WAIT(); asm volatile("" ::: "memory");
}
__device__ __forceinline__ void p0_gu_item8(const float* cp, int ld, const float* gk, const float* bk, unsigned char* WT8, int n0, int kh, float* c1p, float* c2p, LAS float* scr, int lane) {
    float c1 = 0.f, c2 = 0.f;
    for (int kb = kh * 8; kb < kh * 8 + 8; ++kb) {
        const int k0 = 64 * kb;
        float v[32];
#pragma unroll
        for (int i = 0; i < 32; ++i) v[i] = __builtin_nontemporal_load(cp + (size_t)(k0 + 2 * i + (lane >> 5)) * ld);
#pragma unroll
        for (int i = 0; i < 32; ++i) { const int kk = 2 * i + (lane >> 5); const float w = v[i];
            const float r = fp8_rt(w * gk[k0 + kk] * W8_SCALE); c1 += r; c2 += bk[k0 + kk] * w; scr[kk * 33 + (lane & 31)] = r; }
        LDS_WAIT(); asm volatile("" ::: "memory");
        p0_out8(WT8, D, k0, n0, scr, lane);
        LDS_WAIT(); asm volatile("" ::: "memory");
    }
    c1 += __shfl_xor(c1, 32); c2 += __shfl_xor(c2, 32);
    if (lane < 32) { c1p[n0 + lane] = c1 * (1.0f / W8_SCALE); c2p[n0 + lane] = c2; }
}
struct Ptrs {
    const float *x, *w_in, *w_out, *lg, *lb, *wsp, *bsp, *pw, *psc, *ln1g, *ln1b, *rw, *rb, *wg, *wu, *wd, *ln2g, *ln2b;
    float* out; unsigned char* ws;
};
__device__ __forceinline__ void p0_weights(const Ptrs& P, int l, LAS unsigned char* lds, int wave, int lane, int widx, int nw) {
    LAS float* scr = (LAS float*)(lds + wave * 16384);
    bf16* WOUT = (bf16*)(P.ws + WS_WOUT); unsigned char* WGU = P.ws + WS_WGU; unsigned char* WDN = P.ws + WS_WDN;
    constexpr int I_IN = 16 * 72, I_OUT = 16 * 32, I_GU = 2 * 32, I_DN = 8 * 32, N_HEAVY = 16 * I_GU, N_LIGHT = I_IN + I_OUT + 16 * I_DN;
    const int nh = nw < N_HEAVY ? nw : N_HEAVY;
    if (widx < nh) {
        for (int r0 = widx; r0 < N_HEAVY; r0 += nh) { int r = r0; const int e = r / I_GU; r -= e * I_GU; const int le = l * 16 + e, kh = r / 32, nb = r % 32;
            const int n = 32 * nb + (lane & 31), pn = n >> 8, t = n & 255;
            const float* cp = (t < 128 ? P.wg : P.wu) + (size_t)le * D * FF + 128 * pn + (t & 127);
            p0_gu_item8(cp, FF, P.ln1g + l * D, P.ln1b + l * D, WGU + (size_t)le * 1024 * D, 32 * nb, kh,
                       (float*)(P.ws + WS_C1P) + ((size_t)kh * 32 + le) * 1024, (float*)(P.ws + WS_C2P) + ((size_t)kh * 32 + le) * 1024, scr, lane); }
    }
    const int lw0 = nw > N_HEAVY ? N_HEAVY : 0, nlw = nw - lw0;
    if (widx >= lw0) {
        for (int it = widx - lw0; it < N_LIGHT; it += nlw) {
            int r = it;
            if (r < I_IN) { const int kb = r / 72, nb = r % 72;
                const float* cp = P.w_in + (size_t)l * D * NCOL + win_src_col(32 * nb + (lane & 31));
                if (nb < 48) p0_tr_item8(cp, NCOL, D, P.ws + WS_WIN8 + (size_t)l * 1536 * D, 64 * kb, 32 * nb, scr, lane);
                else p0_tr_item(cp, NCOL, D, (bf16*)(P.ws + WS_WINB) + (size_t)l * 768 * D, 64 * kb, 32 * (nb - 48), scr, lane, l != 0);
                continue; }
            r -= I_IN;
            if (r < I_OUT) { const int kb = r / 32, nb = r % 32;
                const float* cp = P.w_out + (size_t)l * D * D + 32 * nb + (lane & 31);
                p0_tr_item(cp, D, D, WOUT + (size_t)l * D * D, 64 * kb, 32 * nb, scr, lane, true, (kb >= 8 && kb < 12) ? 2 : 1); continue; }
            r -= I_OUT;
            { const int e = r / I_DN; r -= e * I_DN; const int le = l * 16 + e, kb = r / 32, nb = r % 32;
                const float* cp = P.wd + (size_t)le * FF * D + 32 * nb + (lane & 31);
                p0_tr_item8(cp, D, FF, WDN + (size_t)le * D * FF, 64 * kb, 32 * nb, scr, lane); }
        }
    }
}
__device__ __forceinline__ void p0_prologue(const Ptrs& P, LAS unsigned char* lds, int vcu, int G, int wave, int lane, int tid) {
    const int gw = vcu * NWAVES + wave, NGW = G * NWAVES;
    for (int rep_ = 0; rep_ < ((MK_REPEAT == 31) ? 2 : 1); ++rep_) {
    p0_weights(P, 0, lds, wave, lane, gw, NGW);
    p0_weights(P, 1, lds, wave, lane, (gw + NGW / 2) % NGW, NGW);
    }
    bf16* XB = (bf16*)(P.ws + WS_HB);
    for (int rep_ = 0; rep_ < ((MK_REPEAT == 32) ? 2 : 1); ++rep_)
    for (size_t i0 = (size_t)gw * 64 + lane; i0 < (size_t)T * D / 8; i0 += (size_t)NGW * 64 * 8) {
        f32x4 a[8], b[8];
#pragma unroll
        for (int u = 0; u < 8; ++u) { const size_t i = i0 + (size_t)u * NGW * 64; a[u] = __builtin_nontemporal_load((const f32x4*)(P.x + i * 8)); b[u] = __builtin_nontemporal_load((const f32x4*)(P.x + i * 8 + 4)); }
#pragma unroll
        for (int u = 0; u < 8; ++u) { const size_t i = i0 + (size_t)u * NGW * 64;
            v4u w; w.x = pk2(a[u][0], a[u][1]); w.y = pk2(a[u][2], a[u][3]); w.z = pk2(b[u][0], b[u][1]); w.w = pk2(b[u][2], b[u][3]);
            *(v4u*)(XB + i * 8) = w;
            v2u w8; w8.x = pk4_fp8(a[u][0], a[u][1], a[u][2], a[u][3]); w8.y = pk4_fp8(b[u][0], b[u][1], b[u][2], b[u][3]); *(v2u*)(P.ws + WS_XB8 + i * 8) = w8; }
    }
    const int gt = vcu * NTHREADS + tid, NGT = G * NTHREADS;
    float* rope = (float*)(P.ws + WS_ROPE);
    for (int i = gt; i < S * 8; i += NGT) { const int pos = i >> 3, k = i & 7;
        const float inv = powf(500000.0f, -(float)k / 8.0f); const float ang = (float)pos * inv;
        rope[2 * i] = cosf(ang); rope[2 * i + 1] = sinf(ang); }
    bf16* WPT = (bf16*)(P.ws + WS_WPT);
    for (int i = gt; i < 2 * 4 * 64 * 64; i += NGT) { const int ii = i & 63, o = (i >> 6) & 63, lgi = i >> 12;
        WPT[i] = (bf16)(pk2(P.pw[((size_t)lgi * 64 + ii) * 64 + o], 0.f) & 0xffffu); }
    bf16* WST = (bf16*)(P.ws + WS_WST);
    for (int i = gt; i < 2 * 4 * 128 * 128; i += NGT) WST[i] = (bf16)(pk2(P.wsp[i], 0.f) & 0xffffu);
    v4u* RWB = (v4u*)(P.ws + WS_RWQ);
    for (int i = gt; i < 2 * 32 * 3 * 64; i += NGT) { const int ln = i & 63, rest = i >> 6, term = rest % 3, j = (rest / 3) & 31, l = rest / 96; const int e = ln & 15, q = ln >> 4;
        unsigned w[4];
#pragma unroll
        for (int p = 0; p < 4; ++p) { unsigned hb[2];
#pragma unroll
            for (int h = 0; h < 2; ++h) { const int k = 32 * j + 8 * q + 2 * p + h; const float v = P.ln1g[l * D + k] * P.rw[(size_t)k * 16 + e];
                const unsigned b0 = pk2(v, 0.f) & 0xffffu; const float r1 = v - bflo(b0); const unsigned b1 = pk2(r1, 0.f) & 0xffffu; const float r2 = r1 - bflo(b1); const unsigned b2 = pk2(r2, 0.f) & 0xffffu;
                hb[h] = term == 0 ? b0 : (term == 1 ? b1 : b2); }
            w[p] = hb[0] | (hb[1] << 16); }
        RWB[i] = (v4u){w[0], w[1], w[2], w[3]}; }
    float* CR = (float*)(P.ws + WS_CR);
    if (gw < 32) { const int l = gw >> 4, e = gw & 15; float a = 0.f, b = 0.f;
        for (int j = 0; j < 16; ++j) { const int k = lane + 64 * j; const float w = P.rw[(size_t)k * 16 + e]; a += P.ln1g[l * D + k] * w; b += P.ln1b[l * D + k] * w; }
        a = wave_sum(a); b = wave_sum(b);
        if (lane == 0) { CR[l * 32 + e] = a; CR[l * 32 + 16 + e] = b; } }
}

#ifdef MK_PROBE
#ifndef MK_PSCALE
#define MK_PSCALE 2e-6f
#endif
#define PROBE_DECL() unsigned long long pt_ = 0; unsigned pacc_ = 0
#define PROBE_T0(id) do { if (MK_PROBE == (id)) pt_ = __builtin_amdgcn_s_memrealtime(); } while (0)
#define PROBE_T1(id) do { if (MK_PROBE == (id)) pacc_ += (unsigned)(__builtin_amdgcn_s_memrealtime() - pt_); } while (0)
#define PROBE_END(ws, cond) do { if (cond) atomicAdd((unsigned*)((ws) + WS_CTL) + 32, pacc_); } while (0)
#else
#define PROBE_DECL() do {} while (0)
#define PROBE_T0(id) do {} while (0)
#define PROBE_T1(id) do {} while (0)
#define PROBE_END(ws, cond) do {} while (0)
#endif
constexpr int KT_STRIDE = 144, VT_STRIDE = 192;
constexpr int ATT_WAVE_LDS = 32 * KT_STRIDE + 32 * VT_STRIDE;
using pg8::v8i_t; using pg8::v4i_t;
constexpr float ASCL = LOG2E * 0.125f;
#define MFMA32(a, b, c) __builtin_amdgcn_mfma_f32_32x32x16_bf16((a), (b), (c), 0, 0, 0)
__device__ __forceinline__ s16x4 tr16(LAS unsigned char* p) { return __builtin_amdgcn_ds_read_tr16_b64_v4i16((LAS s16x4*)p); }

constexpr int VT_ROW = 128, KT_ROW = 64, KT_OFF = 0, VTL_OFF = 65536;
struct AttItem { int dsh, r, j0, rbase; };
__device__ __forceinline__ AttItem att_item(int it, int sp, int wave) {
    AttItem a;
    if (it < 4)      { a.dsh = 0; a.r = 0;      const int js = 1024 * sp + 256 * it; a.j0 = js + 32 * wave; a.rbase = 64 - js; }
    else if (it < 8) { a.dsh = 2; a.r = it - 4; const int js = 256 * sp;             a.j0 = js + 32 * wave; a.rbase = 64 - js; }
    else             { a.dsh = 4; a.r = 4 * (it - 8) + (wave >> 1); a.j0 = 64 * sp + 32 * (wave & 1); a.rbase = 128 * (wave >> 1); }
    return a;
}
template <int RB>
__device__ __forceinline__ const unsigned char* att_src(const unsigned char* Xb, int it, int sp, size_t brow, int h, int rho, int ch) {
    if (it < 8) {
        const int dsh = it < 4 ? 0 : 2, r = it < 4 ? 0 : it - 4, js = it < 4 ? 1024 * sp + 256 * it : 256 * sp;
        int j = js - 64 + rho; j = j < 0 ? 0 : j; const int L = S >> dsh; j = j >= L ? L - 1 : j;
        return Xb + (brow + ((size_t)j << dsh) + r) * RB + h * (RB / 8) + ch * 16;
    }
    const int sl = (rho >> 7) & 3, j = rho & 127, r = 4 * (it - 8) + sl;
    return Xb + (brow + (size_t)j * 16 + r) * RB + h * (RB / 8) + ch * 16;
}
template <bool KSW>
__device__ __forceinline__ void att_fill(const unsigned char* Xb, int it, int sp, size_t brow, int h, LAS unsigned char* tile, int wave, int lane) {
    const int n = KSW ? (it < 8 ? 3 : 4) : (it < 8 ? 6 : 8);
    for (int k = 0; k < n; ++k) {
        const int ins = wave + 8 * k;
        const int rho = KSW ? 16 * ins + (lane >> 2) : 8 * ins + (lane >> 3);
        const int ch = KSW ? ((lane & 3) ^ ((rho >> 2) & 3)) : ((lane & 7) ^ (((rho >> 1) & 1) << 2));
        const unsigned char* src = KSW ? att_src<512>(Xb, it, sp, brow, h, rho, ch) : att_src<1024>(Xb, it, sp, brow, h, rho, ch);
        { unsigned keep_; const unsigned dst_ = (unsigned)(size_t)(tile + ins * 1024);
          asm volatile("s_mov_b32 %0, m0\n\ts_mov_b32 m0, %2\n\ts_nop 0\n\tglobal_load_lds_dwordx4 %1, off\n\ts_mov_b32 m0, %0" : "=&s"(keep_) : "v"(src), "s"(__builtin_amdgcn_readfirstlane(dst_)) : "memory"); }
    }
}
__device__ __forceinline__ void attn_scores(const v8i_t& qf, const AttItem& a, const LAS unsigned char* kt, int lane, f32x16 (&st)[5], int& kb_lo, int& kb_hi) {
    const int L = S >> a.dsh;
    const int qi = lane & 31, hh = lane >> 5;
    kb_lo = 2 - (a.j0 >> 5); if (kb_lo < 0) kb_lo = 0;
    kb_hi = ((L - a.j0) >> 5) + 1; if (kb_hi > 4) kb_hi = 4;
    const int row0 = a.rbase + a.j0 - 64 + qi;
    const int sw = (qi >> 2) & 3;
    f32x16 zero;
#pragma unroll
    for (int i = 0; i < 16; ++i) zero[i] = 0.f;
#pragma unroll
    for (int kb = 0; kb < 5; ++kb) {
        const int kbc = kb < kb_lo ? kb_lo : (kb > kb_hi ? kb_hi : kb);
        const LAS unsigned char* kr = kt + (row0 + 32 * kbc) * KT_ROW;
        const v4i_t k0 = *(const LAS v4i_t*)(kr + (((2 * hh) ^ sw) << 4)), k1 = *(const LAS v4i_t*)(kr + (((2 * hh + 1) ^ sw) << 4));
        const v8i_t kf = __builtin_shufflevector(k0, k1, 0, 1, 2, 3, 4, 5, 6, 7);
        st[kb] = __builtin_amdgcn_mfma_scale_f32_32x32x64_f8f6f4(kf, qf, zero, 0, 0, 0, 0x7f7f7f7f, 0, 0x7f7f7f7f);
    }
}
struct AttPart { v4u a[2], b[2]; float la, lb; };
constexpr float PO8_SCALE = 16.0f;
__device__ __forceinline__ float f8at(unsigned w, int e) { return e == 0 ? __builtin_amdgcn_cvt_f32_fp8((int)w, 0) : e == 1 ? __builtin_amdgcn_cvt_f32_fp8((int)w, 1) : e == 2 ? __builtin_amdgcn_cvt_f32_fp8((int)w, 2) : __builtin_amdgcn_cvt_f32_fp8((int)w, 3); }
__device__ __forceinline__ void attn_softmax_pv(f32x16 (&st)[5], const AttItem& a, int kb_lo, int kb_hi, const LAS unsigned char* vt, int lane,
                                                f32x16& o0, f32x16& o1, float& l_out, float& mxs_out) {
    const int qi = lane & 31, hh = lane >> 5;
    float mx = -1e30f;
#pragma unroll
    for (int kb = 0; kb < 5; ++kb) {
        const bool valid = kb >= kb_lo && kb <= kb_hi;
#pragma unroll
        for (int i = 0; i < 16; ++i) { float sv = st[kb][i]; const int kl = crow(i, hh);
            if (kb == 0 && kl < qi) sv = -1e30f;
            if (kb == 4 && kl > qi) sv = -1e30f;
            sv = valid ? sv : -1e30f;
            st[kb][i] = sv; mx = fmaxf(mx, sv); }
    }
    mx = fmaxf(mx, __shfl_xor(mx, 32));
    const float mxs = mx * ASCL;
    float l = 0.f;
    bf16x8 pf[5][2];
#pragma unroll
    for (int kb = 0; kb < 5; ++kb) {
#pragma unroll
        for (int i = 0; i < 16; ++i) { const float pe = fast_exp2(st[kb][i] * ASCL - mxs); l += pe; st[kb][i] = pe; }
#pragma unroll
        for (int sx = 0; sx < 2; ++sx) { v4u w; w.x = pk2(st[kb][8 * sx], st[kb][8 * sx + 1]); w.y = pk2(st[kb][8 * sx + 2], st[kb][8 * sx + 3]); w.z = pk2(st[kb][8 * sx + 4], st[kb][8 * sx + 5]); w.w = pk2(st[kb][8 * sx + 6], st[kb][8 * sx + 7]);
            pf[kb][sx] = __builtin_bit_cast(bf16x8, w); }
    }
#pragma unroll
    for (int i = 0; i < 16; ++i) { o0[i] = 0.f; o1[i] = 0.f; }
    const int q4 = (lane & 15) >> 2, p4 = lane & 3, blk = (lane >> 4) & 1, sw = (q4 >> 1) & 1;
    const LAS unsigned char* vrow = vt + (a.rbase + a.j0 - 64 + 4 * hh + q4) * VT_ROW + 32 * blk + 8 * p4;
    const int c0 = sw ? 64 : 0, c1 = sw ? 0 : 64;
#pragma unroll
    for (int kb = 0; kb < 5; ++kb) {
        const int kbc = kb < kb_lo ? kb_lo : (kb > kb_hi ? kb_hi : kb);
        LAS unsigned char* vr = (LAS unsigned char*)vrow + (32 * kbc) * VT_ROW;
#pragma unroll
        for (int sx = 0; sx < 2; ++sx) {
            { const s16x4 lo = tr16(vr + (16 * sx) * VT_ROW + c0), hi = tr16(vr + (16 * sx + 8) * VT_ROW + c0);
              const bf16x8 vf = __builtin_shufflevector(lo, hi, 0, 1, 2, 3, 4, 5, 6, 7); o0 = MFMA32(vf, pf[kb][sx], o0); }
            { const s16x4 lo = tr16(vr + (16 * sx) * VT_ROW + c1), hi = tr16(vr + (16 * sx + 8) * VT_ROW + c1);
              const bf16x8 vf = __builtin_shufflevector(lo, hi, 0, 1, 2, 3, 4, 5, 6, 7); o1 = MFMA32(vf, pf[kb][sx], o1); }
        }
    }
    l += __shfl_xor(l, 32);
    l_out = l; mxs_out = mxs;
}
__device__ __forceinline__ void attn_store(unsigned char* __restrict__ POc, float* __restrict__ LSEc, const f32x16& o0, const f32x16& o1, float l, float mxs, int b, int h, const AttItem& a, int lane) {
    const int qi = lane & 31, hh = lane >> 5;
    const size_t qrow = (size_t)b * S + ((size_t)(a.j0 + qi) << a.dsh) + a.r;
    const float inv = PO8_SCALE / l;
    unsigned char* op = POc + qrow * 512 + h * 64 + 32 * hh;
    v4u w0, w1;
    w0.x = pk4_fp8(o0[0] * inv, o0[1] * inv, o0[2] * inv, o0[3] * inv);     w0.y = pk4_fp8(o0[4] * inv, o0[5] * inv, o0[6] * inv, o0[7] * inv);
    w0.z = pk4_fp8(o0[8] * inv, o0[9] * inv, o0[10] * inv, o0[11] * inv);   w0.w = pk4_fp8(o0[12] * inv, o0[13] * inv, o0[14] * inv, o0[15] * inv);
    w1.x = pk4_fp8(o1[0] * inv, o1[1] * inv, o1[2] * inv, o1[3] * inv);     w1.y = pk4_fp8(o1[4] * inv, o1[5] * inv, o1[6] * inv, o1[7] * inv);
    w1.z = pk4_fp8(o1[8] * inv, o1[9] * inv, o1[10] * inv, o1[11] * inv);   w1.w = pk4_fp8(o1[12] * inv, o1[13] * inv, o1[14] * inv, o1[15] * inv);
    *(v4u*)op = w0; *(v4u*)(op + 16) = w1;
    if (hh == 0) LSEc[qrow * 8 + h] = mxs + __log2f(l);
}

__device__ __forceinline__ void attn_load_part(AttPart& part, const unsigned char* __restrict__ PO, const float* __restrict__ LSE, int b, int h, const AttItem& a, int lane) {
    const int qi = lane & 31, hh = lane >> 5;
    const size_t qrow = (size_t)b * S + ((size_t)(a.j0 + qi) << a.dsh) + a.r;
    const unsigned char* po0 = PO + qrow * 512 + h * 64 + 32 * hh; const unsigned char* po1 = po0 + (size_t)T * 512;
    const float* l0 = LSE + qrow * 8 + h; const float* l1 = l0 + (size_t)T * 8;
    asm volatile("global_load_dwordx4 %0, %1, off" : "=v"(part.a[0]) : "v"(po0) : "memory");
    asm volatile("global_load_dwordx4 %0, %1, off offset:16" : "=v"(part.a[1]) : "v"(po0) : "memory");
    asm volatile("global_load_dwordx4 %0, %1, off" : "=v"(part.b[0]) : "v"(po1) : "memory");
    asm volatile("global_load_dwordx4 %0, %1, off offset:16" : "=v"(part.b[1]) : "v"(po1) : "memory");
    asm volatile("global_load_dword %0, %1, off" : "=v"(part.la) : "v"(l0) : "memory");
    asm volatile("global_load_dword %0, %1, off" : "=v"(part.lb) : "v"(l1) : "memory");
}
__device__ __forceinline__ void attn_store_fused(bf16* __restrict__ CC, const AttPart& part, const f32x16& o0, const f32x16& o1, float l, float mxs, int b, int h, const AttItem& a, int lane) {
    const int qi = lane & 31, hh = lane >> 5;
    const size_t qrow = (size_t)b * S + ((size_t)(a.j0 + qi) << a.dsh) + a.r;
    const float l2 = mxs + __log2f(l);
    const float mx = fmaxf(part.la, fmaxf(part.lb, l2));
    float w0 = fast_exp2(part.la - mx), w1 = fast_exp2(part.lb - mx), w2 = fast_exp2(l2 - mx);
    const float inv = 1.0f / (w0 + w1 + w2); w0 *= inv * (1.0f / PO8_SCALE); w1 *= inv * (1.0f / PO8_SCALE); w2 *= inv / l;
    bf16* op = CC + qrow * D + h * 64 + 32 * hh;
#pragma unroll
    for (int g2 = 0; g2 < 2; ++g2) {
        v4u wlo, whi;
#pragma unroll
        for (int s2 = 0; s2 < 2; ++s2) { const int g4 = 2 * g2 + s2;
            { const unsigned pa = part.a[0][g4], pb = part.b[0][g4];
              const unsigned x = pk2(w0 * f8at(pa, 0) + w1 * f8at(pb, 0) + w2 * o0[4 * g4], w0 * f8at(pa, 1) + w1 * f8at(pb, 1) + w2 * o0[4 * g4 + 1]);
              const unsigned y = pk2(w0 * f8at(pa, 2) + w1 * f8at(pb, 2) + w2 * o0[4 * g4 + 2], w0 * f8at(pa, 3) + w1 * f8at(pb, 3) + w2 * o0[4 * g4 + 3]);
              if (s2 == 0) { wlo.x = x; wlo.y = y; } else { wlo.z = x; wlo.w = y; } }
            { const unsigned pa = part.a[1][g4], pb = part.b[1][g4];
              const unsigned x = pk2(w0 * f8at(pa, 0) + w1 * f8at(pb, 0) + w2 * o1[4 * g4], w0 * f8at(pa, 1) + w1 * f8at(pb, 1) + w2 * o1[4 * g4 + 1]);
              const unsigned y = pk2(w0 * f8at(pa, 2) + w1 * f8at(pb, 2) + w2 * o1[4 * g4 + 2], w0 * f8at(pa, 3) + w1 * f8at(pb, 3) + w2 * o1[4 * g4 + 3]);
              if (s2 == 0) { whi.x = x; whi.y = y; } else { whi.z = x; whi.w = y; } }
        }
        *(v4u*)(op + 8 * g2) = wlo; *(v4u*)(op + 16 + 8 * g2) = whi;
    }
}

__device__ __forceinline__ void p2_attention(const unsigned char* ws, unsigned char* wsw, LAS unsigned char* lds, int vcu, int G, int wave, int lane_in, int tid) {
    const unsigned char* Qb = ws + WS_Q; const unsigned char* Kb = ws + WS_K; const unsigned char* Vb = ws + WS_V;
    unsigned char* PO = wsw + WS_PO; float* LSE = (float*)(wsw + WS_LSE); bf16* CC = (bf16*)(wsw + WS_CC);
    LAS unsigned char* ktile = lds + KT_OFF; LAS unsigned char* vtile = lds + VTL_OFF;
    PROBE_DECL(); PROBE_T0(1);
    for (int item = vcu; item < NB * 8 * 2; item += G) {
        const int sp = item & 1, h = (item >> 1) & 7, b = item >> 4;
        const size_t brow = (size_t)b * S;
        v4i_t qn[2];
#pragma unroll 1
        for (int it = -1; it < 12; ++it) {
            int lane = lane_in; asm volatile("" : "+v"(lane));
            const int qi = lane & 31, hh = lane >> 5;
            f32x16 st[5]; int kb_lo = 0, kb_hi = 4; AttPart part;
            AttItem a = att_item(it < 0 ? 0 : it, sp, wave);
            const int c = it >> 2;
            if (it >= 0) {
                PROBE_T0(2);
                if (it < 8) asm volatile("s_waitcnt vmcnt(6)" ::: "memory"); else asm volatile("s_waitcnt vmcnt(8)" ::: "memory");
                PROBE_T1(2); PROBE_T0(6);
                __builtin_amdgcn_s_barrier(); asm volatile("" ::: "memory");
                PROBE_T1(6);
                asm volatile("" : "+v"(qn[0]), "+v"(qn[1]));
                const v8i_t qf = __builtin_shufflevector(qn[0], qn[1], 0, 1, 2, 3, 4, 5, 6, 7);
                if (c == 2) attn_load_part(part, PO, LSE, b, h, a, lane);
                PROBE_T0(3);
                attn_scores(qf, a, ktile, lane, st, kb_lo, kb_hi);
                if (c == 2) asm volatile("s_waitcnt vmcnt(6) lgkmcnt(0)" ::: "memory"); else asm volatile("s_waitcnt vmcnt(0) lgkmcnt(0)" ::: "memory");
                __builtin_amdgcn_s_barrier(); asm volatile("" ::: "memory");
            }
            if (it < 11) {
                att_fill<true>(Kb, it + 1, sp, brow, h, ktile, wave, lane);
                const AttItem an = att_item(it + 1, sp, wave); const unsigned char* qp = Qb + (brow + ((size_t)(an.j0 + qi) << an.dsh) + an.r) * 512 + h * 64 + 32 * hh;
#pragma unroll
                for (int ks = 0; ks < 2; ++ks) asm volatile("global_load_dwordx4 %0, %1, off" : "=v"(qn[ks]) : "v"(qp + 16 * ks) : "memory");
            }
            if (it >= 0) {
                f32x16 o0, o1; float lsum, mxs;
                attn_softmax_pv(st, a, kb_lo, kb_hi, vtile, lane, o0, o1, lsum, mxs);
                PROBE_T1(3); PROBE_T0(4);
                asm volatile("s_waitcnt lgkmcnt(0)" ::: "memory");
                __builtin_amdgcn_s_barrier(); asm volatile("" ::: "memory");
                if (c == 2) {
                    if (it == 11) asm volatile("s_waitcnt vmcnt(0)" ::: "memory"); else asm volatile("s_waitcnt vmcnt(6)" ::: "memory");
                    asm volatile("" : "+v"(part.a[0]), "+v"(part.a[1]), "+v"(part.b[0]), "+v"(part.b[1]), "+v"(part.la), "+v"(part.lb));
                    attn_store_fused(CC, part, o0, o1, lsum, mxs, b, h, a, lane); }
                else attn_store(PO + (size_t)c * T * 512, LSE + (size_t)c * T * 8, o0, o1, lsum, mxs, b, h, a, lane);
                asm volatile("" ::: "memory");
            }
            if (it < 11) att_fill<false>(Vb, it + 1, sp, brow, h, vtile, wave, lane);
            PROBE_T1(4);
        }
        PROBE_T0(5);
        asm volatile("s_waitcnt vmcnt(0)" ::: "memory");
        __syncthreads();
        PROBE_T1(5);
    }
    PROBE_T1(1);
    PROBE_END(ws, vcu == 0 && tid == 0);
}
__device__ __forceinline__ void p2_gmlp(const Ptrs& P, int l, LAS unsigned char* lds, int vcu, int G, int wave, int lane, int tid) {
    const bf16* Gb = (const bf16*)(P.ws + WS_G); const bf16* Ub = (const bf16*)(P.ws + WS_U); bf16* CC = (bf16*)(P.ws + WS_CC);
    const bf16* WST = (const bf16*)(P.ws + WS_WST) + (size_t)l * 4 * 128 * 128;
    const float* bs = P.bsp + l * 4 * 128;
    const int hh = lane >> 5, q4 = (lane & 15) >> 2, p4 = lane & 3, blk = (lane >> 4) & 1;
    const int pb = wave & 3, db = wave >> 2;
    const int p = 32 * pb + (lane & 31);
    constexpr int GT_BYTES = 128 * VT_STRIDE;
    v4u treg[2]; v2u uun[4];
    if (vcu < NB * 16 * 4) { const int g = vcu & 3, cch = (vcu >> 2) & 15, b = vcu >> 6; const size_t row0 = (size_t)b * S + cch * 128;
#pragma unroll
        for (int i = 0; i < 2; ++i) { const int idx = tid + NTHREADS * i; treg[i] = *(const v4u*)(Gb + (row0 + (idx >> 3)) * 256 + g * 64 + (idx & 7) * 8); }
#pragma unroll
        for (int g4 = 0; g4 < 4; ++g4) uun[g4] = *(const v2u*)(Ub + (row0 + p) * 256 + g * 64 + 32 * db + 8 * g4 + 4 * hh); }
    bf16x8 wf[8]; float bsv = 0.f; int gcur = -1, par = 0;
    for (int item = vcu; item < NB * 16 * 4; item += G, par ^= 1) {
        const int g = item & 3, cch = (item >> 2) & 15, b = item >> 6;
        const size_t row0 = (size_t)b * S + cch * 128;
        LAS unsigned char* tl = lds + par * GT_BYTES;
#pragma unroll
        for (int i = 0; i < 2; ++i) { const int idx = tid + NTHREADS * i; *(LAS v4u*)(tl + (idx >> 3) * VT_STRIDE + (idx & 7) * 16) = treg[i]; }
        v2u uu[4];
#pragma unroll
        for (int g4 = 0; g4 < 4; ++g4) uu[g4] = uun[g4];
        __syncthreads();
        if (g != gcur) { gcur = g;
            const bf16* wp = WST + ((size_t)g * 128 + p) * 128 + 8 * hh;
#pragma unroll
            for (int s8 = 0; s8 < 8; ++s8) wf[s8] = *(const bf16x8*)(wp + 16 * s8);
            bsv = bs[g * 128 + p]; }
        if (item + G < NB * 16 * 4) { const int it2 = item + G, g2 = it2 & 3, c2 = (it2 >> 2) & 15, b2 = it2 >> 6; const size_t rown = (size_t)b2 * S + c2 * 128;
#pragma unroll
            for (int i = 0; i < 2; ++i) { const int idx = tid + NTHREADS * i; treg[i] = *(const v4u*)(Gb + (rown + (idx >> 3)) * 256 + g2 * 64 + (idx & 7) * 8); }
#pragma unroll
            for (int g4 = 0; g4 < 4; ++g4) uun[g4] = *(const v2u*)(Ub + (rown + p) * 256 + g2 * 64 + 32 * db + 8 * g4 + 4 * hh); }
        f32x16 acc;
#pragma unroll
        for (int i = 0; i < 16; ++i) acc[i] = 0.f;
        LAS unsigned char* vrd = tl + (8 * hh + q4) * VT_STRIDE + (32 * db + 16 * blk + 4 * p4) * 2;
#pragma unroll
        for (int s8 = 0; s8 < 8; ++s8) {
            const s16x4 lo = tr16(vrd + (16 * s8) * VT_STRIDE), hi = tr16(vrd + (16 * s8 + 4) * VT_STRIDE);
            const bf16x8 vf = __builtin_shufflevector(lo, hi, 0, 1, 2, 3, 4, 5, 6, 7);
            acc = MFMA32(vf, wf[s8], acc);
        }
        { unsigned w[8];
#pragma unroll
          for (int g4 = 0; g4 < 4; ++g4) { w[2 * g4] = pk2(bflo(uu[g4].x) * (acc[4 * g4] + bsv), bfhi(uu[g4].x) * (acc[4 * g4 + 1] + bsv)); w[2 * g4 + 1] = pk2(bflo(uu[g4].y) * (acc[4 * g4 + 2] + bsv), bfhi(uu[g4].y) * (acc[4 * g4 + 3] + bsv)); }
          bf16* op = CC + (row0 + p) * D + 512 + g * 64 + 32 * db + 16 * hh;
          *(v4u*)op = (v4u){w[0], w[1], w[2], w[3]}; *(v4u*)(op + 8) = (v4u){w[4], w[5], w[6], w[7]}; }
    }
    __syncthreads();
}
constexpr int PL_ROWB = 144, PL_WAVE_LDS = 48 * PL_ROWB;
template <int W>
__device__ __forceinline__ void pool_task(const bf16* __restrict__ Zb, bf16* __restrict__ CC, const bf16* __restrict__ WPT, const float* __restrict__ psc, int b, int g, int tile, int lane, LAS unsigned char* wl) {
    const int hh = lane >> 5, pl = lane & 31;
    const int pos = 32 * tile + pl;
    constexpr int left = W / 2, right = W - 1 - left, NR = 32 + W - 1;
    int lo = pos - left; if (lo < 0) lo = 0;
    int hi = pos + right + 1; if (hi > S) hi = S;
    const float inv = 1.0f / (float)(hi - lo);
    const bf16* zb = Zb + (size_t)b * S * 256 + g * 64;
    { constexpr int NL = (NR * 8 + 63) / 64;
      v4u zr[NL];
#pragma unroll
      for (int k = 0; k < NL; ++k) { const int idx = lane + 64 * k, r = idx >> 3, c = idx & 7; int q = 32 * tile - left + r; q = q < 0 ? 0 : (q >= S ? S - 1 : q);
          zr[k] = *(const v4u*)(zb + (size_t)q * 256 + 8 * c); }
#pragma unroll
      for (int k = 0; k < NL; ++k) { const int idx = lane + 64 * k, r = idx >> 3, c = idx & 7; if (NR * 8 % 64 == 0 || idx < NR * 8) *(LAS v4u*)(wl + r * PL_ROWB + 16 * c) = zr[k]; }
      asm volatile("s_waitcnt lgkmcnt(0)" ::: "memory"); }
    bf16x8 bfr[4];
#pragma unroll
    for (int ks = 0; ks < 4; ++ks) {
        float sm[8];
#pragma unroll
        for (int e = 0; e < 8; ++e) sm[e] = 0.f;
        v4u zc;
#pragma unroll
        for (int t = 0; t < W; ++t) { const int q = pos - left + t; const float f = (q >= 0 && q < S) ? 1.0f : 0.0f; const v4u z = *(const LAS v4u*)(wl + (pl + t) * PL_ROWB + 32 * ks + 16 * hh);
            if (t == left) zc = z;
            sm[0] += f * bflo(z.x); sm[1] += f * bfhi(z.x); sm[2] += f * bflo(z.y); sm[3] += f * bfhi(z.y); sm[4] += f * bflo(z.z); sm[5] += f * bfhi(z.z); sm[6] += f * bflo(z.w); sm[7] += f * bfhi(z.w); }
        const v4u z = zc;
        v4u o; o.x = pk2(sm[0] * inv - bflo(z.x), sm[1] * inv - bfhi(z.x)); o.y = pk2(sm[2] * inv - bflo(z.y), sm[3] * inv - bfhi(z.y));
        o.z = pk2(sm[4] * inv - bflo(z.z), sm[5] * inv - bfhi(z.z)); o.w = pk2(sm[6] * inv - bflo(z.w), sm[7] * inv - bfhi(z.w));
        bfr[ks] = __builtin_bit_cast(bf16x8, o);
    }
    asm volatile("s_waitcnt lgkmcnt(0)" ::: "memory");
#pragma unroll
    for (int ob = 0; ob < 2; ++ob) {
        f32x16 acc;
#pragma unroll
        for (int i = 0; i < 16; ++i) acc[i] = 0.f;
#pragma unroll
        for (int ks = 0; ks < 4; ++ks) { const bf16x8 af = *(const bf16x8*)(WPT + ((size_t)g * 64 + 32 * ob + pl) * 64 + 16 * ks + 8 * hh); acc = MFMA32(af, bfr[ks], acc); }
        unsigned w[8];
#pragma unroll
        for (int g4 = 0; g4 < 4; ++g4) {
            const int o0 = 32 * ob + 8 * g4 + 4 * hh;
            const f32x4 sc = *(const f32x4*)(psc + g * 64 + o0);
            w[2 * g4] = pk2(acc[4 * g4] * sc[0], acc[4 * g4 + 1] * sc[1]); w[2 * g4 + 1] = pk2(acc[4 * g4 + 2] * sc[2], acc[4 * g4 + 3] * sc[3]);
        }
        bf16* op = CC + ((size_t)b * S + pos) * D + 768 + g * 64 + 32 * hh + 16 * ob;
        *(v4u*)op = (v4u){w[0], w[1], w[2], w[3]}; *(v4u*)(op + 8) = (v4u){w[4], w[5], w[6], w[7]};
    }
}
__device__ __forceinline__ void p2_pool(const Ptrs& P, int l, LAS unsigned char* lds, int vcu, int G, int wave, int lane) {
    LAS unsigned char* wl = lds + 65536 + wave * PL_WAVE_LDS;
    const bf16* Zb = (const bf16*)(P.ws + WS_Z); bf16* CC = (bf16*)(P.ws + WS_CC);
    const bf16* WPT = (const bf16*)(P.ws + WS_WPT) + (size_t)l * 4 * 64 * 64;
    const float* psc = P.psc + l * 256;
    const int gw = vcu * NWAVES + wave, NGW = G * NWAVES;
    for (int task = gw; task < NB * 4 * 64; task += NGW) {
        const int gr = task & 3, idx = (task >> 2), tile = idx & 63, b = idx >> 6, g = ((task >> 11) & 1) ? 3 - gr : gr;
        if (g == 0) pool_task<2>(Zb, CC, WPT, psc, b, g, tile, lane, wl);
        else if (g == 1) pool_task<4>(Zb, CC, WPT, psc, b, g, tile, lane, wl);
        else if (g == 2) pool_task<8>(Zb, CC, WPT, psc, b, g, tile, lane, wl);
        else pool_task<16>(Zb, CC, WPT, psc, b, g, tile, lane, wl);
    }
}

__device__ __forceinline__ void route16(const float* logit, const float* __restrict__ rbias, int& e0, int& e1, float& g0, float& g1) {
    float sc[16], bi[16];
#pragma unroll
    for (int e = 0; e < 16; ++e) { sc[e] = 1.0f / (1.0f + expf(-logit[e])); bi[e] = sc[e] + rbias[e]; }
    int gsel = 0; float best = -1e30f;
#pragma unroll
    for (int g = 0; g < 4; ++g) {
        float m1 = -1e30f, m2 = -1e30f;
#pragma unroll
        for (int j = 0; j < 4; ++j) { const float v = bi[g * 4 + j]; if (v > m1) { m2 = m1; m1 = v; } else if (v > m2) m2 = v; }
        const float gs = m1 + m2;
        if (gs > best) { best = gs; gsel = g; }
    }
    float bg[4], sg[4];
#pragma unroll
    for (int j = 0; j < 4; ++j) { bg[j] = bi[j]; sg[j] = sc[j];
#pragma unroll
        for (int g = 1; g < 4; ++g) { bg[j] = (g == gsel) ? bi[g * 4 + j] : bg[j]; sg[j] = (g == gsel) ? sc[g * 4 + j] : sg[j]; } }
    int i1 = 0; float m1 = bg[0], s1 = sg[0];
#pragma unroll
    for (int j = 1; j < 4; ++j) if (bg[j] > m1) { m1 = bg[j]; i1 = j; s1 = sg[j]; }
    int i2 = -1; float m2 = -1e30f, s2 = 0.f;
#pragma unroll
    for (int j = 0; j < 4; ++j) if (j != i1 && bg[j] > m2) { m2 = bg[j]; i2 = j; s2 = sg[j]; }
    e0 = gsel * 4 + i1; e1 = gsel * 4 + i2;
    g0 = s1 / (s1 + s2); g1 = s2 / (s1 + s2);
}
__device__ __forceinline__ void p4_stats_router(const Ptrs& P, int l, LAS unsigned char* lds, int vcu, int G, int wave, int lane, int tid) {
    const bf16* Y1B = (const bf16*)(P.ws + WS_Y1B); float* STATS = (float*)(P.ws + WS_STATS);
    int* TOKE = (int*)(P.ws + WS_TOKE); float* TOKG = (float*)(P.ws + WS_TOKG); int* TOKP = (int*)(P.ws + WS_TOKP);
    int* TLIST = (int*)(P.ws + WS_TLIST); float* GLIST = (float*)(P.ws + WS_GLIST);
    unsigned* cnt = (unsigned*)(P.ws + WS_CTL) + CW_CNT + 16 * l;
    const v4u* RWB = (const v4u*)(P.ws + WS_RWQ) + (size_t)l * 6144; const float* CR = (const float*)(P.ws + WS_CR) + l * 32;
    LAS unsigned char* rwb = lds;
    LAS float* dots = (LAS float*)(lds + 98304) + wave * 256;
    LAS int* s_cnt = (LAS int*)(lds + 98304 + 8192); LAS int* s_base = s_cnt + 16; LAS int* s_e = s_cnt + 32; LAS int* s_pos = s_e + 256; LAS float* s_g = (LAS float*)(s_pos + 256);
    const int row_l = lane & 15, q = lane >> 4;
    bool filled = false;
    for (int blk_row = vcu * 128; blk_row < T; blk_row += G * 128) {
        const int row = blk_row + wave * 16 + row_l;
        const bf16* yp = Y1B + (size_t)row * D + 8 * q;
        v4u yv[16];
#pragma unroll
        for (int jj = 0; jj < 16; ++jj) yv[jj] = *(const v4u*)(yp + 32 * jj);
        if (!filled) { filled = true;
            for (int i = tid; i < 6144; i += NTHREADS) ((LAS v4u*)rwb)[i] = RWB[i];
            if (tid < 16) s_cnt[tid] = 0;
            __syncthreads(); }
        f32x4 acc = {0.f, 0.f, 0.f, 0.f}; float s1 = 0.f, s2 = 0.f;
#pragma unroll 1
        for (int jc = 0; jc < 2; ++jc) {
            if (jc == 1) {
#pragma unroll
                for (int jj = 0; jj < 16; ++jj) yv[jj] = *(const v4u*)(yp + 32 * (16 + jj));
            }
#pragma unroll
            for (int jj = 0; jj < 16; ++jj) {
                const int jp = 16 * jc + jj;
                const float y0 = bflo(yv[jj].x), y1 = bfhi(yv[jj].x), y2 = bflo(yv[jj].y), y3 = bfhi(yv[jj].y), y4 = bflo(yv[jj].z), y5 = bfhi(yv[jj].z), y6 = bflo(yv[jj].w), y7 = bfhi(yv[jj].w);
                const bf16x8 af = __builtin_bit_cast(bf16x8, yv[jj]);
#pragma unroll
                for (int term = 0; term < 3; ++term) { const bf16x8 bfr = *(const LAS bf16x8*)(rwb + ((jp * 3 + term) * 64 + lane) * 16); acc = __builtin_amdgcn_mfma_f32_16x16x32_bf16(af, bfr, acc, 0, 0, 0); }
                s1 += ((y0 + y1) + (y2 + y3)) + ((y4 + y5) + (y6 + y7));
                s2 += ((y0 * y0 + y1 * y1) + (y2 * y2 + y3 * y3)) + ((y4 * y4 + y5 * y5) + (y6 * y6 + y7 * y7));
            }
        }
        s1 += __shfl_xor(s1, 16); s1 += __shfl_xor(s1, 32); s2 += __shfl_xor(s2, 16); s2 += __shfl_xor(s2, 32);
#pragma unroll
        for (int i = 0; i < 4; ++i) dots[(4 * q + i) * 16 + row_l] = acc[i];
        LDS_WAIT();
        if (lane < 16) {
            const int grow = blk_row + wave * 16 + lane;
            const float mu = s1 * (1.0f / D), var = s2 * (1.0f / D) - mu * mu, rstd = rsqrtf(var + LN_EPS);
            *(f32x2*)(STATS + 2 * (size_t)grow) = (f32x2){mu, rstd};
            float lg[16];
#pragma unroll
            for (int e4 = 0; e4 < 4; ++e4) { const f32x4 d = *(const LAS f32x4*)(dots + lane * 16 + 4 * e4);
#pragma unroll
                for (int e = 0; e < 4; ++e) lg[4 * e4 + e] = rstd * (d[e] - mu * CR[4 * e4 + e]) + CR[16 + 4 * e4 + e]; }
            int e0, e1; float g0, g1;
            route16(lg, P.rb, e0, e1, g0, g1);
            const int tl = wave * 16 + lane;
            const int p0 = __hip_atomic_fetch_add(s_cnt + e0, 1, __ATOMIC_RELAXED, __HIP_MEMORY_SCOPE_WORKGROUP);
            const int p1 = __hip_atomic_fetch_add(s_cnt + e1, 1, __ATOMIC_RELAXED, __HIP_MEMORY_SCOPE_WORKGROUP);
            s_e[2 * tl] = e0; s_e[2 * tl + 1] = e1; s_pos[2 * tl] = p0; s_pos[2 * tl + 1] = p1; s_g[2 * tl] = g0; s_g[2 * tl + 1] = g1;
            TOKE[2 * grow] = e0; TOKE[2 * grow + 1] = e1; TOKG[2 * grow] = g0; TOKG[2 * grow + 1] = g1;
        }
        __syncthreads();
        if (tid < 16) s_base[tid] = (int)__hip_atomic_fetch_add(cnt + tid, (unsigned)s_cnt[tid], RLX_AGENT);
        __syncthreads();
        if (tid < 256) { const int e = s_e[tid], p = s_base[e] + s_pos[tid]; TOKP[2 * blk_row + tid] = p;
            TLIST[(size_t)e * T + p] = blk_row + (tid >> 1); GLIST[(size_t)e * T + p] = s_g[tid]; }
        if (tid < 16) s_cnt[tid] = 0;
        __syncthreads();
    }
}
__device__ __forceinline__ int build_tables(const unsigned char* ws, int l, LAS unsigned char* lds, int tid) {
    LAS int* s_base = (LAS int*)(lds + TAB_OFF); LAS int* s_cntx = s_base + 32; LAS int* texp = s_base + 64;
    const unsigned* cnt = (const unsigned*)(ws + WS_CTL) + CW_CNT + 16 * l;
    if (tid == 0) {
        int base = 0;
#pragma unroll 1
        for (int e = 0; e < 16; ++e) { const int c = (int)__hip_atomic_load(cnt + e, RLX_AGENT); const int nt = (c + 255) >> 8;
            s_cntx[e] = c; s_base[e] = base;
#pragma clang loop vectorize(disable) unroll(disable)
            for (int t = 0; t < nt; ++t) texp[(base >> 8) + t] = e;
            base += nt << 8; }
        s_base[16] = base;
    }
    __syncthreads();
    return s_base[16] >> 8;
}
__device__ __forceinline__ void p8_ln2(const Ptrs& P, int l, bool last, LAS unsigned char* lds, int vcu, int G, int wave, int lane) {
    const LAS int* s_base = (const LAS int*)(lds + TAB_OFF);
    const bf16* Y1B = (const bf16*)(P.ws + WS_Y1B); const float* STATS = (const float*)(P.ws + WS_STATS); const unsigned char* YB = P.ws + WS_YB; bf16* XB = (bf16*)(P.ws + WS_HB);
    const int* TOKE = (const int*)(P.ws + WS_TOKE); const int* TOKP = (const int*)(P.ws + WS_TOKP); const float* TOKG = (const float*)(P.ws + WS_TOKG);
    const float* g1p = P.ln1g + l * D; const float* b1p = P.ln1b + l * D; const float* g2p = P.ln2g + l * D; const float* b2p = P.ln2b + l * D;
    float g1[16], b1[16], g2[16], b2[16];
#pragma unroll
    for (int j = 0; j < 2; ++j)
#pragma unroll
        for (int h = 0; h < 2; ++h) { const int c = 8 * lane + 512 * j + 4 * h;
            const f32x4 a = *(const f32x4*)(g1p + c), b = *(const f32x4*)(b1p + c), cc = *(const f32x4*)(g2p + c), d = *(const f32x4*)(b2p + c);
#pragma unroll
            for (int e = 0; e < 4; ++e) { g1[8 * j + 4 * h + e] = a[e]; b1[8 * j + 4 * h + e] = b[e]; g2[8 * j + 4 * h + e] = cc[e]; b2[8 * j + 4 * h + e] = d[e]; } }
    const int gw = vcu * NWAVES + wave, NGW = G * NWAVES;
    for (int t0 = gw; t0 < T; t0 += 2 * NGW) {
        v4u yv[2][2]; v2u av[2][2], bv[2][2]; f32x2 stv[2], gtv[2];
#pragma unroll
        for (int u = 0; u < 2; ++u) {
            const int t = (t0 + u * NGW < T) ? t0 + u * NGW : t0;
            const int r0 = s_base[TOKE[2 * t]] + TOKP[2 * t], r1 = s_base[TOKE[2 * t + 1]] + TOKP[2 * t + 1];
            stv[u] = *(const f32x2*)(STATS + 2 * (size_t)t); gtv[u] = *(const f32x2*)(TOKG + 2 * (size_t)t);
#pragma unroll
            for (int j = 0; j < 2; ++j) {
                yv[u][j] = *(const v4u*)(Y1B + (size_t)t * D + 8 * lane + 512 * j);
                av[u][j] = *(const v2u*)(YB + (size_t)r0 * D + 8 * lane + 512 * j); bv[u][j] = *(const v2u*)(YB + (size_t)r1 * D + 8 * lane + 512 * j);
            }
        }
#pragma unroll
        for (int u = 0; u < 2; ++u) {
            const int t = t0 + u * NGW;
            if (t < T) {
                const f32x2 st = stv[u]; const float ga = gtv[u].x * (1.0f / Y8_SCALE), gb = gtv[u].y * (1.0f / Y8_SCALE);
                float v[16]; float s = 0.f;
#pragma unroll
                for (int j = 0; j < 2; ++j) {
                    const v4u y = yv[u][j]; const v2u a = av[u][j], b = bv[u][j];
                    const unsigned yw[4] = {y.x, y.y, y.z, y.w}, aw[2] = {a.x, a.y}, bw[2] = {b.x, b.y};
#pragma unroll
                    for (int k = 0; k < 4; ++k) {
                        const int i0 = 8 * j + 2 * k;
                        const float m0 = ga * f8at(aw[k >> 1], 2 * (k & 1)) + gb * f8at(bw[k >> 1], 2 * (k & 1)), m1 = ga * f8at(aw[k >> 1], 2 * (k & 1) + 1) + gb * f8at(bw[k >> 1], 2 * (k & 1) + 1);
                        v[i0] = ALPHA * ((bflo(yw[k]) - st.x) * st.y * g1[i0] + b1[i0]) + m0;
                        v[i0 + 1] = ALPHA * ((bfhi(yw[k]) - st.x) * st.y * g1[i0 + 1] + b1[i0 + 1]) + m1;
                        s += v[i0] + v[i0 + 1];
                    }
                }
                const float mu = wave_sum(s) * (1.0f / D); float q = 0.f;
#pragma unroll
                for (int i = 0; i < 16; ++i) { v[i] -= mu; q += v[i] * v[i]; }
                const float rstd = rsqrtf(wave_sum(q) * (1.0f / D) + LN_EPS);
#pragma unroll
                for (int i = 0; i < 16; ++i) v[i] = v[i] * rstd * g2[i] + b2[i];
                if (last) {
#ifdef MK_PROBE
                    { const float pscale = 1.0f + (float)__hip_atomic_load((const unsigned*)(P.ws + WS_CTL) + 32, RLX_AGENT) * (MK_PSCALE);
#pragma unroll
                      for (int i = 0; i < 16; ++i) v[i] *= pscale; }
#endif
#pragma unroll
                    for (int j = 0; j < 2; ++j) { float* op = P.out + (size_t)t * D + 8 * lane + 512 * j;
                        __builtin_nontemporal_store((f32x4){v[8 * j], v[8 * j + 1], v[8 * j + 2], v[8 * j + 3]}, (f32x4*)op); __builtin_nontemporal_store((f32x4){v[8 * j + 4], v[8 * j + 5], v[8 * j + 6], v[8 * j + 7]}, (f32x4*)(op + 4)); }
                } else {
#pragma unroll
                    for (int j = 0; j < 2; ++j) { v4u w; w.x = pk2(v[8 * j], v[8 * j + 1]); w.y = pk2(v[8 * j + 2], v[8 * j + 3]); w.z = pk2(v[8 * j + 4], v[8 * j + 5]); w.w = pk2(v[8 * j + 6], v[8 * j + 7]);
                        *(v4u*)(XB + (size_t)t * D + 8 * lane + 512 * j) = w;
                        v2u w8; w8.x = pk4_fp8(v[8 * j], v[8 * j + 1], v[8 * j + 2], v[8 * j + 3]); w8.y = pk4_fp8(v[8 * j + 4], v[8 * j + 5], v[8 * j + 6], v[8 * j + 7]); *(v2u*)(P.ws + WS_XB8 + (size_t)t * D + 8 * lane + 512 * j) = w8; }
                }
            }
        }
    }
}

template <class Tp> __device__ __forceinline__ Tp* asg(Tp* p) { GAS Tp* g = (GAS Tp*)p; asm volatile("" : "+s"(g)); return (Tp*)g; }
__device__ __forceinline__ Ptrs load_ptrs(const Ptrs& q) {
    Ptrs P;
    P.x = asg(q.x); P.w_in = asg(q.w_in); P.w_out = asg(q.w_out); P.lg = asg(q.lg); P.lb = asg(q.lb); P.wsp = asg(q.wsp); P.bsp = asg(q.bsp); P.pw = asg(q.pw); P.psc = asg(q.psc);
    P.ln1g = asg(q.ln1g); P.ln1b = asg(q.ln1b); P.rw = asg(q.rw); P.rb = asg(q.rb); P.wg = asg(q.wg); P.wu = asg(q.wu); P.wd = asg(q.wd); P.ln2g = asg(q.ln2g); P.ln2b = asg(q.ln2b);
    P.out = asg(q.out); P.ws = asg(q.ws);
    return P;
}
struct Args { Ptrs p; int ph_lo, ph_hi, li, pad; };
constexpr int N_PHASES = 13;
__global__ void __launch_bounds__(NTHREADS, 2) mk_fwd(Args args_unused) {
    const Args* ka_ = (const Args*)__builtin_amdgcn_kernarg_segment_ptr();
#ifndef USE_KA
#define KA() (&args_unused)
#else
#define KA() ({ const Args* p_ = ka_; asm volatile("" : "+s"(p_)); p_; })
#endif
    extern __shared__ __attribute__((aligned(16))) unsigned char lds_raw[];
    LAS unsigned char* lds = (LAS unsigned char*)lds_raw;
    const int tid0 = threadIdx.x; const int wave0 = __builtin_amdgcn_readfirstlane(tid0 >> 6);
    const int G = gridDim.x; const int bx = blockIdx.x; const int vcu = (G % 8 == 0) ? (bx % 8) * (G / 8) + bx / 8 : bx;
    volatile LAS unsigned* MISC = (volatile LAS unsigned*)(lds + MISC_OFF);
    for (int u = tid0; u < (LDS_BYTES - RING_BYTES) / 4; u += NTHREADS) ((LAS unsigned*)(lds + RING_BYTES))[u] = 0u;
    __syncthreads();
    const int lo = KA()->ph_lo, hi = KA()->ph_hi;
    unsigned* ctl = (unsigned*)(asg(KA()->p.ws) + WS_CTL);
    XcdBarrier bar; bar.bar = ctl + CW_BAR + KA()->li * XCD_BAR_WORDS; bar.x = 0; bar.st = nullptr;
    if (hi - lo > 1) bar = xcd_barrier_post(ctl + CW_BAR + KA()->li * XCD_BAR_WORDS, MISC + 8, tid0);
#define IN(k) (lo <= (k) && (k) < hi)
#ifndef MK_REPEAT
#define MK_REPEAT -1
#endif
#define REP(k) for (int rep_ = 0; rep_ < ((MK_REPEAT == (k)) ? 2 : 1); ++rep_)
#define PHASE_IDS() int wave = wave0; asm volatile("" : "+s"(wave)); int lane; asm volatile("v_mbcnt_lo_u32_b32 %0, -1, 0\n\tv_mbcnt_hi_u32_b32 %0, -1, %0" : "=&v"(lane)); const int tid = wave * 64 + lane; (void)tid
#define SEAM(k) do { if (IN(k) && IN((k) + 1)) xcd_barrier(bar, tid); } while (0)
    PROBE_DECL();
#ifndef PH_MASK
#define PH_MASK 0x1ff
#endif
    if ((PH_MASK & 1) && IN(0)) REP(0) { PHASE_IDS(); PROBE_T0(100); const Ptrs P = load_ptrs(KA()->p); p0_prologue(P, lds, vcu, G, wave, lane, tid); SEAM(0); PROBE_T1(100); }
    for (int l = 0; l < 2; ++l) {
        const int pb = 1 + 6 * l;
        if ((PH_MASK & 2) && IN(pb + 0)) REP(1) {
            PHASE_IDS(); PROBE_T0(101); const Ptrs P = load_ptrs(KA()->p);
            { pg8::Gemm g{P.ws + WS_HB, P.ws + WS_WINB + (size_t)l * 768 * D * 2, 2 * D};
              pg8::StaticOrder so; so.init(T / 256, 3, G, bx); so.pn_base = 6;
              EpiProj E{P.ws, P.lg + l * 256, P.lb + l * 256, 1.0f};
              pg8::gemm_phase<EpiProj, pg8::StaticOrder>(lds, g, so, E, wave); }
            { pg8::Gemm g{P.ws + WS_XB8, P.ws + WS_WIN8 + (size_t)l * 1536 * D, D};
              pg8::StaticOrder so; so.init(T / 256, 6, G, bx); if (G == 256) so.lo_c = 128;
              EpiProj E{P.ws, P.lg + l * 256, P.lb + l * 256, 1.0f / W8_SCALE};
              pg8::gemm_phase<EpiProj, pg8::StaticOrder, MK_ALIGN, false, true>(lds, g, so, E, wave); }
            SEAM(pb + 0); PROBE_T1(101);
        }
        if ((PH_MASK & 4) && IN(pb + 1)) {
            PHASE_IDS(); PROBE_T0(102); const Ptrs P = load_ptrs(KA()->p);
            PROBE_T0(21); REP(21) p2_attention(P.ws, P.ws, lds, vcu, G, wave, lane, tid); PROBE_T1(21);
            PROBE_T0(22); p2_gmlp(P, l, lds, vcu, G, wave, lane, tid); PROBE_T1(22);
            PROBE_T0(23); p2_pool(P, l, lds, vcu, G, wave, lane); PROBE_T1(23);
            SEAM(pb + 1); PROBE_T1(102);
        }
        if ((PH_MASK & 8) && IN(pb + 2)) REP(3) {
            PHASE_IDS(); PROBE_T0(103); const Ptrs P = load_ptrs(KA()->p);
            pg8::Gemm g{(const bf16*)(P.ws + WS_CC), (const bf16*)(P.ws + WS_WOUT) + (size_t)l * D * D, 2 * D};
            pg8::StaticOrder so; so.init(T / 256, D / 256, G, bx);
            EpiOutB E{(const bf16*)(P.ws + WS_HB), (bf16*)(P.ws + WS_Y1B), P.ws + WS_Y1F};
            pg8::gemm_phase<EpiOutB, pg8::StaticOrder>(lds, g, so, E, wave);
            SEAM(pb + 2); PROBE_T1(103);
        }
        if ((PH_MASK & 16) && IN(pb + 3)) { PHASE_IDS(); PROBE_T0(104); const Ptrs P = load_ptrs(KA()->p); p4_stats_router(P, l, lds, vcu, G, wave, lane, tid); SEAM(pb + 3); PROBE_T1(104); }
        if ((PH_MASK & 64) && IN(pb + 4)) {
            PHASE_IDS(); PROBE_T0(105); const Ptrs P = load_ptrs(KA()->p);
            const int ntiles = build_tables(P.ws, l, lds, tid);
            unsigned* rdy = (unsigned*)(P.ws + WS_CTL) + CW_RDY + l * 32768;
            {
                pg8::Gemm g{P.ws + WS_Y1F, P.ws + WS_WGU + (size_t)l * NE * 1024 * D, D};
                pg8::GroupOrder go; go.so.init(ntiles, 4, G, bx); go.s_base = (const LAS int*)(lds + TAB_OFF); go.tlist = (const int*)(P.ws + WS_TLIST); go.toks = (const LAS unsigned short*)(lds + TAB_OFF + 2048);
                go.ready = rdy; go.mode = 1;
                go.stage_tokens((LAS unsigned short*)(lds + TAB_OFF + 2048), tid, NTHREADS); go.stage_stats((LAS float*)(lds + TAB_OFF + 5120), (const float*)(P.ws + WS_STATS), tid, NTHREADS); __syncthreads();
                EpiGU E{P.ws, (const LAS float*)(lds + TAB_OFF + 5120), l};
                pg8::gemm_phase<EpiGU, pg8::GroupOrder, MK_ALIGN, true, true>(lds, g, go, E, wave);
            }
            __syncthreads();
            {
                pg8::Gemm g{P.ws + WS_HB, P.ws + WS_WDN + (size_t)l * NE * D * FF, FF};
                pg8::GroupOrder go; go.so.init(ntiles, 4, G, G - 1 - bx); go.s_base = (const LAS int*)(lds + TAB_OFF); go.tlist = nullptr; go.toks = nullptr;
                go.ready = rdy; go.mode = 2;
                EpiDown E{P.ws + WS_YB};
                pg8::gemm_phase<EpiDown, pg8::GroupOrder, MK_ALIGN, false, true>(lds, g, go, E, wave);
            }
            if (l == 1) PROBE_END(P.ws, bx == 0 && tid == 0);
            SEAM(pb + 4); PROBE_T1(105);
        }
        if ((PH_MASK & 256) && IN(pb + 5)) REP(8) { PHASE_IDS(); PROBE_T0(107); const Ptrs P = load_ptrs(KA()->p); build_tables(P.ws, l, lds, tid); p8_ln2(P, l, l == 1, lds, vcu, G, wave, lane); SEAM(pb + 5); PROBE_T1(107); }
    }
#undef IN
#undef SEAM
}
}
#ifndef MK_CUT
#define MK_CUT 13
#endif
#if MK_CUT < 13
namespace glue {
using namespace mk;
__global__ void g1(const unsigned char* ws, int b, float* proj) {
    const int pos = blockIdx.x; const size_t row = (size_t)b * S + pos;
    for (int col = threadIdx.x; col < NCOL; col += blockDim.x) {
        float v;
        if (col < 1024) { const int c = col & 511, head = c >> 6, d = c & 63; const int t = d < 16 ? (d < 8 ? 2 * d : 2 * (d - 8) + 1) : d;
            const bf16* src = (const bf16*)(ws + (col < 512 ? WS_Q : WS_K)); v = bflo(src[row * 512 + head * 64 + t]); if (col < 512) v *= 8.0f; }
        else if (col < 1536) v = bflo(((const bf16*)(ws + WS_V))[row * 512 + col - 1024]);
        else if (col < 1792) v = bflo(((const bf16*)(ws + WS_U))[row * 256 + col - 1536]);
        else if (col < 2048) v = bflo(((const bf16*)(ws + WS_G))[row * 256 + col - 1792]);
        else v = bflo(((const bf16*)(ws + WS_Z))[row * 256 + col - 2048]);
        proj[(size_t)pos * NCOL + col] = v;
    }
}
__global__ void g2(const unsigned char* ws, int b, float* cc) {
    const int pos = blockIdx.x; const size_t row = (size_t)b * S + pos;
    for (int col = threadIdx.x; col < D; col += blockDim.x) cc[(size_t)pos * D + col] = bflo(((const bf16*)(ws + WS_CC))[row * D + col]);
}
}
#endif

static void mk_launch_range(const mk::Ptrs& p, int grid, int lo, int hi, int li, hipStream_t stream) {
    mk::Args a{};
    a.p = p; a.ph_lo = lo; a.ph_hi = hi; a.li = li; a.pad = 0;
    hipLaunchKernelGGL(mk::mk_fwd, dim3(grid), dim3(mk::NTHREADS), mk::LDS_BYTES, stream, a);
}

extern "C" void kernel_launch(void* const* d_in, const int* in_sizes, int n_in, void* d_out, int out_size, void* d_ws, size_t ws_size, hipStream_t stream) {
    using namespace mk;
    static int grid = 0;
    if (grid == 0) {
        if (n_in != 18 || ws_size < WS_END) { fprintf(stderr, "kernel_launch: unexpected n_in %d / ws_size %zu\n", n_in, ws_size); grid = -1; return; }
        int dev = 0, cus = 0;
        if (hipGetDevice(&dev) != hipSuccess || hipDeviceGetAttribute(&cus, hipDeviceAttributeMultiprocessorCount, dev) != hipSuccess) { grid = -1; return; }
        if (hipFuncSetAttribute((const void*)mk_fwd, hipFuncAttributeMaxDynamicSharedMemorySize, LDS_BYTES) != hipSuccess) { fprintf(stderr, "kernel_launch: hipFuncSetAttribute failed\n"); grid = -1; return; }
        grid = cus;
    }
    if (grid < 0) return;
    (void)hipMemsetAsync((char*)d_ws + WS_CTL, 0, CTL_ZERO_BYTES, stream);
    Ptrs p{};
    const float* const* in = (const float* const*)d_in;
    p.x = in[0]; p.w_in = in[1]; p.w_out = in[2]; p.lg = in[3]; p.lb = in[4]; p.wsp = in[5]; p.bsp = in[6]; p.pw = in[7]; p.psc = in[8];
    p.ln1g = in[9]; p.ln1b = in[10]; p.rw = in[11]; p.rb = in[12]; p.wg = in[13]; p.wu = in[14]; p.wd = in[15]; p.ln2g = in[16]; p.ln2b = in[17];
    p.out = (float*)d_out; p.ws = (unsigned char*)d_ws;
#if MK_CUT >= 13
    mk_launch_range(p, grid, 0, N_PHASES, 0, stream);
#else
    mk_launch_range(p, grid, 0, MK_CUT, 0, stream);
    nv::In I = nv::make_in(d_in);
    const unsigned char* ws = (const unsigned char*)d_ws;
    float* scr_base = (float*)((char*)d_ws + 509 * MiB) - nv::SCR_FLOATS - (size_t)T * D;
    (void)scr_base;
    float* nscr = (float*)((char*)d_ws + (MK_CUT <= 2 ? (size_t)357 * MiB : (size_t)261 * MiB));
    nv::Scr s = nv::carve(nscr);
    float* xcur = (float*)d_out;
    for (int b = 0; b < NB; ++b) {
        const float* xin = I.x + (size_t)b * S * D; float* xout = xcur + (size_t)b * S * D; const int l = 0;
#if MK_CUT == 2
        glue::g1<<<S, 256, 0, stream>>>(ws, b, s.proj);
#endif
#if MK_CUT <= 2
        nv::attn<<<dim3(S, 8), 64, 0, stream>>>(s.proj, s.cc);
        nv::gmlp_mix<<<S, 256, 0, stream>>>(s.proj, I.wsp + (size_t)l * 4 * 128 * 128, I.bsp + l * 4 * 128, s.cc);
        nv::pool1<<<S, 256, 0, stream>>>(s.proj, s.pooled);
        nv::pool2<<<S, 256, 0, stream>>>(s.pooled, I.pw + (size_t)l * 4 * 64 * 64, I.psc + l * 256, s.cc);
#endif
#if MK_CUT == 3
        glue::g2<<<S, 256, 0, stream>>>(ws, b, s.cc);
#endif
#if MK_CUT <= 3
        nv::gemm<<<dim3(D / 64, S / 64), 256, 0, stream>>>(s.cc, I.w_out + (size_t)l * D * D, s.h, S, D, D);
        nv::ln_res<<<S, 64, 0, stream>>>(xin, s.h, I.ln1g + l * D, I.ln1b + l * D, s.x1);
#endif
        nv::route<<<S, 64, 0, stream>>>(s.x1, I.rw, I.rb, s.eo, s.go);
        nv::moe<<<S, 256, 0, stream>>>(s.x1, s.eo, s.go, I.wg + (size_t)l * NE * D * FF, I.wu + (size_t)l * NE * D * FF, I.wd + (size_t)l * NE * FF * D, s.moe);
        nv::ln_res<<<S, 64, 0, stream>>>(s.x1, s.moe, I.ln2g + l * D, I.ln2b + l * D, xout);
    }
    for (int b = 0; b < NB; ++b) { float* xb = xcur + (size_t)b * S * D; nv::layer(I, 1, xb, xb, s, stream); }
#endif
}
```

```cpp
#define MK_CUT 13
#include <hip/hip_runtime.h>
#include <cstdio>
#ifndef MK_ALIGN
#define MK_ALIGN true
#endif
namespace pg8 {
#define PG8_LAS __attribute__((address_space(3)))
typedef unsigned short bf16_t;
typedef short bf16x8 __attribute__((ext_vector_type(8)));
typedef float f32x4 __attribute__((ext_vector_type(4)));
typedef unsigned u32x4 __attribute__((ext_vector_type(4)));
constexpr int BM = 256, BK = 64, HALF = 128, HTB = HALF * BK * 2  , STAGE_BYTES = 8 * HTB, NXCD = 8, WGM = 8;

__host__ __device__ __forceinline__ int lds_byte(int r, int c) { const int st = (r >> 4) * 2 + (c >> 5), rr = r & 15, cc = c & 31, ob = rr * 64 + cc * 2; return st * 1024 + (ob ^ (((ob >> 9) & 1) << 5)); }
__host__ __device__ __forceinline__ void stage_rc(int b, int& R, int& C) { const int st = b / 1024, sb = b % 1024, swz = sb ^ (((sb >> 9) & 1) << 5); R = (st >> 1) * 16 + swz / 64; C = (st & 1) * 32 + (swz % 64) / 2; }
__host__ __device__ __forceinline__ int perm32(int rho) { const int n = rho >> 4, i = rho & 15; return 8 * (i >> 2) + 4 * n + (i & 3); }

struct Unit { int pm, pn, pb, e, l0, ui; };
struct Gemm { const void* A; const void* Bt; int rb; };
typedef int v8i_t __attribute__((ext_vector_type(8)));
typedef int v4i_t __attribute__((ext_vector_type(4)));

struct StaticOrder {
    int nM, nN, nwg, G, c, pn_base, lo_c;
    __device__ void init(int nM_, int nN_, int G_, int c_) { nM = nM_; nN = nN_; nwg = nM * nN; G = G_; c = c_; pn_base = 0; lo_c = 0; }
    __device__ bool next(int i, Unit& u) const {
        long L = (long)i * G + c;
        if (lo_c > 0) { const int hi_n = G - lo_c; if (c >= lo_c) { if (i >= 4) return false; L = (long)(c - lo_c) + (long)hi_n * i; } else { if (i >= 2) return false; L = 4L * hi_n + c + (long)lo_c * i; } }
        return unit_of(L, i, u);
    }
    __device__ bool unit_of(long L, int i, Unit& u) const {
        if (L >= nwg) return false;
        int wgid = (int)L; { const int q = nwg / NXCD, r = nwg % NXCD, xcd = wgid % NXCD, off = wgid / NXCD; wgid = (xcd < r ? xcd * (q + 1) : r * (q + 1) + (xcd - r) * q) + off; }
        const int nig = WGM * nN, gid = wgid / nig, fm = gid * WGM, gsz = (nM - fm) < WGM ? (nM - fm) : WGM;
        u.pm = fm + ((wgid % nig) % gsz); u.pb = (wgid % nig) / gsz; u.pn = u.pb + pn_base; u.e = 0; u.l0 = 0; u.ui = i; return true;
    }
    __device__ __forceinline__ void a_ready(const Unit&, int, int) const {}
    __device__ __forceinline__ void done(const Unit&, int, bool) const {}
    __device__ __forceinline__ void done_late(int) const {}
    __device__ __forceinline__ void claim_issue(int, int, int, unsigned&) const {}
    __device__ __forceinline__ void claim_commit(int, int, int, unsigned) const {}
};
struct GroupOrder {
    StaticOrder so; const PG8_LAS int* s_base; const int* tlist; unsigned* ready; int mode; unsigned okmask = 0u;
    const PG8_LAS unsigned short* toks;
    __device__ bool next(int i, Unit& u) const { if (!so.next(i, u)) return false; const int e = s_base[64 + u.pm]; u.e = e; u.l0 = u.pm * 256 - s_base[e]; u.pb = e * so.nN + u.pn; return true; }
    __device__ __forceinline__ int row_token(int ui, int r) const { return (int)toks[ui * 256 + r]; }
    __device__ __forceinline__ void done(const Unit& u, int lane, bool has_next) const {
        if (mode == 1 && !has_next) {
            asm volatile("s_waitcnt vmcnt(0)" ::: "memory");
            if (lane == 0) __hip_atomic_fetch_add(ready + 64 * u.pm, 1u, __ATOMIC_RELAXED, __HIP_MEMORY_SCOPE_AGENT);
        }
    }
    __device__ __forceinline__ void done_late(int pm) const {
        if (mode == 1) {
            int ln_; asm volatile("v_mbcnt_lo_u32_b32 %0, -1, 0\n\tv_mbcnt_hi_u32_b32 %0, -1, %0" : "=&v"(ln_));
            if (ln_ == 0) __hip_atomic_fetch_add(ready + 64 * pm, 1u, __ATOMIC_RELAXED, __HIP_MEMORY_SCOPE_AGENT);
        }
    }
    __device__ __forceinline__ void a_ready(const Unit& u, int wid, int lane) const {
        if (mode == 2 && !((okmask >> u.ui) & 1u)) {
            if (wid == 0) {
                unsigned spins = 0;
                while ((unsigned)__builtin_amdgcn_readfirstlane(__hip_atomic_load(ready + 64 * u.pm, __ATOMIC_RELAXED, __HIP_MEMORY_SCOPE_AGENT)) < 32u) {
                    __builtin_amdgcn_s_sleep(2);
                    if (++spins > (1u << 22)) break;
                }
                __builtin_amdgcn_fence(__ATOMIC_ACQUIRE, "agent");
                asm volatile("s_waitcnt vmcnt(0)" ::: "memory");
            }
            asm volatile("" ::: "memory"); __builtin_amdgcn_s_barrier(); asm volatile("" ::: "memory");
        }
    }
    __device__ __forceinline__ void stage_tokens(PG8_LAS unsigned short* dst, int tid, int nthreads) const {
        Unit u;
        for (int ui = 0; so.next(ui, u); ++ui) {
            const int e = s_base[64 + u.pm], l0 = u.pm * 256 - s_base[e], nval = s_base[32 + e] - l0;
            for (int r = tid; r < 256; r += nthreads) dst[ui * 256 + r] = (unsigned short)(r < nval ? tlist[(size_t)e * 32768 + l0 + r] : 0);
        }
    }
    __device__ __forceinline__ void stage_stats(PG8_LAS float* dst, const float* stats, int tid, int nthreads) const {
        Unit u;
        for (int ui = 0; so.next(ui, u); ++ui) {
            const int e = s_base[64 + u.pm], l0 = u.pm * 256 - s_base[e], nval = s_base[32 + e] - l0;
            for (int r = tid; r < 256; r += nthreads) { const int tok = r < nval ? tlist[(size_t)e * 32768 + l0 + r] : 0;
                dst[2 * (ui * 256 + r)] = stats[2 * (size_t)tok]; dst[2 * (ui * 256 + r) + 1] = stats[2 * (size_t)tok + 1]; }
        }
    }
    __device__ __forceinline__ void stage_tok_stats(PG8_LAS unsigned short* dtok, PG8_LAS float* dst, const float* stats, int tid) const {
        const int r = tid & 255, half = tid >> 8;
        for (int ub = 0; ; ub += 6) {
            int tk[3]; bool val[3]; float sx[3], sy[3];
#pragma unroll
            for (int k = 0; k < 3; ++k) { Unit u; u.pm = 0; const int ui = ub + half + 2 * k; val[k] = so.next(ui, u);
                const int e = s_base[64 + u.pm], l0 = u.pm * 256 - s_base[e], nval = s_base[32 + e] - l0; const bool in = val[k] && r < nval;
                const size_t li = (size_t)e * 32768 + l0 + r;
                const int raw = tlist[li]; const float rx = stats[2 * li], ry = stats[2 * li + 1];
                tk[k] = in ? raw : 0; sx[k] = in ? rx : 0.f; sy[k] = in ? ry : 1.f; }
#pragma unroll
            for (int k = 0; k < 3; ++k) if (val[k]) { const int ui = ub + half + 2 * k; dtok[ui * 256 + r] = (unsigned short)tk[k]; dst[2 * (ui * 256 + r)] = sx[k]; dst[2 * (ui * 256 + r) + 1] = sy[k]; }
            Unit u2; if (!so.next(ub + 6, u2)) break;
        }
    }
    __device__ __forceinline__ void stage_gates(PG8_LAS float* dst, const float* glist, int tid, int nthreads) const {
        Unit u;
        for (int ui = 0; so.next(ui, u); ++ui) {
            const int e = s_base[64 + u.pm], l0 = u.pm * 256 - s_base[e], nval = s_base[32 + e] - l0;
            for (int r = tid; r < 256; r += nthreads) dst[ui * 256 + r] = r < nval ? glist[(size_t)e * 32768 + l0 + r] : 0.f;
        }
    }
    __device__ __forceinline__ void claim_issue(int, int, int, unsigned&) const {}
    __device__ __forceinline__ void claim_commit(int, int, int, unsigned) const {}
};
struct DynGroupOrder {
    StaticOrder so; const PG8_LAS int* s_base; unsigned* ready; unsigned* cnt; int x; PG8_LAS int* slot;
    __device__ bool next(int i, Unit& u) const {
        const int L = slot[i & 1];
        if (!so.unit_of((long)L, i, u)) return false;
        const int e = s_base[64 + u.pm]; u.e = e; u.l0 = u.pm * 256 - s_base[e]; u.pb = e * so.nN + u.pn; return true;
    }
    __device__ __forceinline__ unsigned claim_one() const { const unsigned k = __hip_atomic_fetch_add(cnt, 1u, __ATOMIC_RELAXED, __HIP_MEMORY_SCOPE_AGENT); return k * 8u + (unsigned)x; }
    __device__ __forceinline__ void claim_issue(int, int, int, unsigned&) const {}
    __device__ __forceinline__ void claim_commit(int, int, int, unsigned) const {}
    __device__ __forceinline__ void done(const Unit&, int, bool) const {}
    __device__ __forceinline__ void done_late(int) const {}
    __device__ __forceinline__ void a_ready(const Unit& u, int wid, int lane) const {
        if (wid == 0) {
            unsigned nxtL = 0u;
            if (u.ui >= 1 && lane == 0) nxtL = claim_one();
            unsigned spins = 0;
            while ((unsigned)__builtin_amdgcn_readfirstlane(__hip_atomic_load(ready + 64 * u.pm, __ATOMIC_RELAXED, __HIP_MEMORY_SCOPE_AGENT)) < 32u) {
                __builtin_amdgcn_s_sleep(2);
                if (++spins > (1u << 22)) break;
            }
            __builtin_amdgcn_fence(__ATOMIC_ACQUIRE, "agent");
            asm volatile("s_waitcnt vmcnt(0)" ::: "memory");
            if (u.ui >= 1 && lane == 0) slot[(u.ui + 1) & 1] = (int)(nxtL > 0x3fffffffu ? 0x3fffffffu : nxtL);
            asm volatile("s_waitcnt lgkmcnt(0)" ::: "memory");
        }
        asm volatile("" ::: "memory"); __builtin_amdgcn_s_barrier(); asm volatile("" ::: "memory");
    }
};

template <class Epi, class Sched>
__device__ __forceinline__ void gemm_prestage_b(PG8_LAS unsigned char* lds, const Gemm g, const Sched& S, const int wave_id) {
    int lane; asm volatile("v_mbcnt_lo_u32_b32 %0, -1, 0\n\tv_mbcnt_hi_u32_b32 %0, -1, %0" : "=&v"(lane));
    const int tid = wave_id * 64 + lane, RB = g.rb;
    Unit u; if (!S.next(0, u)) return;
    const size_t kstep = (size_t)(BK * 2), hstep = (size_t)HALF * RB, tstep = 2 * hstep;
    const char* cB = (const char*)g.Bt + (size_t)u.pb * tstep;
    const unsigned ldsw = (unsigned)wave_id * 1024u;
#pragma unroll
    for (int i = 0; i < 2; ++i) { int R, C; stage_rc(tid * 16 + i * 8192, R, C); const int Rb = Epi::PERM ? ((R & ~31) + perm32(R & 31)) : R;
        const unsigned vo = (unsigned)(Rb * RB + C * 2);
#pragma unroll
        for (int b = 0; b < 2; ++b)
#pragma unroll
            for (int h = 0; h < 2; ++h)
                __builtin_amdgcn_global_load_lds((const unsigned*)(cB + (size_t)h * hstep + (size_t)b * kstep + vo), (PG8_LAS unsigned*)(lds + (4 + b * 2 + h) * HTB + ldsw + i * 8192), 16, 0, 0); }
}
template <class Epi, class Sched, bool ALIGN_EPI = MK_ALIGN, bool GATHER = false, bool F8 = false, int MIX8 = 0, bool PREB = false>
__device__ __forceinline__ void gemm_phase(PG8_LAS unsigned char* lds, const Gemm g, const Sched& S, const Epi& E, const int wave_id, const bool preb = true) {
    int lane; asm volatile("v_mbcnt_lo_u32_b32 %0, -1, 0\n\tv_mbcnt_hi_u32_b32 %0, -1, %0" : "=&v"(lane));
    const int wid = wave_id, tid = wid * 64 + lane, wr = wid >> 2, wc = wid & 3, fr = lane & 15, fq = lane >> 4;
    const int RB = g.rb, nt = RB / 128;
    unsigned voffA[2], voffB[2];
#pragma unroll
    for (int i = 0; i < 2; ++i) { int R, C; stage_rc(tid * 16 + i * 8192, R, C); const int Rb = Epi::PERM ? ((R & ~31) + perm32(R & 31)) : R;
        voffA[i] = (unsigned)(R * RB + C * 2); voffB[i] = (unsigned)(Rb * RB + C * 2); }
    const size_t kstep = (size_t)(BK * 2);
    const size_t hstep = (size_t)HALF * RB;
    const size_t tstep = 2 * hstep;
    const unsigned ldsw = (unsigned)wid * 1024u;
    const int aoff = lds_byte(wr * 64 + fr, fq * 8), boff = lds_byte(wc * 32 + fr, fq * 8);
#define PG8_SA(b, h) (((b) * 2 + (h)) * HTB)
#define PG8_SB(b, h) ((4 + (b) * 2 + (h)) * HTB)
#define PG8_STAGE(bufoff, gbase, voff) do { _Pragma("unroll") for (int _i = 0; _i < 2; ++_i) \
        __builtin_amdgcn_global_load_lds((const unsigned*)((const char*)(gbase) + (voff)[_i]), (PG8_LAS unsigned*)(lds + (bufoff) + ldsw + _i * 8192), 16, 0, 0); } while (0)
#define PG8_STAGE_A(bufoff, gbase, half, usenext) do { if constexpr (GATHER) { _Pragma("unroll") for (int _i = 0; _i < 2; ++_i) \
        __builtin_amdgcn_global_load_lds((const unsigned*)((const char*)(gbase) + ((usenext) ? (((gnp[_i] >> (16 * (half))) & 0xffffu) * (unsigned)RB + (ga[half][_i] & (unsigned)(RB - 1))) : ga[half][_i])), (PG8_LAS unsigned*)(lds + (bufoff) + ldsw + _i * 8192), 16, 0, 0); } \
        else { PG8_STAGE(bufoff, (gbase) + (half) * hstep, voffA); } } while (0)
#define PG8_LD16(off) (*(const PG8_LAS v4i_t*)(lds + (off)))
#define PG8_LDA(dst, b, h, F) do { _Pragma("unroll") for (int m = 0; m < 4; ++m) { if constexpr (F) dst##8[m] = __builtin_shufflevector(PG8_LD16(PG8_SA(b, h) + aoff + m * 2048), PG8_LD16(PG8_SA(b, h) + aoff + m * 2048 + 1024), 0, 1, 2, 3, 4, 5, 6, 7); \
        else { _Pragma("unroll") for (int k = 0; k < 2; ++k) dst[m][k] = *(const PG8_LAS bf16x8*)(lds + PG8_SA(b, h) + aoff + m * 2048 + k * 1024); } } } while (0)
#define PG8_LDB(dst, b, h) PG8_LDB_(dst, b, h, F8)
#define PG8_LDB_(dst, b, h, F) do { _Pragma("unroll") for (int n = 0; n < 2; ++n) { if constexpr (F) dst##8[n] = __builtin_shufflevector(PG8_LD16(PG8_SB(b, h) + boff + n * 2048), PG8_LD16(PG8_SB(b, h) + boff + n * 2048 + 1024), 0, 1, 2, 3, 4, 5, 6, 7); \
        else { _Pragma("unroll") for (int k = 0; k < 2; ++k) dst[n][k] = *(const PG8_LAS bf16x8*)(lds + PG8_SB(b, h) + boff + n * 2048 + k * 1024); } } } while (0)
#define PG8_MMA(ai, bj, At, Bt, F) do { __builtin_amdgcn_s_setprio(1); _Pragma("unroll") for (int m = 0; m < 4; ++m) _Pragma("unroll") for (int n = 0; n < 2; ++n) { \
        if constexpr (F) asm volatile("s_nop 1\n\tv_mfma_scale_f32_16x16x128_f8f6f4 %0, %1, %2, %0, %3, %3 op_sel_hi:[0,0,0]" : "+v"(acc[ai][bj][m][n]) : "v"(Bt##8[n]), "v"(At##8[m]), "v"(one8));   \
        else { _Pragma("unroll") for (int k = 0; k < 2; ++k) acc[ai][bj][m][n] = __builtin_amdgcn_mfma_f32_16x16x32_bf16(Bt[n][k], At[m][k], acc[ai][bj][m][n], 0, 0, 0); } } \
        __builtin_amdgcn_s_setprio(0); } while (0)
#define PG8_WAIT_V(n) asm volatile("s_waitcnt vmcnt(" #n ")" ::: "memory")
#define PG8_WAIT_L(n) asm volatile("s_waitcnt lgkmcnt(" #n ")" ::: "memory")
#define PG8_BAR __builtin_amdgcn_s_barrier()
#define PG8_SCHED __builtin_amdgcn_sched_barrier(0)
    Unit cur, nxt; int ui = 0, prev_pm = 0;
    if (!S.next(0, cur)) return;
    S.a_ready(cur, wid, lane);
    f32x4 acc[2][2][4][2];
#pragma unroll
    for (int a = 0; a < 2; ++a)
#pragma unroll
        for (int b = 0; b < 2; ++b)
#pragma unroll
            for (int m = 0; m < 4; ++m)
#pragma unroll
                for (int n = 0; n < 2; ++n) acc[a][b][m][n] = (f32x4){0.f, 0.f, 0.f, 0.f};
    int one8 = 0x7f7f7f7f; asm volatile("" : "+v"(one8));
    bf16x8 At[4][2], B0[2][2], B1[2][2]; v8i_t At8[4], B08[2], B18[2];
    const char* cA = (const char*)g.A + (GATHER ? (size_t)0 : (size_t)cur.pm * tstep); const char* cB = (const char*)g.Bt + (size_t)cur.pb * tstep;
    unsigned ga[2][2], gnp[2];
    if constexpr (GATHER) {
#pragma unroll
        for (int i = 0; i < 2; ++i) { int R, C; stage_rc(tid * 16 + i * 8192, R, C);
            const unsigned t0 = (unsigned)S.row_token(0, R), t1 = (unsigned)S.row_token(0, 128 + R);
            ga[0][i] = t0 * (unsigned)RB + (unsigned)(C * 2); ga[1][i] = t1 * (unsigned)RB + (unsigned)(C * 2); gnp[i] = t0 | (t1 << 16); }
    }
    if (PREB && preb) {
        PG8_STAGE_A(PG8_SA(0, 0), cA, 0, false); PG8_STAGE_A(PG8_SA(0, 1), cA, 1, false);
        if (wr == 1) PG8_BAR;
        PG8_WAIT_V(2); PG8_BAR;
        PG8_STAGE_A(PG8_SA(1, 0), cA + kstep, 0, false);
        PG8_WAIT_V(2); PG8_BAR;
    } else {
    PG8_STAGE(PG8_SB(0, 0), cB, voffB); PG8_STAGE(PG8_SB(0, 1), cB + hstep, voffB); PG8_STAGE_A(PG8_SA(0, 0), cA, 0, false); PG8_STAGE_A(PG8_SA(0, 1), cA, 1, false);
    if (wr == 1) PG8_BAR;
    PG8_WAIT_V(2); PG8_BAR;
    PG8_STAGE(PG8_SB(1, 0), cB + kstep, voffB); PG8_STAGE_A(PG8_SA(1, 0), cA + kstep, 0, false); PG8_STAGE(PG8_SB(1, 1), cB + hstep + kstep, voffB);
    PG8_WAIT_V(6); PG8_BAR;
    }
    for (;;) {
        const bool has_next = S.next(ui + 1, nxt);
        unsigned claim_ = 0u; S.claim_issue(ui + 2, wid, lane, claim_);
        if constexpr (GATHER) {
            if (has_next) {
                int ln2_; asm volatile("v_mbcnt_lo_u32_b32 %0, -1, 0\n\tv_mbcnt_hi_u32_b32 %0, -1, %0" : "=&v"(ln2_)); const int tid2_ = wid * 64 + ln2_;
#pragma unroll
                for (int i = 0; i < 2; ++i) { int R, C; stage_rc(tid2_ * 16 + i * 8192, R, C); gnp[i] = (unsigned)S.row_token(ui + 1, R) | ((unsigned)S.row_token(ui + 1, 128 + R) << 16); }
            }
        }
        const char* nA = (has_next && !GATHER) ? (const char*)g.A + (size_t)nxt.pm * tstep : cA; const char* nB = has_next ? (const char*)g.Bt + (size_t)nxt.pb * tstep : cB;
#define PG8_TRIP(F) { \
            const bool last = (t == nt - 2); \
            if (last) S.claim_commit(ui + 2, wid, lane, claim_); \
            if (last && has_next) S.a_ready(nxt, wid, lane); \
            const char* a1 = cA + (size_t)(t + 1) * kstep; \
            const char* a2 = last ? nA : cA + (size_t)(t + 2) * kstep; const char* b2 = last ? nB : cB + (size_t)(t + 2) * kstep; \
            const char* a3 = a2 + kstep; const char* b3 = b2 + kstep; \
              \
            PG8_LDB_(B0, 0, 0, F); PG8_LDB_(B1, 0, 1, F); PG8_SCHED; PG8_LDA(At, 0, 0, F); PG8_STAGE_A(PG8_SA(1, 1), a1, 1, false); \
            PG8_WAIT_V(8); PG8_WAIT_L(0); PG8_BAR; PG8_MMA(0, 0, At, B0, F); PG8_MMA(0, 1, At, B1, F); PG8_BAR; PG8_SCHED; \
              \
            PG8_LDA(At, 0, 1, F); PG8_STAGE(PG8_SB(0, 0), b2, voffB); PG8_STAGE(PG8_SB(0, 1), b2 + hstep, voffB); PG8_STAGE_A(PG8_SA(0, 0), a2, 0, last); \
            PG8_WAIT_V(8); if (t == 0 && ui > 0) S.done_late(prev_pm); PG8_WAIT_L(0); PG8_BAR; PG8_MMA(1, 0, At, B0, F); PG8_MMA(1, 1, At, B1, F); PG8_BAR; PG8_SCHED; \
              \
            PG8_LDB_(B0, 1, 0, F); PG8_LDB_(B1, 1, 1, F); PG8_SCHED; PG8_LDA(At, 1, 0, F); PG8_STAGE_A(PG8_SA(0, 1), a2, 1, last); \
            PG8_WAIT_V(8); PG8_WAIT_L(0); PG8_BAR; PG8_MMA(0, 0, At, B0, F); PG8_MMA(0, 1, At, B1, F); PG8_BAR; PG8_SCHED; \
              \
            PG8_LDA(At, 1, 1, F); PG8_STAGE(PG8_SB(1, 0), b3, voffB); PG8_STAGE(PG8_SB(1, 1), b3 + hstep, voffB); PG8_STAGE_A(PG8_SA(1, 0), a3, 0, last); \
            PG8_WAIT_V(8); PG8_WAIT_L(0); PG8_BAR; PG8_MMA(1, 0, At, B0, F); PG8_MMA(1, 1, At, B1, F); PG8_BAR; PG8_SCHED; \
        }
        if constexpr (MIX8) {
            for (int t = 0; t < MIX8; t += 2) PG8_TRIP(true)
            asm volatile("s_nop 7\n\ts_nop 7" ::: "memory");
            for (int t = MIX8; t < nt; t += 2) PG8_TRIP(false)
        } else {
            for (int t = 0; t < nt; t += 2) PG8_TRIP(F8)
        }
#undef PG8_TRIP
        if constexpr (ALIGN_EPI) { if (wr == 0) PG8_BAR; }
        if constexpr (F8) asm volatile("s_nop 7\n\ts_nop 7" ::: "memory");
        { int ln_; asm volatile("v_mbcnt_lo_u32_b32 %0, -1, 0\n\tv_mbcnt_hi_u32_b32 %0, -1, %0" : "=&v"(ln_)); E(acc, cur, wr, wc, ln_ & 15, ln_ >> 4); S.done(cur, ln_, has_next); }
        if (!has_next) break;
#pragma unroll
        for (int a = 0; a < 2; ++a)
#pragma unroll
            for (int b = 0; b < 2; ++b)
#pragma unroll
                for (int m = 0; m < 4; ++m)
#pragma unroll
                    for (int n = 0; n < 2; ++n) acc[a][b][m][n] = (f32x4){0.f, 0.f, 0.f, 0.f};
        prev_pm = cur.pm; cur = nxt; cA = nA; cB = nB; ++ui;
        if constexpr (GATHER) {
#pragma unroll
            for (int h = 0; h < 2; ++h)
#pragma unroll
                for (int i = 0; i < 2; ++i) ga[h][i] = ((gnp[i] >> (16 * h)) & 0xffffu) * (unsigned)RB + (ga[h][i] & (unsigned)(RB - 1));
        }
        if constexpr (ALIGN_EPI) { if (wr == 1) PG8_BAR; }
    }
    PG8_WAIT_V(0);
    if constexpr (!ALIGN_EPI) { if (wr == 0) PG8_BAR; }
    PG8_BAR;
#undef PG8_SA
#undef PG8_SB
#undef PG8_STAGE
#undef PG8_STAGE_A
#undef PG8_LDA
#undef PG8_LDB
#undef PG8_MMA
#undef PG8_LD16
#undef PG8_WAIT_V
#undef PG8_WAIT_L
#undef PG8_BAR
#undef PG8_SCHED
}
}
#ifndef MK_REPEAT
#define MK_REPEAT -1
#endif
#ifndef MK_PREB
#define MK_PREB (MK_CUT >= 13 && MK_REPEAT < 0)
#endif
namespace mk {
constexpr int NB = 16, S = 2048, T = NB * S, D = 1024, NCOL = 2304, NE = 16, FF = 512;
constexpr float ALPHA = 1.4142135623730951f, LN_EPS = 1e-5f, LOG2E = 1.4426950408889634f;
constexpr int NWAVES = 8, NTHREADS = 512;
constexpr int MAXROWS = 69632;
constexpr int MAXTILES = 272;

constexpr size_t MiB = 1u << 20;
constexpr size_t WS_CTL = 0, CTL_ZERO_BYTES = MiB / 2;
constexpr size_t WS_ROPE = 1 * MiB;
constexpr size_t WS_TOKE = WS_ROPE + 256 * 1024;
constexpr size_t WS_TOKG = WS_TOKE + 256 * 1024;
constexpr size_t WS_TOKP = WS_TOKG + 256 * 1024;
constexpr size_t WS_STATS = 2 * MiB;
constexpr size_t WS_LSE = 3 * MiB;
constexpr size_t WS_WPT = 6 * MiB;
constexpr size_t WS_WST = 6 * MiB + 64 * 1024;
constexpr size_t WS_RWQ = 6 * MiB + 512 * 1024;
constexpr size_t WS_CR = 6 * MiB + 768 * 1024;
constexpr size_t WS_C1P = 7 * MiB;
constexpr size_t WS_C2P = 7 * MiB + 256 * 1024;
constexpr size_t WS_WIN8 = 8 * MiB, WS_WINB = 12 * MiB, WS_WOUT = 17 * MiB, WS_WGU = 21 * MiB, WS_WDN = 85 * MiB;
constexpr size_t WS_XB8 = 445 * MiB;
constexpr size_t WS_Y1B = 117 * MiB;
constexpr size_t WS_TLIST = 181 * MiB;
constexpr size_t WS_SLIST = 320 * MiB;
constexpr size_t WS_GLIST = 183 * MiB;
constexpr size_t WS_Y1F = 185 * MiB;
constexpr size_t WS_YB = 245 * MiB;
constexpr size_t WS_HB = 381 * MiB;
constexpr size_t WS_Q = 117 * MiB, WS_K = 149 * MiB, WS_V = 181 * MiB, WS_U = 213 * MiB, WS_G = 229 * MiB, WS_Z = 245 * MiB;
constexpr size_t WS_PO = 261 * MiB;
constexpr size_t WS_CC = 445 * MiB;
constexpr int CCB = 1536;
constexpr float CC_SCALE = 16.0f;
constexpr size_t WS_END = 509 * MiB;
constexpr int CW_CNT = 64;
constexpr int CW_BAR = 4096;
constexpr int CW_Q = 128;
constexpr int CW_RDY = 65536;

constexpr int RING_BYTES = 131072;
constexpr int MISC_OFF = RING_BYTES + 320;
constexpr int TAB_OFF = RING_BYTES + 1024;
constexpr int LDS_BYTES = 147456;

#define GAS __attribute__((address_space(1)))
#define LAS __attribute__((address_space(3)))
typedef unsigned short bf16;
typedef unsigned v4u __attribute__((ext_vector_type(4)));
typedef unsigned v2u __attribute__((ext_vector_type(2)));
typedef float f32x4 __attribute__((ext_vector_type(4)));
typedef float f32x2 __attribute__((ext_vector_type(2)));
typedef float f32x16 __attribute__((ext_vector_type(16)));
typedef short bf16x8 __attribute__((ext_vector_type(8)));
typedef short s16x4 __attribute__((ext_vector_type(4)));
typedef __bf16 bf16x2_t __attribute__((ext_vector_type(2)));
typedef GAS unsigned gu32;
#define RLX_AGENT __ATOMIC_RELAXED, __HIP_MEMORY_SCOPE_AGENT
#define LDS_WAIT() asm volatile("s_waitcnt lgkmcnt(0)" ::: "memory")

__device__ __forceinline__ unsigned pk2(float lo, float hi) { f32x2 v = {lo, hi}; bf16x2_t r = __builtin_convertvector(v, bf16x2_t); return __builtin_bit_cast(unsigned, r); }
__device__ __forceinline__ unsigned pk4_fp8(float a, float b, float c, float d) { int r = 0; r = __builtin_amdgcn_cvt_pk_fp8_f32(a, b, r, false); r = __builtin_amdgcn_cvt_pk_fp8_f32(c, d, r, true); return (unsigned)r; }
__device__ __forceinline__ float fp8_rt(float a) { const int r = __builtin_amdgcn_cvt_pk_fp8_f32(a, a, 0, false); return __builtin_amdgcn_cvt_f32_fp8(r, 0); }
constexpr float W8_SCALE = 64.0f, H8_SCALE = 8.0f, Y8_SCALE = 16.0f;
__device__ __forceinline__ float bflo(unsigned u) { return __builtin_bit_cast(float, u << 16); }
__device__ __forceinline__ float bfhi(unsigned u) { return __builtin_bit_cast(float, u & 0xffff0000u); }
__device__ __forceinline__ float wave_sum(float v) {
#pragma unroll
    for (int o = 1; o < 64; o <<= 1) v += __shfl_xor(v, o);
    return v;
}
__device__ __forceinline__ float fast_exp2(float x) { return __builtin_amdgcn_exp2f(x); }
__device__ __forceinline__ float fast_rcp(float x) { return __builtin_amdgcn_rcpf(x); }
__device__ __forceinline__ float gelu_t(float x) {
    const float y = x * (1.5957691216057308f + 0.07135481627159498f * x * x);
    return x * fast_rcp(1.0f + fast_exp2(-LOG2E * y));
}
__device__ __forceinline__ float silu_f(float x) { return x * fast_rcp(1.0f + fast_exp2(-LOG2E * x)); }
__device__ __forceinline__ int crow(int reg, int h) { return (reg & 3) + 8 * (reg >> 2) + 4 * h; }

#define XB_TMO      128
#define XB_XCNT(j)  (256  + 64 * (j))
#define XB_XSUB(j)  (1280 + 64 * (j))
#define XB_XGEN(j)  (2304 + 64 * (j))
#define XB_TOP      3328
#define XB_TOPGEN   3392
#define XCD_BAR_WORDS 3456
#define XB_SPIN_CAP (1u << 22)
__device__ __forceinline__ unsigned xb_ld(unsigned* p)              { return __hip_atomic_load(p, __ATOMIC_RELAXED, __HIP_MEMORY_SCOPE_AGENT); }
__device__ __forceinline__ unsigned xb_add(unsigned* p, unsigned v) { return __hip_atomic_fetch_add(p, v, __ATOMIC_RELAXED, __HIP_MEMORY_SCOPE_AGENT); }
__device__ __forceinline__ unsigned xb_xcc_id() { return (unsigned)__builtin_amdgcn_s_getreg((3 << 11) | 20) & 0xFu; }
#define XB_SPIN(cond, bar) do { unsigned _sp = 0; while (cond) { __builtin_amdgcn_s_sleep(1); \
    if ((++_sp & 255u) == 0u) { if (xb_ld(&(bar)[XB_TMO])) break; if (_sp > XB_SPIN_CAP) { atomicAdd(&(bar)[XB_TMO], 1u); break; } } } } while (0)
struct XcdBarrier { unsigned* bar; unsigned x; volatile LAS unsigned* st; };
__device__ __forceinline__ XcdBarrier xcd_barrier_post(unsigned* bar, volatile LAS unsigned* st, int tid) {
    XcdBarrier b; b.bar = bar; b.x = xb_xcc_id(); b.st = st;
    if (tid == 0) (void)xb_add(&bar[XB_XCNT(b.x)], 1u);
    return b;
}
__device__ __forceinline__ void xcd_barrier_complete(unsigned* bar, unsigned x, unsigned& nloc, unsigned& nx) {
    const unsigned G = gridDim.x * gridDim.y * gridDim.z;
    unsigned sum, cnt, mine, sp = 0u;
    for (;;) {
        sum = 0u; cnt = 0u; mine = 0u;
#pragma unroll
        for (unsigned j = 0; j < 16; ++j) { const unsigned c = xb_ld(&bar[XB_XCNT(j)]); sum += c; cnt += (c > 0u) ? 1u : 0u; mine = (j == x) ? c : mine; }
        if (sum == G) break;
        __builtin_amdgcn_s_sleep(1);
        if ((++sp & 255u) == 0u) { if (xb_ld(&bar[XB_TMO])) break; if (sp > XB_SPIN_CAP) { atomicAdd(&bar[XB_TMO], 1u); break; } }
    }
    nloc = mine > 0u ? mine : 1u; nx = cnt > 0u ? cnt : 1u;
}
__device__ __forceinline__ void xcd_barrier(const XcdBarrier& b, int tid) {
    asm volatile("s_waitcnt vmcnt(0)" ::: "memory");
    __syncthreads();
    if (tid == 0) {
        unsigned* bar = b.bar;
        __builtin_amdgcn_s_waitcnt(0);
        unsigned nloc = b.st[0], nx = b.st[1];
        if (nloc == 0u) { xcd_barrier_complete(bar, b.x, nloc, nx); b.st[0] = nloc; b.st[1] = nx; }
        const unsigned old = xb_add(&bar[XB_XSUB(b.x)], 1u);
        const unsigned gen = old / nloc;
        if (old + 1u == (gen + 1u) * nloc) {
            __builtin_amdgcn_fence(__ATOMIC_RELEASE, "agent");
            asm volatile("s_waitcnt vmcnt(0)" ::: "memory");
            const unsigned og = xb_add(&bar[XB_TOP], 1u);
            const unsigned tg = og / nx;
            if (og + 1u == (tg + 1u) * nx) xb_add(&bar[XB_TOPGEN], 1u);
            else XB_SPIN(xb_ld(&bar[XB_TOPGEN]) == tg, bar);
            __builtin_amdgcn_fence(__ATOMIC_ACQUIRE, "agent");
            xb_add(&bar[XB_XGEN(b.x)], 1u);
            asm volatile("s_waitcnt vmcnt(0)" ::: "memory");
        } else {
            XB_SPIN(xb_ld(&bar[XB_XGEN(b.x)]) == gen, bar);
            __builtin_amdgcn_fence(__ATOMIC_ACQUIRE, "agent");
            asm volatile("s_waitcnt vmcnt(0)" ::: "memory");
        }
    }
    __syncthreads();
}

__device__ __forceinline__ v4u pair16(v2u xa, v2u xb) {
    const auto r0 = __builtin_amdgcn_permlane16_swap(xa.x, xb.x, false, false);
    const auto r1 = __builtin_amdgcn_permlane16_swap(xa.y, xb.y, false, false);
    return (v4u){(unsigned)r0[0], (unsigned)r1[0], (unsigned)r0[1], (unsigned)r1[1]};
}
#ifdef NO_FENCE
#define EPI_FENCE() do {} while (0)
#else
#define EPI_FENCE() asm volatile("" ::: "memory")
#endif
using pg8::Unit;
struct EpiProj {
    static constexpr bool PERM = true;
    unsigned char* ws; const float *lg, *lb; float accscale;
    static __device__ __forceinline__ void store16(bf16* dst, const f32x4 (&v)[2]) {
        v4u w; w.x = pk2(v[0][0], v[0][1]); w.y = pk2(v[0][2], v[0][3]); w.z = pk2(v[1][0], v[1][1]); w.w = pk2(v[1][2], v[1][3]);
        *(v4u*)dst = w;
    }
    template <int MODE>
    __device__ __forceinline__ void run(const f32x4 (&acc)[2][2][4][2], const Unit& u, int wr, int wc, int fr, int fq) const {
        const int pn = u.pn;
        const int rowb = u.pm * 256 + wr * 64 + fr;
        bf16* dbase; int cstep = 128, rstride = 512;
        if (MODE == 0) dbase = nullptr;
        else if (MODE == 1) { if (pn < 6) dbase = (bf16*)(ws + WS_V) + (pn - 4) * 256 + wc * 32 + 8 * fq; else { dbase = (bf16*)(ws + WS_Z) + wc * 32 + 8 * fq; rstride = 256; } }
        else if (MODE == 2) { dbase = (bf16*)(ws + WS_U) + wc * 32 + 8 * fq; rstride = 256; }
        else { dbase = (bf16*)(ws + WS_G) + wc * 64 + 8 * fq; rstride = 256; cstep = 32; }
        const bool dorope = ((wc & 1) == 0) && (fq < 2);
        const float sc = accscale;
        v2u keep0 = {0u, 0u}, keep1 = {0u, 0u};
        const bool hi4 = fq & 1;
        const float ir0 = hi4 ? 0.00022507907903927653f : 0.15915494309189535f, ir1 = hi4 ? 4.364795279280289e-05f : 0.03086376340470123f,
                    ir2 = hi4 ? 8.464330808241401e-06f : 0.005985185712713705f, ir3 = hi4 ? 1.6414262627950345e-06f : 0.001160663641240061f;
        f32x4 lgv[2][2], lbv[2][2];
        if (MODE == 3) {
#pragma unroll
            for (int bj = 0; bj < 2; ++bj)
#pragma unroll
                for (int n = 0; n < 2; ++n) { const int dim = wc * 64 + 32 * bj + 8 * fq + 4 * n; lgv[bj][n] = *(const f32x4*)(lg + dim); lbv[bj][n] = *(const f32x4*)(lb + dim); }
        }
#pragma unroll
        for (int g = 0; g < 8; ++g) {
            const int ai = g >> 2, m = g & 3;
            const int row = rowb + ai * 128 + m * 16;
            f32x4 v[2][2];
#pragma unroll
            for (int bj = 0; bj < 2; ++bj)
#pragma unroll
                for (int n = 0; n < 2; ++n) v[bj][n] = (MODE == 1) ? acc[ai][bj][m][n] * accscale : acc[ai][bj][m][n];
            if (MODE == 0) {
                f32x4 cs0, cs1;
                { const float fp = (float)(row & (S - 1));
                  const float r0 = __builtin_amdgcn_fractf(fp * ir0), r1 = __builtin_amdgcn_fractf(fp * ir1), r2 = __builtin_amdgcn_fractf(fp * ir2), r3 = __builtin_amdgcn_fractf(fp * ir3);
                  cs0 = (f32x4){__builtin_amdgcn_cosf(r0), __builtin_amdgcn_sinf(r0), __builtin_amdgcn_cosf(r1), __builtin_amdgcn_sinf(r1)};
                  cs1 = (f32x4){__builtin_amdgcn_cosf(r2), __builtin_amdgcn_sinf(r2), __builtin_amdgcn_cosf(r3), __builtin_amdgcn_sinf(r3)}; }
                if (dorope) {
#pragma unroll
                    for (int bj = 0; bj < 2; ++bj) {
                        float a, b;
                        a = v[bj][0][0]; b = v[bj][0][1]; v[bj][0][0] = a * cs0[0] - b * cs0[1]; v[bj][0][1] = b * cs0[0] + a * cs0[1];
                        a = v[bj][0][2]; b = v[bj][0][3]; v[bj][0][2] = a * cs0[2] - b * cs0[3]; v[bj][0][3] = b * cs0[2] + a * cs0[3];
                        a = v[bj][1][0]; b = v[bj][1][1]; v[bj][1][0] = a * cs1[0] - b * cs1[1]; v[bj][1][1] = b * cs1[0] + a * cs1[1];
                        a = v[bj][1][2]; b = v[bj][1][3]; v[bj][1][2] = a * cs1[2] - b * cs1[3]; v[bj][1][3] = b * cs1[2] + a * cs1[3];
                    }
                }
#pragma unroll
                for (int bj = 0; bj < 2; ++bj)
#pragma unroll
                    for (int n = 0; n < 2; ++n) v[bj][n] = v[bj][n] * sc;
            }
            if (MODE == 2 || MODE == 3) {
#pragma unroll
                for (int bj = 0; bj < 2; ++bj)
#pragma unroll
                    for (int n = 0; n < 2; ++n)
#pragma unroll
                        for (int e = 0; e < 4; ++e) v[bj][n][e] = gelu_t(v[bj][n][e]);
            }
            if (MODE == 3) {
                float s = 0.f;
#pragma unroll
                for (int bj = 0; bj < 2; ++bj)
#pragma unroll
                    for (int n = 0; n < 2; ++n) s += (v[bj][n][0] + v[bj][n][1]) + (v[bj][n][2] + v[bj][n][3]);
                s += __shfl_xor(s, 16); s += __shfl_xor(s, 32);
                const float mu = s * (1.0f / 64.0f); float q = 0.f;
#pragma unroll
                for (int bj = 0; bj < 2; ++bj)
#pragma unroll
                    for (int n = 0; n < 2; ++n)
#pragma unroll
                        for (int e = 0; e < 4; ++e) { v[bj][n][e] -= mu; q += v[bj][n][e] * v[bj][n][e]; }
                q += __shfl_xor(q, 16); q += __shfl_xor(q, 32);
                const float rstd = rsqrtf(q * (1.0f / 64.0f) + LN_EPS);
#pragma unroll
                for (int bj = 0; bj < 2; ++bj)
#pragma unroll
                    for (int n = 0; n < 2; ++n) v[bj][n] = v[bj][n] * rstd * lgv[bj][n] + lbv[bj][n];
            }
            if (MODE == 0) {
                v2u w0; w0.x = pk4_fp8(v[0][0][0], v[0][0][1], v[0][0][2], v[0][0][3]); w0.y = pk4_fp8(v[0][1][0], v[0][1][1], v[0][1][2], v[0][1][3]);
                v2u w1; w1.x = pk4_fp8(v[1][0][0], v[1][0][1], v[1][0][2], v[1][0][3]); w1.y = pk4_fp8(v[1][1][0], v[1][1][1], v[1][1][2], v[1][1][3]);
                if ((g & 1) == 0) { keep0 = w0; keep1 = w1; }
                else {
                    const int prow = (fq & 1) ? row : row - 16;
                    unsigned char* d8 = ws + (pn < 2 ? WS_Q : WS_K) + (size_t)prow * 512 + (pn & 1) * 256 + wc * 32 + 8 * (fq & ~1);
                    *(v4u*)d8 = pair16(keep0, w0); *(v4u*)(d8 + 128) = pair16(keep1, w1);
                }
            } else {
                bf16* dst = dbase + (size_t)row * rstride;
                store16(dst, v[0]); store16(dst + cstep, v[1]);
            }
            EPI_FENCE();
        }
    }
    __device__ __forceinline__ void operator()(const f32x4 (&acc)[2][2][4][2], const Unit& u, int wr, int wc, int fr, int fq) const {
        const int pn = u.pn;
        if (pn < 4) run<0>(acc, u, wr, wc, fr, fq);
        else if (pn == 6) run<2>(acc, u, wr, wc, fr, fq);
        else if (pn == 7) run<3>(acc, u, wr, wc, fr, fq);
        else run<1>(acc, u, wr, wc, fr, fq);
    }
};
struct EpiOutB {
    static constexpr bool PERM = true;
    const bf16* xres; bf16* Y; unsigned char* Y8;
    __device__ __forceinline__ void operator()(const f32x4 (&acc)[2][2][4][2], const Unit& u, int wr, int wc, int fr, int fq) const {
        const size_t off0 = (size_t)(u.pm * 256 + wr * 64 + fr) * D + u.pn * 256 + wc * 32 + 8 * fq;
        v2u keep8[2] = {{0u, 0u}, {0u, 0u}};
        constexpr int XD = 8;
        v4u xr[XD][2];
#pragma unroll
        for (int g = 0; g < XD; ++g) { const size_t off = off0 + (size_t)((g >> 2) * 128 + (g & 3) * 16) * D; xr[g][0] = *(const v4u*)(xres + off); xr[g][1] = *(const v4u*)(xres + off + 128); }
#pragma unroll
        for (int g = 0; g < 8; ++g) {
            const int ai = g >> 2, m = g & 3;
            const size_t off = off0 + (size_t)(ai * 128 + m * 16) * D;
            const v4u x0 = xr[g % XD][0], x1 = xr[g % XD][1];
            if (g + XD < 8) { const size_t offn = off0 + (size_t)(((g + XD) >> 2) * 128 + ((g + XD) & 3) * 16) * D; xr[g % XD][0] = *(const v4u*)(xres + offn); xr[g % XD][1] = *(const v4u*)(xres + offn + 128); }
#pragma unroll
            for (int bj = 0; bj < 2; ++bj) {
                const v4u x = bj ? x1 : x0;
                const f32x4 a = acc[ai][bj][m][0] * (1.0f / (CC_SCALE * W8_SCALE)), b = acc[ai][bj][m][1] * (1.0f / (CC_SCALE * W8_SCALE));
                v4u w; w.x = pk2(a[0] + ALPHA * bflo(x.x), a[1] + ALPHA * bfhi(x.x)); w.y = pk2(a[2] + ALPHA * bflo(x.y), a[3] + ALPHA * bfhi(x.y));
                w.z = pk2(b[0] + ALPHA * bflo(x.z), b[1] + ALPHA * bfhi(x.z)); w.w = pk2(b[2] + ALPHA * bflo(x.w), b[3] + ALPHA * bfhi(x.w));
                *(v4u*)(Y + off + bj * 128) = w;
                v2u w8; w8.x = pk4_fp8(a[0] + ALPHA * bflo(x.x), a[1] + ALPHA * bfhi(x.x), a[2] + ALPHA * bflo(x.y), a[3] + ALPHA * bfhi(x.y));
                w8.y = pk4_fp8(b[0] + ALPHA * bflo(x.z), b[1] + ALPHA * bfhi(x.z), b[2] + ALPHA * bflo(x.w), b[3] + ALPHA * bfhi(x.w));
                if ((g & 1) == 0) keep8[bj] = w8;
                else { const size_t poff = ((fq & 1) ? off : off - (size_t)16 * D) - 8 * (fq & 1); *(v4u*)(Y8 + poff + bj * 128) = pair16(keep8[bj], w8); }
            }
            EPI_FENCE();
        }
    }
};
struct EpiGU {
    static constexpr bool PERM = true;
    unsigned char* ws; const LAS float* meta; int l;
    __device__ __forceinline__ void operator()(const f32x4 (&acc)[2][2][4][2], const Unit& u, int wr, int wc, int fr, int fq) const {
        const int cb = u.e * 1024 + u.pn * 256 + wc * 32 + 8 * fq;
        unsigned char* H = ws + WS_HB;
        const float* c1a = (const float*)(ws + WS_C1P) + (size_t)l * 16 * 1024; const float* c1b = c1a + 32 * 1024; const float* c2a = c1a + 65536; const float* c2b = c2a + 32 * 1024;
        float c1[2][8], c2[2][8];
#pragma unroll
        for (int bj = 0; bj < 2; ++bj)
#pragma unroll
            for (int n = 0; n < 2; ++n) {
                const f32x4 a = *(const f32x4*)(c1a + cb + bj * 128 + 4 * n), b = *(const f32x4*)(c1b + cb + bj * 128 + 4 * n);
                const f32x4 c = *(const f32x4*)(c2a + cb + bj * 128 + 4 * n), d = *(const f32x4*)(c2b + cb + bj * 128 + 4 * n);
#pragma unroll
                for (int e = 0; e < 4; ++e) { c1[bj][4 * n + e] = a[e] + b[e]; c2[bj][4 * n + e] = c[e] + d[e]; }
            }
#pragma unroll
        for (int ai = 0; ai < 2; ++ai)
#pragma unroll
            for (int mp = 0; mp < 2; ++mp) {
                v2u wq[2];
#pragma unroll
                for (int q = 0; q < 2; ++q) {
                    const int m = 2 * mp + q;
                    const int rl = ai * 128 + wr * 64 + m * 16 + fr;
                    const f32x2 st = *(const LAS f32x2*)(meta + 2 * (u.ui * 256 + rl));
                    float hv[8];
#pragma unroll
                    for (int n = 0; n < 2; ++n)
#pragma unroll
                        for (int e = 0; e < 4; ++e) {
                            const float g = st.y * (acc[ai][0][m][n][e] * (1.0f / W8_SCALE) - st.x * c1[0][4 * n + e]) + c2[0][4 * n + e];
                            const float up = st.y * (acc[ai][1][m][n][e] * (1.0f / W8_SCALE) - st.x * c1[1][4 * n + e]) + c2[1][4 * n + e];
                            hv[4 * n + e] = silu_f(g) * up * H8_SCALE;
                        }
                    wq[q].x = pk4_fp8(hv[0], hv[1], hv[2], hv[3]); wq[q].y = pk4_fp8(hv[4], hv[5], hv[6], hv[7]);
                }
                const v4u w = pair16(wq[0], wq[1]);
                const int rl = ai * 128 + wr * 64 + (2 * mp + (fq & 1)) * 16 + fr;
                { unsigned char* hp = H + (size_t)(u.pm * 256 + rl) * FF + u.pn * 128 + wc * 32 + 8 * (fq & ~1);
                  asm volatile("global_store_dwordx4 %0, %1, off sc1\n\ts_nop 1" :: "v"(hp), "v"(w) : "memory"); }
                EPI_FENCE();
            }
    }
};
struct EpiDown {
    static constexpr bool PERM = true;
    unsigned char* Y;
    __device__ __forceinline__ void operator()(const f32x4 (&acc)[2][2][4][2], const Unit& u, int wr, int wc, int fr, int fq) const {
        constexpr float gs = Y8_SCALE / (W8_SCALE * H8_SCALE);
#pragma unroll
        for (int ai = 0; ai < 2; ++ai)
#pragma unroll
            for (int m = 0; m < 4; ++m) {
                const int rl = ai * 128 + wr * 64 + m * 16 + fr;
                const f32x4 a0 = acc[ai][0][m][0] * gs, b0 = acc[ai][0][m][1] * gs, a1 = acc[ai][1][m][0] * gs, b1 = acc[ai][1][m][1] * gs;
                v4u w; w.x = pk4_fp8(a0[0], a0[1], a0[2], a0[3]); w.y = pk4_fp8(b0[0], b0[1], b0[2], b0[3]); w.z = pk4_fp8(a1[0], a1[1], a1[2], a1[3]); w.w = pk4_fp8(b1[0], b1[1], b1[2], b1[3]);
                *(v4u*)(Y + (size_t)(u.pm * 256 + rl) * D + u.pn * 256 + wc * 64 + 16 * fq) = w;
                EPI_FENCE();
            }
    }
};

__device__ __forceinline__ int win_src_col(int n) {
    if (n < 1024) { int t = n & 63; const int hb = n & ~63; if (t < 16) t = (t & 1) ? 8 + (t >> 1) : (t >> 1); return hb + t; }
    if (n >= 1792 && n < 2048) { const int t = n - 1792, bj = t >> 7, wc = (t >> 5) & 3, j = t & 31; return 1792 + 64 * wc + 32 * bj + j; }
    return n;
}
__device__ __forceinline__ int cc_dim(int p, int kind) {
    if (kind == 1) { const int hh = p >> 5, j = p & 31; return (j < 16 ? 0 : 32) + 8 * ((j & 15) >> 2) + 4 * hh + (j & 3); }
    if (kind == 2) { const int db = p >> 5, hh = (p >> 4) & 1, g4 = (p >> 2) & 3, e = p & 3; return 32 * db + 8 * g4 + 4 * hh + e; }
    return p;
}
template <int KIND = 0, bool SCALED = false>
__device__ __forceinline__ void p0_tr_item(const float* cp, int ld, int K, bf16* WT, int k0, int n0, LAS float* scr, int lane, bool ntst = false, int ksrc0 = -1) {
    const int ks0 = ksrc0 < 0 ? k0 : ksrc0;
    constexpr int kind = KIND; constexpr float scale = SCALED ? W8_SCALE : 1.0f;
    float v[32];
#pragma unroll
    for (int i = 0; i < 32; ++i) v[i] = __builtin_nontemporal_load(cp + (size_t)(ks0 + cc_dim(2 * i + (lane >> 5), kind)) * ld);
#pragma unroll
    for (int i = 0; i < 32; ++i) scr[(2 * i + (lane >> 5)) * 33 + (lane & 31)] = v[i] * scale;
    LDS_WAIT(); asm volatile("" ::: "memory");
    const int c = lane & 7;
#pragma unroll
    for (int j = 0; j < 4; ++j) { const int n = (lane >> 3) + 8 * j; const LAS float* s = scr + (8 * c) * 33 + n;
        v4u o; o.x = pk2(s[0 * 33], s[1 * 33]); o.y = pk2(s[2 * 33], s[3 * 33]); o.z = pk2(s[4 * 33], s[5 * 33]); o.w = pk2(s[6 * 33], s[7 * 33]);
        if (ntst) __builtin_nontemporal_store(o, (v4u*)(WT + (size_t)(n0 + n) * K + k0 + 8 * c)); else *(v4u*)(WT + (size_t)(n0 + n) * K + k0 + 8 * c) = o; }
    LDS_WAIT(); asm volatile("" ::: "memory");
}
__device__ __forceinline__ void p0_gu_item(const float* cp, int ld, const float* gk, const float* bk, bf16* WT, int n0, int kh, float* c1p, float* c2p, LAS float* scr, int lane) {
    float c1 = 0.f, c2 = 0.f;
    for (int kb = kh * 8; kb < kh * 8 + 8; ++kb) {
        const int k0 = 64 * kb;
        float v[32];
#pragma unroll
        for (int i = 0; i < 32; ++i) v[i] = __builtin_nontemporal_load(cp + (size_t)(k0 + 2 * i + (lane >> 5)) * ld);
#pragma unroll
        for (int i = 0; i < 32; ++i) { const int kk = 2 * i + (lane >> 5); const float w = v[i];
            const float r = bflo(pk2(w * gk[k0 + kk], 0.f)); c1 += r; c2 += bk[k0 + kk] * w; scr[kk * 33 + (lane & 31)] = r; }
        LDS_WAIT(); asm volatile("" ::: "memory");
        const int c = lane & 7;
#pragma unroll
        for (int j = 0; j < 4; ++j) { const int n = (lane >> 3) + 8 * j; const LAS float* sp = scr + (8 * c) * 33 + n;
            v4u o; o.x = pk2(sp[0 * 33], sp[1 * 33]); o.y = pk2(sp[2 * 33], sp[3 * 33]); o.z = pk2(sp[4 * 33], sp[5 * 33]); o.w = pk2(sp[6 * 33], sp[7 * 33]);
            __builtin_nontemporal_store(o, (v4u*)(WT + (size_t)(n0 + n) * D + k0 + 8 * c)); }
        LDS_WAIT(); asm volatile("" ::: "memory");
    }
    c1 += __shfl_xor(c1, 32); c2 += __shfl_xor(c2, 32);
    if (lane < 32) { c1p[n0 + lane] = c1; c2p[n0 + lane] = c2; }
}
__device__ __forceinline__ void p0_out8(unsigned char* WT8, int K, int k0, int n0, const LAS float* scr, int lane) {
    const int c = lane & 3;
#pragma unroll
    for (int j = 0; j < 2; ++j) { const int n = (lane >> 2) + 16 * j; const LAS float* sp = scr + (16 * c) * 33 + n;
        v4u o; o.x = pk4_fp8(sp[0 * 33], sp[1 * 33], sp[2 * 33], sp[3 * 33]); o.y = pk4_fp8(sp[4 * 33], sp[5 * 33], sp[6 * 33], sp[7 * 33]);
        o.z = pk4_fp8(sp[8 * 33], sp[9 * 33], sp[10 * 33], sp[11 * 33]); o.w = pk4_fp8(sp[12 * 33], sp[13 * 33], sp[14 * 33], sp[15 * 33]);
        __builtin_nontemporal_store(o, (v4u*)(WT8 + (size_t)(n0 + n) * K + k0 + 16 * c)); }
}
template <int KIND = 0>
__device__ __forceinline__ void p0_tr_item8(const float* cp, int ld, int K, unsigned char* WT8, int k0, int n0, LAS float* scr, int lane) {
    constexpr int kind = KIND;
    float v[32];
#pragma unroll
    for (int i = 0; i < 32; ++i) v[i] = __builtin_nontemporal_load(cp + (size_t)(k0 + cc_dim(2 * i + (lane >> 5), kind)) * ld);
#pragma unroll
    for (int i = 0; i < 32; ++i) scr[(2 * i + (lane >> 5)) * 33 + (lane & 31)] = v[i] * W8_SCALE;
    LDS_WAIT(); asm volatile("" ::: "memory");
    p0_out8(WT8, K, k0, n0, scr, lane);
    LDS_WAIT(); asm volatile("" ::: "memory");
}
__device__ __forceinline__ void p0_gu_item8(const float* cp, int ld, const float* gk, const float* bk, unsigned char* WT8, int n0, int kh, float* c1p, float* c2p, LAS float* scr, int lane) {
    float c1 = 0.f, c2 = 0.f;
    for (int kb = kh * 8; kb < kh * 8 + 8; ++kb) {
        const int k0 = 64 * kb;
        float v[32];
#pragma unroll
        for (int i = 0; i < 32; ++i) v[i] = __builtin_nontemporal_load(cp + (size_t)(k0 + 2 * i + (lane >> 5)) * ld);
#pragma unroll
        for (int i = 0; i < 32; ++i) { const int kk = 2 * i + (lane >> 5); const float w = v[i];
            const float r = fp8_rt(w * gk[k0 + kk] * W8_SCALE); c1 += r; c2 += bk[k0 + kk] * w; scr[kk * 33 + (lane & 31)] = r; }
        LDS_WAIT(); asm volatile("" ::: "memory");
        p0_out8(WT8, D, k0, n0, scr, lane);
        LDS_WAIT(); asm volatile("" ::: "memory");
    }
    c1 += __shfl_xor(c1, 32); c2 += __shfl_xor(c2, 32);
    if (lane < 32) { c1p[n0 + lane] = c1 * (1.0f / W8_SCALE); c2p[n0 + lane] = c2; }
}
template <int KIND>
__device__ __forceinline__ void p0_loadw(const float* base, int ld, int ks0, int lane, f32x4 (&v)[8]) {
#pragma unroll
    for (int i = 0; i < 8; ++i) v[i] = __builtin_nontemporal_load((const f32x4*)(base + (size_t)(ks0 + cc_dim(8 * i + (lane >> 3), KIND)) * ld + 4 * (lane & 7)));
}
template <int KIND = 0, bool SCALED = false>
__device__ __forceinline__ void p0_tr_itemw(const float* base, int ld, int K, bf16* WT, int k0, int n0, LAS float* scr, int lane, bool ntst = false, int ksrc0 = -1) {
    constexpr float scale = SCALED ? W8_SCALE : 1.0f;
    f32x4 v[8]; p0_loadw<KIND>(base, ld, ksrc0 < 0 ? k0 : ksrc0, lane, v);
#pragma unroll
    for (int i = 0; i < 8; ++i)
#pragma unroll
        for (int e = 0; e < 4; ++e) scr[(8 * i + (lane >> 3)) * 33 + 4 * (lane & 7) + e] = v[i][e] * scale;
    LDS_WAIT(); asm volatile("" ::: "memory");
    const int c = lane & 7;
#pragma unroll
    for (int j = 0; j < 4; ++j) { const int n = (lane >> 3) + 8 * j; const LAS float* s = scr + (8 * c) * 33 + n;
        v4u o; o.x = pk2(s[0 * 33], s[1 * 33]); o.y = pk2(s[2 * 33], s[3 * 33]); o.z = pk2(s[4 * 33], s[5 * 33]); o.w = pk2(s[6 * 33], s[7 * 33]);
        if (ntst) __builtin_nontemporal_store(o, (v4u*)(WT + (size_t)(n0 + n) * K + k0 + 8 * c)); else *(v4u*)(WT + (size_t)(n0 + n) * K + k0 + 8 * c) = o; }
    LDS_WAIT(); asm volatile("" ::: "memory");
}
template <int KIND = 0>
__device__ __forceinline__ void p0_tr_item8w(const float* base, int ld, int K, unsigned char* WT8, int k0, int n0, LAS float* scr, int lane) {
    f32x4 v[8]; p0_loadw<KIND>(base, ld, k0, lane, v);
#pragma unroll
    for (int i = 0; i < 8; ++i)
#pragma unroll
        for (int e = 0; e < 4; ++e) scr[(8 * i + (lane >> 3)) * 33 + 4 * (lane & 7) + e] = v[i][e] * W8_SCALE;
    LDS_WAIT(); asm volatile("" ::: "memory");
    p0_out8(WT8, K, k0, n0, scr, lane);
    LDS_WAIT(); asm volatile("" ::: "memory");
}
__device__ __forceinline__ void p0_gu_item8w(const float* base, int ld, const float* gk, const float* bk, unsigned char* WT8, int n0, int kh, float* c1p, float* c2p, LAS float* scr, int lane) {
    float c1[4] = {0.f, 0.f, 0.f, 0.f}, c2[4] = {0.f, 0.f, 0.f, 0.f};
    f32x4 v[8], vn[8]; p0_loadw<0>(base, ld, 64 * (kh * 8), lane, v);
#pragma unroll 1
    for (int kb = kh * 8; kb < kh * 8 + 8; ++kb) {
        const int k0 = 64 * kb;
        if (kb + 1 < kh * 8 + 8) p0_loadw<0>(base, ld, k0 + 64, lane, vn);
#pragma unroll
        for (int i = 0; i < 8; ++i) { const int kk = 8 * i + (lane >> 3); const float gg = gk[k0 + kk] * W8_SCALE, bb = bk[k0 + kk];
#pragma unroll
            for (int e = 0; e < 4; ++e) { const float w = v[i][e]; const float r = fp8_rt(w * gg); c1[e] += r; c2[e] += bb * w; scr[kk * 33 + 4 * (lane & 7) + e] = r; } }
        LDS_WAIT(); asm volatile("" ::: "memory");
        p0_out8(WT8, D, k0, n0, scr, lane);
        LDS_WAIT(); asm volatile("" ::: "memory");
#pragma unroll
        for (int i = 0; i < 8; ++i) v[i] = vn[i];
    }
#pragma unroll
    for (int e = 0; e < 4; ++e) {
        c1[e] += __shfl_xor(c1[e], 8); c1[e] += __shfl_xor(c1[e], 16); c1[e] += __shfl_xor(c1[e], 32);
        c2[e] += __shfl_xor(c2[e], 8); c2[e] += __shfl_xor(c2[e], 16); c2[e] += __shfl_xor(c2[e], 32); }
    if (lane < 8) {
        *(f32x4*)(c1p + n0 + 4 * lane) = (f32x4){c1[0], c1[1], c1[2], c1[3]} * (1.0f / W8_SCALE);
        *(f32x4*)(c2p + n0 + 4 * lane) = (f32x4){c2[0], c2[1], c2[2], c2[3]}; }
}
struct Ptrs {
    const float *x, *w_in, *w_out, *lg, *lb, *wsp, *bsp, *pw, *psc, *ln1g, *ln1b, *rw, *rb, *wg, *wu, *wd, *ln2g, *ln2b;
    float* out; unsigned char* ws;
};
struct P0Item { const float* base; unsigned char* dst8; int ld, ks0, kind, K, k0, n0; float scale; bool f8, ntst, rope; };
__device__ __forceinline__ void p0_loadw_rt(const float* base, int ld, int ks0, int kind, int lane, f32x4 (&v)[8]) {
#pragma unroll
    for (int i = 0; i < 8; ++i) v[i] = __builtin_nontemporal_load((const f32x4*)(base + (size_t)(ks0 + cc_dim(8 * i + (lane >> 3), kind)) * ld + 4 * (lane & 7)));
}
__device__ __forceinline__ P0Item p0_decode(const Ptrs& P, int l, int it, int lane) {
    constexpr int I_IN = 16 * 72, I_OUT = 16 * 32, I_DN = 8 * 32;
    P0Item d; d.kind = 0; d.scale = W8_SCALE; d.f8 = true; d.ntst = false; d.rope = false;
    int r = it;
    if (r < I_IN) { const int kb = r / 72, nb = r % 72; d.ld = NCOL; d.k0 = 64 * kb; d.ks0 = 64 * kb; d.K = D;
        if (nb < 32 && (nb & 1) == 0) { d.rope = true; d.base = P.w_in + (size_t)l * D * NCOL + win_src_col(32 * nb + (lane & 31)); d.dst8 = P.ws + WS_WIN8 + (size_t)l * 1536 * D; d.n0 = 32 * nb; return d; }
        d.base = P.w_in + (size_t)l * D * NCOL + win_src_col(32 * nb);
        if (nb < 48) { d.dst8 = P.ws + WS_WIN8 + (size_t)l * 1536 * D; d.n0 = 32 * nb; }
        else { d.f8 = false; d.scale = 1.0f; d.dst8 = P.ws + WS_WINB + (size_t)l * 768 * D * 2; d.n0 = 32 * (nb - 48); d.ntst = (l != 0); }
        return d; }
    r -= I_IN;
    if (r < I_OUT) { const int kb = r / 32, nb = r % 32; d.ld = D; d.base = P.w_out + (size_t)l * D * D + 32 * nb; d.n0 = 32 * nb; d.ks0 = 64 * kb;
        unsigned char* wo = P.ws + WS_WOUT + (size_t)l * D * CCB;
        if (kb < 8) { d.kind = 1; d.K = CCB; d.dst8 = wo; d.k0 = 64 * kb; }
        else { d.f8 = false; d.kind = kb < 12 ? 2 : 1; d.K = CCB / 2; d.dst8 = wo + 512; d.k0 = 64 * (kb - 8); d.ntst = true; }
        return d; }
    r -= I_OUT;
    { const int e = r / I_DN; r -= e * I_DN; const int le = l * 16 + e, kb = r / 32, nb = r % 32;
      const int nn = 32 * nb;
      d.ld = D; d.base = P.wd + (size_t)le * FF * D + 128 * (nn >> 8) + 512 * ((nn >> 7) & 1) + (nn & 127); d.K = FF; d.dst8 = P.ws + WS_WDN + (size_t)le * D * FF; d.k0 = 64 * kb; d.ks0 = 64 * kb; d.n0 = 32 * nb; }
    return d;
}
__device__ __forceinline__ void p0_weights(const Ptrs& P, int l, LAS unsigned char* lds, int wave, int lane, int widx, int nw) {
    LAS float* scr = (LAS float*)(lds + wave * 16384);
    bf16* WOUT = (bf16*)(P.ws + WS_WOUT); unsigned char* WGU = P.ws + WS_WGU; unsigned char* WDN = P.ws + WS_WDN;
    constexpr int I_IN = 16 * 72, I_OUT = 16 * 32, I_GU = 2 * 32, I_DN = 8 * 32, N_HEAVY = 16 * I_GU, N_LIGHT = I_IN + I_OUT + 16 * I_DN;
    const int nh = nw < N_HEAVY ? nw : N_HEAVY;
    if (widx < nh) {
        for (int r0 = widx; r0 < N_HEAVY; r0 += nh) { int r = r0; const int e = r / I_GU; r -= e * I_GU; const int le = l * 16 + e, kh = r / 32, nb = r % 32;
            const int n = 32 * nb, pn = n >> 8, t = n & 255;
            const float* cp = (t < 128 ? P.wg : P.wu) + (size_t)le * D * FF + 128 * pn + (t & 127);
            p0_gu_item8w(cp, FF, P.ln1g + l * D, P.ln1b + l * D, WGU + (size_t)le * 1024 * D, 32 * nb, kh,
                       (float*)(P.ws + WS_C1P) + ((size_t)kh * 32 + le) * 1024, (float*)(P.ws + WS_C2P) + ((size_t)kh * 32 + le) * 1024, scr, lane); }
    }
    const int lw0 = nw > N_HEAVY ? N_HEAVY : 0, nlw = nw - lw0;
    if (widx >= lw0) {
        P0Item cur, nx; f32x4 v[8], vn[8];
        int it = widx - lw0;
        bool have = it < N_LIGHT;
        if (have) { cur = p0_decode(P, l, it, lane); if (!cur.rope) p0_loadw_rt(cur.base, cur.ld, cur.ks0, cur.kind, lane, v); }
#pragma unroll 1
        while (have) {
            const int itn = it + nlw; const bool hn = itn < N_LIGHT;
            if (hn) { nx = p0_decode(P, l, itn, lane); if (!nx.rope) p0_loadw_rt(nx.base, nx.ld, nx.ks0, nx.kind, lane, vn); }
            if (cur.rope) p0_tr_item8(cur.base, cur.ld, cur.K, cur.dst8, cur.k0, cur.n0, scr, lane);
            else {
#pragma unroll
                for (int i = 0; i < 8; ++i)
#pragma unroll
                    for (int e = 0; e < 4; ++e) scr[(8 * i + (lane >> 3)) * 33 + 4 * (lane & 7) + e] = v[i][e] * cur.scale;
                LDS_WAIT(); asm volatile("" ::: "memory");
                if (cur.f8) p0_out8(cur.dst8, cur.K, cur.k0, cur.n0, scr, lane);
                else { const int c = lane & 7;
#pragma unroll
                    for (int j = 0; j < 4; ++j) { const int n = (lane >> 3) + 8 * j; const LAS float* sp = scr + (8 * c) * 33 + n;
                        v4u o; o.x = pk2(sp[0 * 33], sp[1 * 33]); o.y = pk2(sp[2 * 33], sp[3 * 33]); o.z = pk2(sp[4 * 33], sp[5 * 33]); o.w = pk2(sp[6 * 33], sp[7 * 33]);
                        bf16* dp = (bf16*)cur.dst8 + (size_t)(cur.n0 + n) * cur.K + cur.k0 + 8 * c;
                        if (cur.ntst) __builtin_nontemporal_store(o, (v4u*)dp); else *(v4u*)dp = o; } }
                LDS_WAIT(); asm volatile("" ::: "memory");
            }
#pragma unroll
            for (int i = 0; i < 8; ++i) v[i] = vn[i];
            cur = nx; it = itn; have = hn;
        }
    }
}
__device__ __forceinline__ void p0_prologue(const Ptrs& P, LAS unsigned char* lds, int vcu, int G, int wave, int lane, int tid) {
    const int gw = vcu * NWAVES + wave, NGW = G * NWAVES;
    for (int rep_ = 0; rep_ < ((MK_REPEAT == 31) ? 2 : 1); ++rep_) {
    p0_weights(P, 0, lds, wave, lane, gw, NGW);
    p0_weights(P, 1, lds, wave, lane, (gw + NGW / 2) % NGW, NGW);
    }
    bf16* XB = (bf16*)(P.ws + WS_HB);
    {
        const size_t step = (size_t)NGW * 64 * 8, iend = (size_t)T * D / 8;
        const bool odd = lane & 1;
        const size_t eo = odd ? 256 + 4 * (lane - 1) : 4 * lane;
        f32x4 a[8], b[8], an[8], bn[8];
        size_t i0 = (size_t)gw * 64 + lane;
        if (i0 < iend) { const size_t seg0 = (i0 - lane) * 8;
#pragma unroll
            for (int u = 0; u < 8; ++u) { const size_t sg = seg0 + (size_t)u * NGW * 512; a[u] = __builtin_nontemporal_load((const f32x4*)(P.x + sg + 4 * lane)); b[u] = __builtin_nontemporal_load((const f32x4*)(P.x + sg + 256 + 4 * lane)); } }
#pragma unroll 1
        for (; i0 < iend; i0 += step) {
            const size_t seg0 = (i0 - lane) * 8;
            if (i0 + step < iend) { const size_t sn = seg0 + step * 8;
#pragma unroll
                for (int u = 0; u < 8; ++u) { const size_t sg = sn + (size_t)u * NGW * 512; an[u] = __builtin_nontemporal_load((const f32x4*)(P.x + sg + 4 * lane)); bn[u] = __builtin_nontemporal_load((const f32x4*)(P.x + sg + 256 + 4 * lane)); } }
#pragma unroll
            for (int u = 0; u < 8; ++u) { const size_t e = seg0 + (size_t)u * NGW * 512 + eo;
                f32x4 lo, hi;
#pragma unroll
                for (int k = 0; k < 4; ++k) { const float snd = odd ? a[u][k] : b[u][k];
                    const float rcv = __builtin_bit_cast(float, __builtin_amdgcn_mov_dpp(__builtin_bit_cast(int, snd), 0xB1, 0xf, 0xf, true));
                    lo[k] = odd ? rcv : a[u][k]; hi[k] = odd ? b[u][k] : rcv; }
                v4u w; w.x = pk2(lo[0], lo[1]); w.y = pk2(lo[2], lo[3]); w.z = pk2(hi[0], hi[1]); w.w = pk2(hi[2], hi[3]);
                *(v4u*)(XB + e) = w;
                v2u w8; w8.x = pk4_fp8(lo[0], lo[1], lo[2], lo[3]); w8.y = pk4_fp8(hi[0], hi[1], hi[2], hi[3]); *(v2u*)(P.ws + WS_XB8 + e) = w8; }
#pragma unroll
            for (int u = 0; u < 8; ++u) { a[u] = an[u]; b[u] = bn[u]; }
        }
    }
    const int gt = vcu * NTHREADS + tid, NGT = G * NTHREADS;
    bf16* WPT = (bf16*)(P.ws + WS_WPT);
    for (int i = gt; i < 2 * 4 * 64 * 64; i += NGT) { const int ii = i & 63, o = (i >> 6) & 63, lgi = i >> 12;
        WPT[i] = (bf16)(pk2(P.pw[((size_t)lgi * 64 + ii) * 64 + o], 0.f) & 0xffffu); }
    bf16* WST = (bf16*)(P.ws + WS_WST);
    for (int i = gt; i < 2 * 4 * 128 * 128; i += NGT) WST[i] = (bf16)(pk2(P.wsp[i], 0.f) & 0xffffu);
    v4u* RWB = (v4u*)(P.ws + WS_RWQ);
    for (int i = gt; i < 2 * 32 * 3 * 64; i += NGT) { const int ln = i & 63, rest = i >> 6, term = rest % 3, j = (rest / 3) & 31, l = rest / 96; const int e = ln & 15, q = ln >> 4;
        unsigned w[4];
#pragma unroll
        for (int p = 0; p < 4; ++p) { unsigned hb[2];
#pragma unroll
            for (int h = 0; h < 2; ++h) { const int k = 32 * j + 8 * q + 2 * p + h; const float v = P.ln1g[l * D + k] * P.rw[(size_t)k * 16 + e];
                const unsigned b0 = pk2(v, 0.f) & 0xffffu; const float r1 = v - bflo(b0); const unsigned b1 = pk2(r1, 0.f) & 0xffffu; const float r2 = r1 - bflo(b1); const unsigned b2 = pk2(r2, 0.f) & 0xffffu;
                hb[h] = term == 0 ? b0 : (term == 1 ? b1 : b2); }
            w[p] = hb[0] | (hb[1] << 16); }
        RWB[i] = (v4u){w[0], w[1], w[2], w[3]}; }
    float* CR = (float*)(P.ws + WS_CR);
    if (gw < 32) { const int l = gw >> 4, e = gw & 15; float a = 0.f, b = 0.f;
        for (int j = 0; j < 16; ++j) { const int k = lane + 64 * j; const float w = P.rw[(size_t)k * 16 + e]; a += P.ln1g[l * D + k] * w; b += P.ln1b[l * D + k] * w; }
        a = wave_sum(a); b = wave_sum(b);
        if (lane == 0) { CR[l * 32 + e] = a; CR[l * 32 + 16 + e] = b; } }
}

#ifdef MK_PROBE
#ifndef MK_PSCALE
#define MK_PSCALE 2e-6f
#endif
#define PROBE_DECL() unsigned long long pt_ = 0; unsigned pacc_ = 0
#define PROBE_T0(id) do { if (MK_PROBE == (id)) pt_ = __builtin_amdgcn_s_memrealtime(); } while (0)
#define PROBE_T1(id) do { if (MK_PROBE == (id)) pacc_ += (unsigned)(__builtin_amdgcn_s_memrealtime() - pt_); } while (0)
#define PROBE_END(ws, cond) do { if (cond) atomicAdd((unsigned*)((ws) + WS_CTL) + 32, pacc_); } while (0)
#else
#define PROBE_DECL() do {} while (0)
#define PROBE_T0(id) do {} while (0)
#define PROBE_T1(id) do {} while (0)
#define PROBE_END(ws, cond) do {} while (0)
#endif
constexpr int KT_STRIDE = 144, VT_STRIDE = 192;
constexpr int ATT_WAVE_LDS = 32 * KT_STRIDE + 32 * VT_STRIDE;
using pg8::v8i_t; using pg8::v4i_t;
constexpr float ASCL = LOG2E * 0.125f;
#define MFMA32(a, b, c) __builtin_amdgcn_mfma_f32_32x32x16_bf16((a), (b), (c), 0, 0, 0)
__device__ __forceinline__ s16x4 tr16(LAS unsigned char* p) { return __builtin_amdgcn_ds_read_tr16_b64_v4i16((LAS s16x4*)p); }

constexpr int VT_ROW = 128, KT_ROW = 64, KT_OFF = 0, VTL_OFF = 65536;
struct AttItem { int dsh, r, j0, rbase; };
__device__ __forceinline__ AttItem att_item(int it, int sp, int wave) {
    AttItem a;
    if (it < 4)      { a.dsh = 0; a.r = 0;      const int js = 1024 * sp + 256 * it; a.j0 = js + 32 * wave; a.rbase = 64 - js; }
    else if (it < 8) { a.dsh = 2; a.r = it - 4; const int js = 256 * sp;             a.j0 = js + 32 * wave; a.rbase = 64 - js; }
    else             { a.dsh = 4; a.r = 4 * (it - 8) + (wave >> 1); a.j0 = 64 * sp + 32 * (wave & 1); a.rbase = 128 * (wave >> 1); }
    return a;
}
template <int RB>
__device__ __forceinline__ const unsigned char* att_src(const unsigned char* Xb, int it, int sp, size_t brow, int h, int rho, int ch) {
    if (it < 8) {
        const int dsh = it < 4 ? 0 : 2, r = it < 4 ? 0 : it - 4, js = it < 4 ? 1024 * sp + 256 * it : 256 * sp;
        int j = js - 64 + rho; j = j < 0 ? 0 : j; const int L = S >> dsh; j = j >= L ? L - 1 : j;
        return Xb + (brow + ((size_t)j << dsh) + r) * RB + h * (RB / 8) + ch * 16;
    }
    const int sl = (rho >> 7) & 3, j = rho & 127, r = 4 * (it - 8) + sl;
    return Xb + (brow + (size_t)j * 16 + r) * RB + h * (RB / 8) + ch * 16;
}
template <bool KSW>
__device__ __forceinline__ void att_fill(const unsigned char* Xb, int it, int sp, size_t brow, int h, LAS unsigned char* tile, int wave, int lane) {
    const int n = KSW ? (it < 8 ? 3 : 4) : (it < 8 ? 6 : 8);
    for (int k = 0; k < n; ++k) {
        const int ins = wave + 8 * k;
        const int rho = KSW ? 16 * ins + (lane >> 2) : 8 * ins + (lane >> 3);
        const int ch = KSW ? ((lane & 3) ^ ((rho >> 2) & 3)) : ((lane & 7) ^ (((rho >> 1) & 1) << 2));
        const unsigned char* src = KSW ? att_src<512>(Xb, it, sp, brow, h, rho, ch) : att_src<1024>(Xb, it, sp, brow, h, rho, ch);
        { unsigned keep_; const unsigned dst_ = (unsigned)(size_t)(tile + ins * 1024);
          asm volatile("s_mov_b32 %0, m0\n\ts_mov_b32 m0, %2\n\ts_nop 0\n\tglobal_load_lds_dwordx4 %1, off\n\ts_mov_b32 m0, %0" : "=&s"(keep_) : "v"(src), "s"(__builtin_amdgcn_readfirstlane(dst_)) : "memory"); }
    }
}
__device__ __forceinline__ void attn_scores(const v8i_t& qf, const AttItem& a, const LAS unsigned char* kt, int lane, f32x16 (&st)[5], int& kb_lo, int& kb_hi) {
    const int L = S >> a.dsh;
    const int qi = lane & 31, hh = lane >> 5;
    kb_lo = 2 - (a.j0 >> 5); if (kb_lo < 0) kb_lo = 0;
    kb_hi = ((L - a.j0) >> 5) + 1; if (kb_hi > 4) kb_hi = 4;
    const int row0 = a.rbase + a.j0 - 64 + qi;
    const int sw = (qi >> 2) & 3;
    f32x16 zero;
#pragma unroll
    for (int i = 0; i < 16; ++i) zero[i] = 0.f;
#pragma unroll
    for (int kb = 0; kb < 5; ++kb) {
        const int kbc = kb < kb_lo ? kb_lo : (kb > kb_hi ? kb_hi : kb);
        const LAS unsigned char* kr = kt + (row0 + 32 * kbc) * KT_ROW;
        const v4i_t k0 = *(const LAS v4i_t*)(kr + (((2 * hh) ^ sw) << 4)), k1 = *(const LAS v4i_t*)(kr + (((2 * hh + 1) ^ sw) << 4));
        const v8i_t kf = __builtin_shufflevector(k0, k1, 0, 1, 2, 3, 4, 5, 6, 7);
        st[kb] = __builtin_amdgcn_mfma_scale_f32_32x32x64_f8f6f4(kf, qf, zero, 0, 0, 0, 0x7f7f7f7f, 0, 0x7f7f7f7f);
    }
}
struct AttPart { v4u a[2], b[2]; float la, lb; };
constexpr float PO8_SCALE = 16.0f;
__device__ __forceinline__ float f8at(unsigned w, int e) { return e == 0 ? __builtin_amdgcn_cvt_f32_fp8((int)w, 0) : e == 1 ? __builtin_amdgcn_cvt_f32_fp8((int)w, 1) : e == 2 ? __builtin_amdgcn_cvt_f32_fp8((int)w, 2) : __builtin_amdgcn_cvt_f32_fp8((int)w, 3); }
__device__ __forceinline__ void attn_softmax_pv(f32x16 (&st)[5], const AttItem& a, int kb_lo, int kb_hi, const LAS unsigned char* vt, int lane,
                                                f32x16& o0, f32x16& o1, float& l_out, float& mxs_out) {
    const int qi = lane & 31, hh = lane >> 5;
    float mx = -1e30f;
#pragma unroll
    for (int kb = 0; kb < 5; ++kb) {
        const bool valid = kb >= kb_lo && kb <= kb_hi;
#pragma unroll
        for (int i = 0; i < 16; ++i) { float sv = st[kb][i]; const int kl = crow(i, hh);
            if (kb == 0 && kl < qi) sv = -1e30f;
            if (kb == 4 && kl > qi) sv = -1e30f;
            sv = valid ? sv : -1e30f;
            st[kb][i] = sv; mx = fmaxf(mx, sv); }
    }
    mx = fmaxf(mx, __shfl_xor(mx, 32));
    const float mxs = mx * ASCL;
    float l = 0.f;
    bf16x8 pf[5][2];
#pragma unroll
    for (int kb = 0; kb < 5; ++kb) {
#pragma unroll
        for (int i = 0; i < 16; ++i) { const float pe = fast_exp2(st[kb][i] * ASCL - mxs); l += pe; st[kb][i] = pe; }
#pragma unroll
        for (int sx = 0; sx < 2; ++sx) { v4u w; w.x = pk2(st[kb][8 * sx], st[kb][8 * sx + 1]); w.y = pk2(st[kb][8 * sx + 2], st[kb][8 * sx + 3]); w.z = pk2(st[kb][8 * sx + 4], st[kb][8 * sx + 5]); w.w = pk2(st[kb][8 * sx + 6], st[kb][8 * sx + 7]);
            pf[kb][sx] = __builtin_bit_cast(bf16x8, w); }
    }
#pragma unroll
    for (int i = 0; i < 16; ++i) { o0[i] = 0.f; o1[i] = 0.f; }
    const int q4 = (lane & 15) >> 2, p4 = lane & 3, blk = (lane >> 4) & 1, sw = (q4 >> 1) & 1;
    const LAS unsigned char* vrow = vt + (a.rbase + a.j0 - 64 + 4 * hh + q4) * VT_ROW + 32 * blk + 8 * p4;
    const int c0 = sw ? 64 : 0, c1 = sw ? 0 : 64;
#pragma unroll
    for (int kb = 0; kb < 5; ++kb) {
        const int kbc = kb < kb_lo ? kb_lo : (kb > kb_hi ? kb_hi : kb);
        LAS unsigned char* vr = (LAS unsigned char*)vrow + (32 * kbc) * VT_ROW;
#pragma unroll
        for (int sx = 0; sx < 2; ++sx) {
            { const s16x4 lo = tr16(vr + (16 * sx) * VT_ROW + c0), hi = tr16(vr + (16 * sx + 8) * VT_ROW + c0);
              const bf16x8 vf = __builtin_shufflevector(lo, hi, 0, 1, 2, 3, 4, 5, 6, 7); o0 = MFMA32(vf, pf[kb][sx], o0); }
            { const s16x4 lo = tr16(vr + (16 * sx) * VT_ROW + c1), hi = tr16(vr + (16 * sx + 8) * VT_ROW + c1);
              const bf16x8 vf = __builtin_shufflevector(lo, hi, 0, 1, 2, 3, 4, 5, 6, 7); o1 = MFMA32(vf, pf[kb][sx], o1); }
        }
    }
    l += __shfl_xor(l, 32);
    l_out = l; mxs_out = mxs;
}
__device__ __forceinline__ void attn_store(unsigned char* __restrict__ POc, float* __restrict__ LSEc, const f32x16& o0, const f32x16& o1, float l, float mxs, int b, int h, const AttItem& a, int lane) {
    const int qi = lane & 31, hh = lane >> 5;
    const size_t qrow = (size_t)b * S + ((size_t)(a.j0 + qi) << a.dsh) + a.r;
    const float inv = PO8_SCALE / l;
    unsigned char* op = POc + qrow * 512 + h * 64 + 32 * hh;
    v4u w0, w1;
    w0.x = pk4_fp8(o0[0] * inv, o0[1] * inv, o0[2] * inv, o0[3] * inv);     w0.y = pk4_fp8(o0[4] * inv, o0[5] * inv, o0[6] * inv, o0[7] * inv);
    w0.z = pk4_fp8(o0[8] * inv, o0[9] * inv, o0[10] * inv, o0[11] * inv);   w0.w = pk4_fp8(o0[12] * inv, o0[13] * inv, o0[14] * inv, o0[15] * inv);
    w1.x = pk4_fp8(o1[0] * inv, o1[1] * inv, o1[2] * inv, o1[3] * inv);     w1.y = pk4_fp8(o1[4] * inv, o1[5] * inv, o1[6] * inv, o1[7] * inv);
    w1.z = pk4_fp8(o1[8] * inv, o1[9] * inv, o1[10] * inv, o1[11] * inv);   w1.w = pk4_fp8(o1[12] * inv, o1[13] * inv, o1[14] * inv, o1[15] * inv);
    *(v4u*)op = w0; *(v4u*)(op + 16) = w1;
    if (hh == 0) LSEc[qrow * 8 + h] = mxs + __log2f(l);
}

__device__ __forceinline__ void attn_load_part(AttPart& part, const unsigned char* __restrict__ PO, const float* __restrict__ LSE, int b, int h, const AttItem& a, int lane) {
    const int qi = lane & 31, hh = lane >> 5;
    const size_t qrow = (size_t)b * S + ((size_t)(a.j0 + qi) << a.dsh) + a.r;
    const unsigned char* po0 = PO + qrow * 512 + h * 64 + 32 * hh; const unsigned char* po1 = po0 + (size_t)T * 512;
    const float* l0 = LSE + qrow * 8 + h; const float* l1 = l0 + (size_t)T * 8;
    asm volatile("global_load_dwordx4 %0, %1, off" : "=v"(part.a[0]) : "v"(po0) : "memory");
    asm volatile("global_load_dwordx4 %0, %1, off offset:16" : "=v"(part.a[1]) : "v"(po0) : "memory");
    asm volatile("global_load_dwordx4 %0, %1, off" : "=v"(part.b[0]) : "v"(po1) : "memory");
    asm volatile("global_load_dwordx4 %0, %1, off offset:16" : "=v"(part.b[1]) : "v"(po1) : "memory");
    asm volatile("global_load_dword %0, %1, off" : "=v"(part.la) : "v"(l0) : "memory");
    asm volatile("global_load_dword %0, %1, off" : "=v"(part.lb) : "v"(l1) : "memory");
}
__device__ __forceinline__ void attn_store_fused(unsigned char* __restrict__ CC, const AttPart& part, const f32x16& o0, const f32x16& o1, float l, float mxs, int b, int h, const AttItem& a, int lane) {
    const int qi = lane & 31, hh = lane >> 5;
    const size_t qrow = (size_t)b * S + ((size_t)(a.j0 + qi) << a.dsh) + a.r;
    const float l2 = mxs + __log2f(l);
    const float mx = fmaxf(part.la, fmaxf(part.lb, l2));
    float w0 = fast_exp2(part.la - mx), w1 = fast_exp2(part.lb - mx), w2 = fast_exp2(l2 - mx);
    const float inv = 1.0f / (w0 + w1 + w2); w0 *= inv * (CC_SCALE / PO8_SCALE); w1 *= inv * (CC_SCALE / PO8_SCALE); w2 *= inv * CC_SCALE / l;
    unsigned char* op = CC + qrow * CCB + h * 64 + 32 * hh;
    unsigned wlo[4], whi[4];
#pragma unroll
    for (int g4 = 0; g4 < 4; ++g4) {
        { const unsigned pa = part.a[0][g4], pb = part.b[0][g4];
          wlo[g4] = pk4_fp8(w0 * f8at(pa, 0) + w1 * f8at(pb, 0) + w2 * o0[4 * g4], w0 * f8at(pa, 1) + w1 * f8at(pb, 1) + w2 * o0[4 * g4 + 1],
                            w0 * f8at(pa, 2) + w1 * f8at(pb, 2) + w2 * o0[4 * g4 + 2], w0 * f8at(pa, 3) + w1 * f8at(pb, 3) + w2 * o0[4 * g4 + 3]); }
        { const unsigned pa = part.a[1][g4], pb = part.b[1][g4];
          whi[g4] = pk4_fp8(w0 * f8at(pa, 0) + w1 * f8at(pb, 0) + w2 * o1[4 * g4], w0 * f8at(pa, 1) + w1 * f8at(pb, 1) + w2 * o1[4 * g4 + 1],
                            w0 * f8at(pa, 2) + w1 * f8at(pb, 2) + w2 * o1[4 * g4 + 2], w0 * f8at(pa, 3) + w1 * f8at(pb, 3) + w2 * o1[4 * g4 + 3]); }
    }
    *(v4u*)op = (v4u){wlo[0], wlo[1], wlo[2], wlo[3]}; *(v4u*)(op + 16) = (v4u){whi[0], whi[1], whi[2], whi[3]};
}

__device__ __forceinline__ void p2_attention(const unsigned char* ws, unsigned char* wsw, LAS unsigned char* lds, int vcu, int G, int wave, int lane_in, int tid) {
    const unsigned char* Qb = ws + WS_Q; const unsigned char* Kb = ws + WS_K; const unsigned char* Vb = ws + WS_V;
    unsigned char* PO = wsw + WS_PO; float* LSE = (float*)(wsw + WS_LSE); unsigned char* CC = wsw + WS_CC;
    LAS unsigned char* ktile = lds + KT_OFF; LAS unsigned char* vtile = lds + VTL_OFF;
    PROBE_DECL(); PROBE_T0(1);
    for (int item = vcu; item < NB * 8 * 2; item += G) {
        const int sp = item & 1, h = (item >> 1) & 7, b = item >> 4;
        const size_t brow = (size_t)b * S;
        v4i_t qn[2];
#pragma unroll 1
        for (int it = -1; it < 12; ++it) {
            int lane = lane_in; asm volatile("" : "+v"(lane));
            const int qi = lane & 31, hh = lane >> 5;
            f32x16 st[5]; int kb_lo = 0, kb_hi = 4; AttPart part;
            AttItem a = att_item(it < 0 ? 0 : it, sp, wave);
            const int c = it >> 2;
            if (it >= 0) {
                PROBE_T0(2);
                if (it < 8) asm volatile("s_waitcnt vmcnt(6)" ::: "memory"); else asm volatile("s_waitcnt vmcnt(8)" ::: "memory");
                PROBE_T1(2); PROBE_T0(6);
                __builtin_amdgcn_s_barrier(); asm volatile("" ::: "memory");
                PROBE_T1(6);
                asm volatile("" : "+v"(qn[0]), "+v"(qn[1]));
                const v8i_t qf = __builtin_shufflevector(qn[0], qn[1], 0, 1, 2, 3, 4, 5, 6, 7);
                if (c == 2) attn_load_part(part, PO, LSE, b, h, a, lane);
                PROBE_T0(3);
                attn_scores(qf, a, ktile, lane, st, kb_lo, kb_hi);
                if (c == 2) asm volatile("s_waitcnt vmcnt(6) lgkmcnt(0)" ::: "memory"); else asm volatile("s_waitcnt vmcnt(0) lgkmcnt(0)" ::: "memory");
                __builtin_amdgcn_s_barrier(); asm volatile("" ::: "memory");
            }
            if (it < 11) {
                att_fill<true>(Kb, it + 1, sp, brow, h, ktile, wave, lane);
                const AttItem an = att_item(it + 1, sp, wave); const unsigned char* qp = Qb + (brow + ((size_t)(an.j0 + qi) << an.dsh) + an.r) * 512 + h * 64 + 32 * hh;
#pragma unroll
                for (int ks = 0; ks < 2; ++ks) asm volatile("global_load_dwordx4 %0, %1, off" : "=v"(qn[ks]) : "v"(qp + 16 * ks) : "memory");
            }
            if (it >= 0) {
                f32x16 o0, o1; float lsum, mxs;
                attn_softmax_pv(st, a, kb_lo, kb_hi, vtile, lane, o0, o1, lsum, mxs);
                PROBE_T1(3); PROBE_T0(4);
                asm volatile("s_waitcnt lgkmcnt(0)" ::: "memory");
                __builtin_amdgcn_s_barrier(); asm volatile("" ::: "memory");
                if (c == 2) {
                    if (it == 11) asm volatile("s_waitcnt vmcnt(0)" ::: "memory"); else asm volatile("s_waitcnt vmcnt(6)" ::: "memory");
                    asm volatile("" : "+v"(part.a[0]), "+v"(part.a[1]), "+v"(part.b[0]), "+v"(part.b[1]), "+v"(part.la), "+v"(part.lb));
                    attn_store_fused(CC, part, o0, o1, lsum, mxs, b, h, a, lane); }
                else attn_store(PO + (size_t)c * T * 512, LSE + (size_t)c * T * 8, o0, o1, lsum, mxs, b, h, a, lane);
                asm volatile("" ::: "memory");
            }
            if (it < 11) att_fill<false>(Vb, it + 1, sp, brow, h, vtile, wave, lane);
            PROBE_T1(4);
        }
        PROBE_T0(5);
        asm volatile("s_waitcnt vmcnt(0)" ::: "memory");
        __syncthreads();
        PROBE_T1(5);
    }
    PROBE_T1(1);
    PROBE_END(ws, vcu == 0 && tid == 0);
}
__device__ __forceinline__ void p2_gmlp(const Ptrs& P, int l, LAS unsigned char* lds, int vcu, int G, int wave, int lane, int tid) {
    const bf16* Gb = (const bf16*)(P.ws + WS_G); const bf16* Ub = (const bf16*)(P.ws + WS_U); unsigned char* CC = P.ws + WS_CC;
    const bf16* WST = (const bf16*)(P.ws + WS_WST) + (size_t)l * 4 * 128 * 128;
    const float* bs = P.bsp + l * 4 * 128;
    const int hh = lane >> 5, q4 = (lane & 15) >> 2, p4 = lane & 3, blk = (lane >> 4) & 1;
    const int pb = wave & 3, db = wave >> 2;
    const int p = 32 * pb + (lane & 31);
    constexpr int GT_BYTES = 128 * VT_STRIDE;
    v4u treg[2]; v2u uun[4];
    if (vcu < NB * 16 * 4) { const int g = vcu & 3, cch = (vcu >> 2) & 15, b = vcu >> 6; const size_t row0 = (size_t)b * S + cch * 128;
#pragma unroll
        for (int i = 0; i < 2; ++i) { const int idx = tid + NTHREADS * i; treg[i] = *(const v4u*)(Gb + (row0 + (idx >> 3)) * 256 + g * 64 + (idx & 7) * 8); }
#pragma unroll
        for (int g4 = 0; g4 < 4; ++g4) uun[g4] = *(const v2u*)(Ub + (row0 + p) * 256 + g * 64 + 32 * db + 8 * g4 + 4 * hh); }
    bf16x8 wf[8]; float bsv = 0.f; int gcur = -1, par = 0;
    for (int item = vcu; item < NB * 16 * 4; item += G, par ^= 1) {
        const int g = item & 3, cch = (item >> 2) & 15, b = item >> 6;
        const size_t row0 = (size_t)b * S + cch * 128;
        LAS unsigned char* tl = lds + par * GT_BYTES;
#pragma unroll
        for (int i = 0; i < 2; ++i) { const int idx = tid + NTHREADS * i; *(LAS v4u*)(tl + (idx >> 3) * VT_STRIDE + (idx & 7) * 16) = treg[i]; }
        v2u uu[4];
#pragma unroll
        for (int g4 = 0; g4 < 4; ++g4) uu[g4] = uun[g4];
        asm volatile("s_waitcnt lgkmcnt(0)" ::: "memory"); __builtin_amdgcn_s_barrier(); asm volatile("" ::: "memory");
        if (g != gcur) { gcur = g;
            const bf16* wp = WST + ((size_t)g * 128 + p) * 128 + 8 * hh;
#pragma unroll
            for (int s8 = 0; s8 < 8; ++s8) wf[s8] = *(const bf16x8*)(wp + 16 * s8);
            bsv = bs[g * 128 + p]; }
        if (item + G < NB * 16 * 4) { const int it2 = item + G, g2 = it2 & 3, c2 = (it2 >> 2) & 15, b2 = it2 >> 6; const size_t rown = (size_t)b2 * S + c2 * 128;
#pragma unroll
            for (int i = 0; i < 2; ++i) { const int idx = tid + NTHREADS * i; treg[i] = *(const v4u*)(Gb + (rown + (idx >> 3)) * 256 + g2 * 64 + (idx & 7) * 8); }
#pragma unroll
            for (int g4 = 0; g4 < 4; ++g4) uun[g4] = *(const v2u*)(Ub + (rown + p) * 256 + g2 * 64 + 32 * db + 8 * g4 + 4 * hh); }
        f32x16 acc;
#pragma unroll
        for (int i = 0; i < 16; ++i) acc[i] = 0.f;
        LAS unsigned char* vrd = tl + (8 * hh + q4) * VT_STRIDE + (32 * db + 16 * blk + 4 * p4) * 2;
#pragma unroll
        for (int s8 = 0; s8 < 8; ++s8) {
            const s16x4 lo = tr16(vrd + (16 * s8) * VT_STRIDE), hi = tr16(vrd + (16 * s8 + 4) * VT_STRIDE);
            const bf16x8 vf = __builtin_shufflevector(lo, hi, 0, 1, 2, 3, 4, 5, 6, 7);
            acc = MFMA32(vf, wf[s8], acc);
        }
        { unsigned w[8];
#pragma unroll
          for (int g4 = 0; g4 < 4; ++g4) { w[2 * g4] = pk2(CC_SCALE * bflo(uu[g4].x) * (acc[4 * g4] + bsv), CC_SCALE * bfhi(uu[g4].x) * (acc[4 * g4 + 1] + bsv)); w[2 * g4 + 1] = pk2(CC_SCALE * bflo(uu[g4].y) * (acc[4 * g4 + 2] + bsv), CC_SCALE * bfhi(uu[g4].y) * (acc[4 * g4 + 3] + bsv)); }
          bf16* op = (bf16*)(CC + (row0 + p) * CCB + 512) + g * 64 + 32 * db + 16 * hh;
          *(v4u*)op = (v4u){w[0], w[1], w[2], w[3]}; *(v4u*)(op + 8) = (v4u){w[4], w[5], w[6], w[7]}; }
    }
    __syncthreads();
}
constexpr int PL_ROWB = 144, PL_WAVE_LDS = 48 * PL_ROWB;
template <int W>
__device__ __forceinline__ void pool_task(const bf16* __restrict__ Zb, unsigned char* __restrict__ CC, const bf16* __restrict__ WPT, const float* __restrict__ psc, int b, int g, int tile, int lane, LAS unsigned char* wl) {
    const int hh = lane >> 5, pl = lane & 31;
    const int pos = 32 * tile + pl;
    constexpr int left = W / 2, right = W - 1 - left, NR = 32 + W - 1;
    int lo = pos - left; if (lo < 0) lo = 0;
    int hi = pos + right + 1; if (hi > S) hi = S;
    const float inv = 1.0f / (float)(hi - lo);
    const bf16* zb = Zb + (size_t)b * S * 256 + g * 64;
    bf16x8 afr[2][4]; f32x4 scv[2][4];
    { constexpr int NL = (NR * 8 + 63) / 64;
      v4u zr[NL];
#pragma unroll
      for (int k = 0; k < NL; ++k) { const int idx = lane + 64 * k, r = idx >> 3, c = idx & 7; int q = 32 * tile - left + r; q = q < 0 ? 0 : (q >= S ? S - 1 : q);
          zr[k] = *(const v4u*)(zb + (size_t)q * 256 + 8 * c); }
#pragma unroll
      for (int ob = 0; ob < 2; ++ob)
#pragma unroll
          for (int ks = 0; ks < 4; ++ks) { afr[ob][ks] = *(const bf16x8*)(WPT + ((size_t)g * 64 + 32 * ob + pl) * 64 + 16 * ks + 8 * hh); scv[ob][ks] = *(const f32x4*)(psc + g * 64 + 32 * ob + 8 * ks + 4 * hh); }
#pragma unroll
      for (int k = 0; k < NL; ++k) { const int idx = lane + 64 * k, r = idx >> 3, c = idx & 7; *(LAS v4u*)(wl + r * PL_ROWB + 16 * c) = zr[k]; }
      asm volatile("s_waitcnt lgkmcnt(0)" ::: "memory"); }
    bf16x8 bfr[4];
#pragma unroll
    for (int ks = 0; ks < 4; ++ks) {
        float sm[8];
#pragma unroll
        for (int e = 0; e < 8; ++e) sm[e] = 0.f;
        v4u zc;
#pragma unroll
        for (int t = 0; t < W; ++t) { const int q = pos - left + t; const float f = (q >= 0 && q < S) ? 1.0f : 0.0f; const v4u z = *(const LAS v4u*)(wl + (pl + t) * PL_ROWB + 32 * ks + 16 * hh);
            if (t == left) zc = z;
            sm[0] += f * bflo(z.x); sm[1] += f * bfhi(z.x); sm[2] += f * bflo(z.y); sm[3] += f * bfhi(z.y); sm[4] += f * bflo(z.z); sm[5] += f * bfhi(z.z); sm[6] += f * bflo(z.w); sm[7] += f * bfhi(z.w); }
        const v4u z = zc;
        v4u o; o.x = pk2(sm[0] * inv - bflo(z.x), sm[1] * inv - bfhi(z.x)); o.y = pk2(sm[2] * inv - bflo(z.y), sm[3] * inv - bfhi(z.y));
        o.z = pk2(sm[4] * inv - bflo(z.z), sm[5] * inv - bfhi(z.z)); o.w = pk2(sm[6] * inv - bflo(z.w), sm[7] * inv - bfhi(z.w));
        bfr[ks] = __builtin_bit_cast(bf16x8, o);
    }
    asm volatile("s_waitcnt lgkmcnt(0)" ::: "memory");
#pragma unroll
    for (int ob = 0; ob < 2; ++ob) {
        f32x16 acc;
#pragma unroll
        for (int i = 0; i < 16; ++i) acc[i] = 0.f;
#pragma unroll
        for (int ks = 0; ks < 4; ++ks) acc = MFMA32(afr[ob][ks], bfr[ks], acc);
        unsigned w[8];
#pragma unroll
        for (int g4 = 0; g4 < 4; ++g4) {
            const f32x4 sc = scv[ob][g4];
            w[2 * g4] = pk2(CC_SCALE * acc[4 * g4] * sc[0], CC_SCALE * acc[4 * g4 + 1] * sc[1]); w[2 * g4 + 1] = pk2(CC_SCALE * acc[4 * g4 + 2] * sc[2], CC_SCALE * acc[4 * g4 + 3] * sc[3]);
        }
        bf16* op = (bf16*)(CC + ((size_t)b * S + pos) * CCB + 512) + 256 + g * 64 + 32 * hh + 16 * ob;
        *(v4u*)op = (v4u){w[0], w[1], w[2], w[3]}; *(v4u*)(op + 8) = (v4u){w[4], w[5], w[6], w[7]};
    }
}
__device__ __forceinline__ void p2_pool(const Ptrs& P, int l, LAS unsigned char* lds, int vcu, int G, int wave, int lane) {
    LAS unsigned char* wl = lds + 65536 + wave * PL_WAVE_LDS;
    const bf16* Zb = (const bf16*)(P.ws + WS_Z); unsigned char* CC = P.ws + WS_CC;
    const bf16* WPT = (const bf16*)(P.ws + WS_WPT) + (size_t)l * 4 * 64 * 64;
    const float* psc = P.psc + l * 256;
    const int gw = vcu * NWAVES + wave, NGW = G * NWAVES;
    for (int task = gw; task < NB * 4 * 64; task += NGW) {
        const int gr = task & 3, idx = (task >> 2), tile = idx & 63, b = idx >> 6, g = ((task >> 11) & 1) ? 3 - gr : gr;
        if (g == 0) pool_task<2>(Zb, CC, WPT, psc, b, g, tile, lane, wl);
        else if (g == 1) pool_task<4>(Zb, CC, WPT, psc, b, g, tile, lane, wl);
        else if (g == 2) pool_task<8>(Zb, CC, WPT, psc, b, g, tile, lane, wl);
        else pool_task<16>(Zb, CC, WPT, psc, b, g, tile, lane, wl);
    }
}

__device__ __forceinline__ void route16(const float* logit, const float* __restrict__ rbias, int& e0, int& e1, float& g0, float& g1) {
    float sc[16], bi[16];
#pragma unroll
    for (int e = 0; e < 16; ++e) { sc[e] = 1.0f / (1.0f + expf(-logit[e])); bi[e] = sc[e] + rbias[e]; }
    int gsel = 0; float best = -1e30f;
#pragma unroll
    for (int g = 0; g < 4; ++g) {
        float m1 = -1e30f, m2 = -1e30f;
#pragma unroll
        for (int j = 0; j < 4; ++j) { const float v = bi[g * 4 + j]; if (v > m1) { m2 = m1; m1 = v; } else if (v > m2) m2 = v; }
        const float gs = m1 + m2;
        if (gs > best) { best = gs; gsel = g; }
    }
    float bg[4], sg[4];
#pragma unroll
    for (int j = 0; j < 4; ++j) { bg[j] = bi[j]; sg[j] = sc[j];
#pragma unroll
        for (int g = 1; g < 4; ++g) { bg[j] = (g == gsel) ? bi[g * 4 + j] : bg[j]; sg[j] = (g == gsel) ? sc[g * 4 + j] : sg[j]; } }
    int i1 = 0; float m1 = bg[0], s1 = sg[0];
#pragma unroll
    for (int j = 1; j < 4; ++j) if (bg[j] > m1) { m1 = bg[j]; i1 = j; s1 = sg[j]; }
    int i2 = -1; float m2 = -1e30f, s2 = 0.f;
#pragma unroll
    for (int j = 0; j < 4; ++j) if (j != i1 && bg[j] > m2) { m2 = bg[j]; i2 = j; s2 = sg[j]; }
    e0 = gsel * 4 + i1; e1 = gsel * 4 + i2;
    g0 = s1 / (s1 + s2); g1 = s2 / (s1 + s2);
}
__device__ __forceinline__ void p4_prefill(const Ptrs& P, int l, LAS unsigned char* lds, int tid) {
    const v4u* RWB = (const v4u*)(P.ws + WS_RWQ) + (size_t)l * 6144;
    LAS int* s_cnt = (LAS int*)(lds + 98304 + 8192);
    v4u tb[12];
#pragma unroll
    for (int k = 0; k < 12; ++k) tb[k] = RWB[tid + NTHREADS * k];
#pragma unroll
    for (int k = 0; k < 12; ++k) ((LAS v4u*)lds)[tid + NTHREADS * k] = tb[k];
    if (tid < 16) s_cnt[tid] = 0;
}
__device__ __forceinline__ void p4_stats_router(const Ptrs& P, int l, LAS unsigned char* lds, int vcu, int G, int wave, int lane, int tid, bool prefilled) {
    const bf16* Y1B = (const bf16*)(P.ws + WS_Y1B); float* STATS = (float*)(P.ws + WS_STATS);
    int* TOKE = (int*)(P.ws + WS_TOKE); float* TOKG = (float*)(P.ws + WS_TOKG); int* TOKP = (int*)(P.ws + WS_TOKP);
    int* TLIST = (int*)(P.ws + WS_TLIST);
    unsigned* cnt = (unsigned*)(P.ws + WS_CTL) + CW_CNT + 16 * l;
    const v4u* RWB = (const v4u*)(P.ws + WS_RWQ) + (size_t)l * 6144; const float* CR = (const float*)(P.ws + WS_CR) + l * 32;
    LAS unsigned char* rwb = lds;
    LAS float* dots = (LAS float*)(lds + 98304) + wave * 256;
    LAS int* s_cnt = (LAS int*)(lds + 98304 + 8192); LAS int* s_base = s_cnt + 16; LAS int* s_e = s_cnt + 32; LAS int* s_pos = s_e + 256; LAS float* s_g = (LAS float*)(s_pos + 256);
    const int row_l = lane & 15, q = lane >> 4;
    bool filled = prefilled;
    for (int blk_row = vcu * 128; blk_row < T; blk_row += G * 128) {
        const int row = blk_row + wave * 16 + row_l;
        const bf16* yp = Y1B + (size_t)row * D + 8 * q;
        v4u yv[16];
#pragma unroll
        for (int jj = 0; jj < 16; ++jj) yv[jj] = *(const v4u*)(yp + 32 * jj);
        if (!filled) { filled = true;
            { v4u tb[12];
#pragma unroll
              for (int k = 0; k < 12; ++k) tb[k] = RWB[tid + NTHREADS * k];
#pragma unroll
              for (int k = 0; k < 12; ++k) ((LAS v4u*)rwb)[tid + NTHREADS * k] = tb[k]; }
            if (tid < 16) s_cnt[tid] = 0;
            __syncthreads(); }
        f32x4 acc = {0.f, 0.f, 0.f, 0.f}; float s1 = 0.f, s2 = 0.f;
#pragma unroll 1
        for (int jc = 0; jc < 2; ++jc) {
            if (jc == 1) {
#pragma unroll
                for (int jj = 0; jj < 16; ++jj) yv[jj] = *(const v4u*)(yp + 32 * (16 + jj));
            }
#pragma unroll
            for (int jj = 0; jj < 16; ++jj) {
                const int jp = 16 * jc + jj;
                const float y0 = bflo(yv[jj].x), y1 = bfhi(yv[jj].x), y2 = bflo(yv[jj].y), y3 = bfhi(yv[jj].y), y4 = bflo(yv[jj].z), y5 = bfhi(yv[jj].z), y6 = bflo(yv[jj].w), y7 = bfhi(yv[jj].w);
                const bf16x8 af = __builtin_bit_cast(bf16x8, yv[jj]);
#pragma unroll
                for (int term = 0; term < 3; ++term) { const bf16x8 bfr = *(const LAS bf16x8*)(rwb + ((jp * 3 + term) * 64 + lane) * 16); acc = __builtin_amdgcn_mfma_f32_16x16x32_bf16(af, bfr, acc, 0, 0, 0); }
                s1 += ((y0 + y1) + (y2 + y3)) + ((y4 + y5) + (y6 + y7));
                s2 += ((y0 * y0 + y1 * y1) + (y2 * y2 + y3 * y3)) + ((y4 * y4 + y5 * y5) + (y6 * y6 + y7 * y7));
            }
        }
        s1 += __shfl_xor(s1, 16); s1 += __shfl_xor(s1, 32); s2 += __shfl_xor(s2, 16); s2 += __shfl_xor(s2, 32);
#pragma unroll
        for (int i = 0; i < 4; ++i) dots[(4 * q + i) * 16 + row_l] = acc[i];
        LDS_WAIT();
        if (lane < 16) {
            const int grow = blk_row + wave * 16 + lane;
            const float mu = s1 * (1.0f / D), var = s2 * (1.0f / D) - mu * mu, rstd = rsqrtf(var + LN_EPS);
            *(f32x2*)(STATS + 2 * (size_t)grow) = (f32x2){mu, rstd};
            float lg[16];
#pragma unroll
            for (int e4 = 0; e4 < 4; ++e4) { const f32x4 d = *(const LAS f32x4*)(dots + lane * 16 + 4 * e4);
#pragma unroll
                for (int e = 0; e < 4; ++e) lg[4 * e4 + e] = rstd * (d[e] - mu * CR[4 * e4 + e]) + CR[16 + 4 * e4 + e]; }
            int e0, e1; float g0, g1;
            route16(lg, P.rb, e0, e1, g0, g1);
            const int tl = wave * 16 + lane;
            const int p0 = __hip_atomic_fetch_add(s_cnt + e0, 1, __ATOMIC_RELAXED, __HIP_MEMORY_SCOPE_WORKGROUP);
            const int p1 = __hip_atomic_fetch_add(s_cnt + e1, 1, __ATOMIC_RELAXED, __HIP_MEMORY_SCOPE_WORKGROUP);
            s_e[2 * tl] = e0; s_e[2 * tl + 1] = e1; s_pos[2 * tl] = p0; s_pos[2 * tl + 1] = p1; s_g[2 * tl] = mu; s_g[2 * tl + 1] = rstd;
            TOKE[2 * grow] = e0; TOKE[2 * grow + 1] = e1; TOKG[2 * grow] = g0; TOKG[2 * grow + 1] = g1;
        }
        __syncthreads();
        if (tid < 16) s_base[tid] = (int)__hip_atomic_fetch_add(cnt + tid, (unsigned)s_cnt[tid], RLX_AGENT);
        __syncthreads();
        if (tid < 256) { const int e = s_e[tid], p = s_base[e] + s_pos[tid]; TOKP[2 * blk_row + tid] = p;
            TLIST[(size_t)e * T + p] = blk_row + (tid >> 1); *(f32x2*)(P.ws + WS_SLIST + ((size_t)e * T + p) * 8) = (f32x2){s_g[2 * (tid >> 1)], s_g[2 * (tid >> 1) + 1]}; }
        if (tid < 16) s_cnt[tid] = 0;
        __syncthreads();
    }
}
__device__ __forceinline__ int build_tables(const unsigned char* ws, int l, LAS unsigned char* lds, int tid) {
    LAS int* s_base = (LAS int*)(lds + TAB_OFF); LAS int* s_cntx = s_base + 32; LAS int* texp = s_base + 64;
    const unsigned* cnt = (const unsigned*)(ws + WS_CTL) + CW_CNT + 16 * l;
    if (tid < 64) {
        const int c = tid < 16 ? (int)__hip_atomic_load(cnt + (tid & 15), RLX_AGENT) : 0;
        const int nt = (c + 255) >> 8;
        int incl = nt;
#pragma unroll
        for (int d = 1; d < 16; d <<= 1) { const int v = __shfl_up(incl, d); if ((tid & 63) >= d) incl += v; }
        if (tid < 16) { s_cntx[tid] = c; s_base[tid] = (incl - nt) << 8; }
        if (tid == 15) s_base[16] = incl << 8;
    }
    __syncthreads();
    const int ntiles = s_base[16] >> 8;
    for (int t = tid; t < ntiles; t += NTHREADS) {
        int e = 0;
#pragma unroll 1
        for (int k = 1; k < 16; ++k) e += (s_base[k] >> 8) <= t ? 1 : 0;
        texp[t] = e;
    }
    __syncthreads();
    return ntiles;
}
__device__ __forceinline__ void p8_rows(const Ptrs& P, LAS unsigned char* lds, int vcu, int G, int wave, int lane) {
    const LAS int* s_base = (const LAS int*)(lds + TAB_OFF);
    const int* TOKE = (const int*)(P.ws + WS_TOKE); const int* TOKP = (const int*)(P.ws + WS_TOKP);
    const int gw = vcu * NWAVES + wave, NGW = G * NWAVES;
    LAS int* rtab = (LAS int*)(lds + 16384 + wave * 512);
    for (int i = lane; gw + i * NGW < T && i < 64; i += 64) { const int t = gw + i * NGW;
        rtab[2 * i] = s_base[TOKE[2 * t]] + TOKP[2 * t]; rtab[2 * i + 1] = s_base[TOKE[2 * t + 1]] + TOKP[2 * t + 1]; }
    asm volatile("s_waitcnt lgkmcnt(0)" ::: "memory");
}
__device__ __forceinline__ void p8_ln2(const Ptrs& P, int l, bool last, LAS unsigned char* lds, int vcu, int G, int wave, int lane, bool have_rtab) {
    const LAS int* s_base = (const LAS int*)(lds + TAB_OFF);
    const bf16* Y1B = (const bf16*)(P.ws + WS_Y1B); const float* STATS = (const float*)(P.ws + WS_STATS); const unsigned char* YB = P.ws + WS_YB; bf16* XB = (bf16*)(P.ws + WS_HB);
    const int* TOKE = (const int*)(P.ws + WS_TOKE); const int* TOKP = (const int*)(P.ws + WS_TOKP); const float* TOKG = (const float*)(P.ws + WS_TOKG);
    const float* g1p = P.ln1g + l * D; const float* b1p = P.ln1b + l * D; const float* g2p = P.ln2g + l * D; const float* b2p = P.ln2b + l * D;
    float g1[16], b1[16], g2[16], b2[16];
#pragma unroll
    for (int j = 0; j < 2; ++j)
#pragma unroll
        for (int h = 0; h < 2; ++h) { const int c = 8 * lane + 512 * j + 4 * h;
            const f32x4 a = *(const f32x4*)(g1p + c), b = *(const f32x4*)(b1p + c), cc = *(const f32x4*)(g2p + c), d = *(const f32x4*)(b2p + c);
#pragma unroll
            for (int e = 0; e < 4; ++e) { g1[8 * j + 4 * h + e] = a[e]; b1[8 * j + 4 * h + e] = b[e]; g2[8 * j + 4 * h + e] = cc[e]; b2[8 * j + 4 * h + e] = d[e]; } }
    const int gw = vcu * NWAVES + wave, NGW = G * NWAVES;
    LAS int* rtab = (LAS int*)(lds + 16384 + wave * 512);
    if (!have_rtab) p8_rows(P, lds, vcu, G, wave, lane);
    for (int t0 = gw, ti = 0; t0 < T; t0 += 2 * NGW, ti += 2) {
        v4u yv[2][2]; v2u av[2][2], bv[2][2]; f32x2 stv[2], gtv[2];
#pragma unroll
        for (int u = 0; u < 2; ++u) {
            const int t = (t0 + u * NGW < T) ? t0 + u * NGW : t0;
            const int tk = (t0 + u * NGW < T) ? ti + u : ti;
            const int r0 = rtab[2 * tk], r1 = rtab[2 * tk + 1];
            stv[u] = *(const f32x2*)(STATS + 2 * (size_t)t); gtv[u] = *(const f32x2*)(TOKG + 2 * (size_t)t);
#pragma unroll
            for (int j = 0; j < 2; ++j) {
                yv[u][j] = *(const v4u*)(Y1B + (size_t)t * D + 8 * lane + 512 * j);
                if (j == 0) { const v4u a4 = *(const v4u*)(YB + (size_t)r0 * D + 16 * lane), b4 = *(const v4u*)(YB + (size_t)r1 * D + 16 * lane);
                    av[u][0] = (v2u){a4.x, a4.y}; av[u][1] = (v2u){a4.z, a4.w}; bv[u][0] = (v2u){b4.x, b4.y}; bv[u][1] = (v2u){b4.z, b4.w}; }
            }
        }
#pragma unroll
        for (int u = 0; u < 2; ++u) {
            const int t = t0 + u * NGW;
            if (t < T) {
                const f32x2 st = stv[u]; const float ga = gtv[u].x * (1.0f / Y8_SCALE), gb = gtv[u].y * (1.0f / Y8_SCALE);
                float v[16]; float s = 0.f;
#pragma unroll
                for (int j = 0; j < 2; ++j) {
                    const v4u y = yv[u][j]; const v2u a = av[u][j], b = bv[u][j];
                    const unsigned yw[4] = {y.x, y.y, y.z, y.w}, aw[2] = {a.x, a.y}, bw[2] = {b.x, b.y};
#pragma unroll
                    for (int k = 0; k < 4; ++k) {
                        const int i0 = 8 * j + 2 * k;
                        const float m0 = ga * f8at(aw[k >> 1], 2 * (k & 1)) + gb * f8at(bw[k >> 1], 2 * (k & 1)), m1 = ga * f8at(aw[k >> 1], 2 * (k & 1) + 1) + gb * f8at(bw[k >> 1], 2 * (k & 1) + 1);
                        v[i0] = ALPHA * ((bflo(yw[k]) - st.x) * st.y * g1[i0] + b1[i0]) + m0;
                        v[i0 + 1] = ALPHA * ((bfhi(yw[k]) - st.x) * st.y * g1[i0 + 1] + b1[i0 + 1]) + m1;
                        s += v[i0] + v[i0 + 1];
                    }
                }
                const float mu = wave_sum(s) * (1.0f / D); float q = 0.f;
#pragma unroll
                for (int i = 0; i < 16; ++i) { v[i] -= mu; q += v[i] * v[i]; }
                const float rstd = rsqrtf(wave_sum(q) * (1.0f / D) + LN_EPS);
#pragma unroll
                for (int i = 0; i < 16; ++i) v[i] = v[i] * rstd * g2[i] + b2[i];
                if (last) {
#ifdef MK_PROBE
                    { const float pscale = 1.0f + (float)__hip_atomic_load((const unsigned*)(P.ws + WS_CTL) + 32, RLX_AGENT) * (MK_PSCALE);
#pragma unroll
                      for (int i = 0; i < 16; ++i) v[i] *= pscale; }
#endif
#pragma unroll
                    for (int j = 0; j < 2; ++j) { float* op = P.out + (size_t)t * D + 8 * lane + 512 * j;
                        __builtin_nontemporal_store((f32x4){v[8 * j], v[8 * j + 1], v[8 * j + 2], v[8 * j + 3]}, (f32x4*)op); __builtin_nontemporal_store((f32x4){v[8 * j + 4], v[8 * j + 5], v[8 * j + 6], v[8 * j + 7]}, (f32x4*)(op + 4)); }
                } else {
#pragma unroll
                    for (int j = 0; j < 2; ++j) { v4u w; w.x = pk2(v[8 * j], v[8 * j + 1]); w.y = pk2(v[8 * j + 2], v[8 * j + 3]); w.z = pk2(v[8 * j + 4], v[8 * j + 5]); w.w = pk2(v[8 * j + 6], v[8 * j + 7]);
                        *(v4u*)(XB + (size_t)t * D + 8 * lane + 512 * j) = w;
                        v2u w8; w8.x = pk4_fp8(v[8 * j], v[8 * j + 1], v[8 * j + 2], v[8 * j + 3]); w8.y = pk4_fp8(v[8 * j + 4], v[8 * j + 5], v[8 * j + 6], v[8 * j + 7]); *(v2u*)(P.ws + WS_XB8 + (size_t)t * D + 8 * lane + 512 * j) = w8; }
                }
            }
        }
    }
}

template <class Tp> __device__ __forceinline__ Tp* asg(Tp* p) { GAS Tp* g = (GAS Tp*)p; asm volatile("" : "+s"(g)); return (Tp*)g; }
__device__ __forceinline__ Ptrs load_ptrs(const Ptrs& q) {
    Ptrs P;
    P.x = asg(q.x); P.w_in = asg(q.w_in); P.w_out = asg(q.w_out); P.lg = asg(q.lg); P.lb = asg(q.lb); P.wsp = asg(q.wsp); P.bsp = asg(q.bsp); P.pw = asg(q.pw); P.psc = asg(q.psc);
    P.ln1g = asg(q.ln1g); P.ln1b = asg(q.ln1b); P.rw = asg(q.rw); P.rb = asg(q.rb); P.wg = asg(q.wg); P.wu = asg(q.wu); P.wd = asg(q.wd); P.ln2g = asg(q.ln2g); P.ln2b = asg(q.ln2b);
    P.out = asg(q.out); P.ws = asg(q.ws);
    return P;
}
struct Args { Ptrs p; int ph_lo, ph_hi, li, pad; };
constexpr int N_PHASES = 13;
__global__ void __launch_bounds__(NTHREADS, 2) mk_fwd(Args args_unused) {
    const Args* ka_ = (const Args*)__builtin_amdgcn_kernarg_segment_ptr();
#ifndef USE_KA
#define KA() (&args_unused)
#else
#define KA() ({ const Args* p_ = ka_; asm volatile("" : "+s"(p_)); p_; })
#endif
    extern __shared__ __attribute__((aligned(16))) unsigned char lds_raw[];
    LAS unsigned char* lds = (LAS unsigned char*)lds_raw;
    const int tid0 = threadIdx.x; const int wave0 = __builtin_amdgcn_readfirstlane(tid0 >> 6);
    const int G = gridDim.x; const int bx = blockIdx.x; const int vcu = (G % 8 == 0) ? (bx % 8) * (G / 8) + bx / 8 : bx;
    volatile LAS unsigned* MISC = (volatile LAS unsigned*)(lds + MISC_OFF);
    for (int u = tid0; u < (LDS_BYTES - RING_BYTES) / 4; u += NTHREADS) ((LAS unsigned*)(lds + RING_BYTES))[u] = 0u;
    __syncthreads();
    const int lo = KA()->ph_lo, hi = KA()->ph_hi;
    unsigned* ctl = (unsigned*)(asg(KA()->p.ws) + WS_CTL);
    XcdBarrier bar; bar.bar = ctl + CW_BAR + KA()->li * XCD_BAR_WORDS; bar.x = 0; bar.st = nullptr;
    if (hi - lo > 1) bar = xcd_barrier_post(ctl + CW_BAR + KA()->li * XCD_BAR_WORDS, MISC + 8, tid0);
#define IN(k) (lo <= (k) && (k) < hi)
#ifndef MK_REPEAT
#define MK_REPEAT -1
#endif
#define REP(k) for (int rep_ = 0; rep_ < ((MK_REPEAT == (k)) ? 2 : 1); ++rep_)
#define PHASE_IDS() int wave = wave0; asm volatile("" : "+s"(wave)); int lane; asm volatile("v_mbcnt_lo_u32_b32 %0, -1, 0\n\tv_mbcnt_hi_u32_b32 %0, -1, %0" : "=&v"(lane)); const int tid = wave * 64 + lane; (void)tid
#define SEAM(k) do { if (IN(k) && IN((k) + 1)) xcd_barrier(bar, tid); } while (0)
#define PRE_G1(ll) do { if (MK_PREB) { pg8::Gemm g_{P.ws + WS_HB, P.ws + WS_WINB + (size_t)(ll) * 768 * D * 2, 2 * D}; int Gl_ = G, bxl_ = bx; asm volatile("" : "+s"(Gl_), "+s"(bxl_)); \
        pg8::StaticOrder so_; so_.init(T / 256, 3, Gl_, bxl_); so_.pn_base = 6; pg8::gemm_prestage_b<EpiProj, pg8::StaticOrder>(lds, g_, so_, wave); } } while (0)
#define PRE_G2(ll) do { if (MK_PREB) { pg8::Gemm g_{P.ws + WS_CC, P.ws + WS_WOUT + (size_t)(ll) * D * CCB, CCB}; int Gl_ = G, bxl_ = bx; asm volatile("" : "+s"(Gl_), "+s"(bxl_)); \
        pg8::StaticOrder so_; so_.init(T / 256, 4, Gl_, bxl_); pg8::gemm_prestage_b<EpiOutB, pg8::StaticOrder>(lds, g_, so_, wave); } } while (0)
    PROBE_DECL();
#ifndef PH_MASK
#define PH_MASK 0x1ff
#endif
    if ((PH_MASK & 1) && IN(0)) REP(0) { PHASE_IDS(); PROBE_T0(100); const Ptrs P = load_ptrs(KA()->p); p0_prologue(P, lds, vcu, G, wave, lane, tid); SEAM(0); PROBE_T1(100); }
    for (int l = 0; l < 2; ++l) {
        const int pb = 1 + 6 * l;
        if ((PH_MASK & 2) && IN(pb + 0)) REP(1) {
            PHASE_IDS(); PROBE_T0(101); const Ptrs P = load_ptrs(KA()->p);
            { pg8::Gemm g{P.ws + WS_HB, P.ws + WS_WINB + (size_t)l * 768 * D * 2, 2 * D};
              int Gl = G, bxl = bx; asm volatile("" : "+s"(Gl), "+s"(bxl));
              pg8::StaticOrder so; so.init(T / 256, 3, Gl, bxl); so.pn_base = 6;
              EpiProj E{P.ws, P.lg + l * 256, P.lb + l * 256, 1.0f};
              pg8::gemm_phase<EpiProj, pg8::StaticOrder, MK_ALIGN, false, false, 0, MK_PREB>(lds, g, so, E, wave, l == 1); }
            { pg8::Gemm g{P.ws + WS_XB8, P.ws + WS_WIN8 + (size_t)l * 1536 * D, D};
              int Gl = G, bxl = bx; asm volatile("" : "+s"(Gl), "+s"(bxl));
              pg8::StaticOrder so; so.init(T / 256, 6, Gl, bxl); if (Gl == 256) so.lo_c = 128;
              EpiProj E{P.ws, P.lg + l * 256, P.lb + l * 256, 1.0f / W8_SCALE};
              pg8::gemm_phase<EpiProj, pg8::StaticOrder, MK_ALIGN, false, true>(lds, g, so, E, wave); }
            SEAM(pb + 0); PROBE_T1(101);
        }
        if ((PH_MASK & 4) && IN(pb + 1)) {
            PHASE_IDS(); PROBE_T0(102); const Ptrs P = load_ptrs(KA()->p);
            PROBE_T0(21); REP(21) p2_attention(P.ws, P.ws, lds, vcu, G, wave, lane, tid); PROBE_T1(21);
            PROBE_T0(22); p2_gmlp(P, l, lds, vcu, G, wave, lane, tid); PROBE_T1(22);
            PROBE_T0(23); p2_pool(P, l, lds, vcu, G, wave, lane); PROBE_T1(23);
            if (MK_PREB) { __syncthreads(); PRE_G2(l); }
            SEAM(pb + 1); PROBE_T1(102);
        }
        if ((PH_MASK & 8) && IN(pb + 2)) REP(3) {
            PHASE_IDS(); PROBE_T0(103); const Ptrs P = load_ptrs(KA()->p);
            pg8::Gemm g{P.ws + WS_CC, P.ws + WS_WOUT + (size_t)l * D * CCB, CCB};
            int Gl = G, bxl = bx; asm volatile("" : "+s"(Gl), "+s"(bxl));
            pg8::StaticOrder so; so.init(T / 256, D / 256, Gl, bxl);
            EpiOutB E{(const bf16*)(P.ws + WS_HB), (bf16*)(P.ws + WS_Y1B), P.ws + WS_Y1F};
            pg8::gemm_phase<EpiOutB, pg8::StaticOrder, MK_ALIGN, false, false, 4, MK_PREB>(lds, g, so, E, wave);
            if (IN(pb + 3)) p4_prefill(P, l, lds, tid);
            SEAM(pb + 2); PROBE_T1(103);
        }
        if ((PH_MASK & 16) && IN(pb + 3)) { PHASE_IDS(); PROBE_T0(104); const Ptrs P = load_ptrs(KA()->p); p4_stats_router(P, l, lds, vcu, G, wave, lane, tid, IN(pb + 2)); SEAM(pb + 3); PROBE_T1(104); }
        if ((PH_MASK & 64) && IN(pb + 4)) {
            PHASE_IDS(); PROBE_T0(105); const Ptrs P = load_ptrs(KA()->p);
            const int ntiles = build_tables(P.ws, l, lds, tid);
            unsigned* rdy = (unsigned*)(P.ws + WS_CTL) + CW_RDY + l * 32768;
            {
                pg8::Gemm g{P.ws + WS_Y1F, P.ws + WS_WGU + (size_t)l * NE * 1024 * D, D};
                int Gl = G, bxl = bx; asm volatile("" : "+s"(Gl), "+s"(bxl));
                pg8::GroupOrder go; go.so.init(ntiles, 4, Gl, bxl); go.s_base = (const LAS int*)(lds + TAB_OFF); go.tlist = (const int*)(P.ws + WS_TLIST); go.toks = (const LAS unsigned short*)(lds + TAB_OFF + 2048);
                go.ready = rdy; go.mode = 1;
                go.stage_tok_stats((LAS unsigned short*)(lds + TAB_OFF + 2048), (LAS float*)(lds + TAB_OFF + 5120), (const float*)(P.ws + WS_SLIST), tid); __syncthreads();
                EpiGU E{P.ws, (const LAS float*)(lds + TAB_OFF + 5120), l};
                pg8::gemm_phase<EpiGU, pg8::GroupOrder, MK_ALIGN, true, true>(lds, g, go, E, wave);
            }
            __syncthreads();
            {
                pg8::Gemm g{P.ws + WS_HB, P.ws + WS_WDN + (size_t)l * NE * D * FF, FF};
                int Gl = G, bxl = bx; asm volatile("" : "+s"(Gl), "+s"(bxl));
                pg8::GroupOrder go; go.so.init(ntiles, 4, Gl, Gl - 1 - bxl); go.s_base = (const LAS int*)(lds + TAB_OFF); go.tlist = nullptr; go.toks = nullptr;
                go.ready = rdy; go.mode = 2;
                if (MK_PREB) pg8::gemm_prestage_b<EpiDown, pg8::GroupOrder>(lds, g, go, wave);
                { LAS unsigned* okm = (LAS unsigned*)(lds + TAB_OFF + 5120);
                  if (wave == 0) { pg8::Unit uu; int mypm = 0, n = 0;
#pragma unroll 1
                      for (int ui = 0; ui < 8; ++ui) { if (!go.next(ui, uu)) break; mypm = (lane == ui) ? uu.pm : mypm; n = ui + 1; }
                      bool ok = false;
                      if (lane < n) ok = __hip_atomic_load(rdy + 64 * mypm, __ATOMIC_RELAXED, __HIP_MEMORY_SCOPE_AGENT) >= 32u;
                      const unsigned m = (unsigned)__ballot(ok) & 0xffu;
                      __builtin_amdgcn_fence(__ATOMIC_ACQUIRE, "agent"); asm volatile("s_waitcnt vmcnt(0)" ::: "memory");
                      if (lane == 0) okm[0] = m; }
                  __syncthreads();
                  go.okmask = okm[0]; }
                EpiDown E{P.ws + WS_YB};
                pg8::gemm_phase<EpiDown, pg8::GroupOrder, MK_ALIGN, false, true, 0, MK_PREB>(lds, g, go, E, wave);
            }
            if (l == 1) PROBE_END(P.ws, bx == 0 && tid == 0);
            if (IN(pb + 5)) p8_rows(P, lds, vcu, G, wave, lane);
            SEAM(pb + 4); PROBE_T1(105);
        }
        if ((PH_MASK & 256) && IN(pb + 5)) REP(8) { PHASE_IDS(); PROBE_T0(107); const Ptrs P = load_ptrs(KA()->p); if (!IN(pb + 4)) build_tables(P.ws, l, lds, tid); p8_ln2(P, l, l == 1, lds, vcu, G, wave, lane, IN(pb + 4)); if (MK_PREB && l == 0) PRE_G1(1); SEAM(pb + 5); PROBE_T1(107); }
    }
#undef IN
#undef SEAM
}
}
#ifndef MK_CUT
#define MK_CUT 13
#endif
#if MK_CUT < 13
namespace glue {
using namespace mk;
__global__ void g1(const unsigned char* ws, int b, float* proj) {
    const int pos = blockIdx.x; const size_t row = (size_t)b * S + pos;
    for (int col = threadIdx.x; col < NCOL; col += blockDim.x) {
        float v;
        if (col < 1024) { const int c = col & 511, head = c >> 6, d = c & 63; const int t = d < 16 ? (d < 8 ? 2 * d : 2 * (d - 8) + 1) : d;
            const bf16* src = (const bf16*)(ws + (col < 512 ? WS_Q : WS_K)); v = bflo(src[row * 512 + head * 64 + t]); if (col < 512) v *= 8.0f; }
        else if (col < 1536) v = bflo(((const bf16*)(ws + WS_V))[row * 512 + col - 1024]);
        else if (col < 1792) v = bflo(((const bf16*)(ws + WS_U))[row * 256 + col - 1536]);
        else if (col < 2048) v = bflo(((const bf16*)(ws + WS_G))[row * 256 + col - 1792]);
        else v = bflo(((const bf16*)(ws + WS_Z))[row * 256 + col - 2048]);
        proj[(size_t)pos * NCOL + col] = v;
    }
}
__global__ void g2(const unsigned char* ws, int b, float* cc) {
    const int pos = blockIdx.x; const size_t row = (size_t)b * S + pos;
    for (int col = threadIdx.x; col < D; col += blockDim.x) cc[(size_t)pos * D + col] = bflo(((const bf16*)(ws + WS_CC))[row * D + col]);
}
}
#endif

static void mk_launch_range(const mk::Ptrs& p, int grid, int lo, int hi, int li, hipStream_t stream) {
    mk::Args a{};
    a.p = p; a.ph_lo = lo; a.ph_hi = hi; a.li = li; a.pad = 0;
    hipLaunchKernelGGL(mk::mk_fwd, dim3(grid), dim3(mk::NTHREADS), mk::LDS_BYTES, stream, a);
}

extern "C" void kernel_launch(void* const* d_in, const int* in_sizes, int n_in, void* d_out, int out_size, void* d_ws, size_t ws_size, hipStream_t stream) {
    using namespace mk;
    static int grid = 0;
    if (grid == 0) {
        if (n_in != 18 || ws_size < WS_END) { fprintf(stderr, "kernel_launch: unexpected n_in %d / ws_size %zu\n", n_in, ws_size); grid = -1; return; }
        int dev = 0, cus = 0;
        if (hipGetDevice(&dev) != hipSuccess || hipDeviceGetAttribute(&cus, hipDeviceAttributeMultiprocessorCount, dev) != hipSuccess) { grid = -1; return; }
        if (hipFuncSetAttribute((const void*)mk_fwd, hipFuncAttributeMaxDynamicSharedMemorySize, LDS_BYTES) != hipSuccess) { fprintf(stderr, "kernel_launch: hipFuncSetAttribute failed\n"); grid = -1; return; }
        grid = cus;
    }
    if (grid < 0) return;
    (void)hipMemsetAsync((char*)d_ws + WS_CTL, 0, CTL_ZERO_BYTES, stream);
    Ptrs p{};
    const float* const* in = (const float* const*)d_in;
    p.x = in[0]; p.w_in = in[1]; p.w_out = in[2]; p.lg = in[3]; p.lb = in[4]; p.wsp = in[5]; p.bsp = in[6]; p.pw = in[7]; p.psc = in[8];
    p.ln1g = in[9]; p.ln1b = in[10]; p.rw = in[11]; p.rb = in[12]; p.wg = in[13]; p.wu = in[14]; p.wd = in[15]; p.ln2g = in[16]; p.ln2b = in[17];
    p.out = (float*)d_out; p.ws = (unsigned char*)d_ws;
#if MK_CUT >= 13
    mk_launch_range(p, grid, 0, N_PHASES, 0, stream);
#else
    mk_launch_range(p, grid, 0, MK_CUT, 0, stream);
    nv::In I = nv::make_in(d_in);
    const unsigned char* ws = (const unsigned char*)d_ws;
    float* scr_base = (float*)((char*)d_ws + 509 * MiB) - nv::SCR_FLOATS - (size_t)T * D;
    (void)scr_base;
    float* nscr = (float*)((char*)d_ws + (MK_CUT <= 2 ? (size_t)357 * MiB : (size_t)261 * MiB));
    nv::Scr s = nv::carve(nscr);
    float* xcur = (float*)d_out;
    for (int b = 0; b < NB; ++b) {
        const float* xin = I.x + (size_t)b * S * D; float* xout = xcur + (size_t)b * S * D; const int l = 0;
#if MK_CUT == 2
        glue::g1<<<S, 256, 0, stream>>>(ws, b, s.proj);
#endif
#if MK_CUT <= 2
        nv::attn<<<dim3(S, 8), 64, 0, stream>>>(s.proj, s.cc);
        nv::gmlp_mix<<<S, 256, 0, stream>>>(s.proj, I.wsp + (size_t)l * 4 * 128 * 128, I.bsp + l * 4 * 128, s.cc);
        nv::pool1<<<S, 256, 0, stream>>>(s.proj, s.pooled);
        nv::pool2<<<S, 256, 0, stream>>>(s.pooled, I.pw + (size_t)l * 4 * 64 * 64, I.psc + l * 256, s.cc);
#endif
#if MK_CUT == 3
        glue::g2<<<S, 256, 0, stream>>>(ws, b, s.cc);
#endif
#if MK_CUT <= 3
        nv::gemm<<<dim3(D / 64, S / 64), 256, 0, stream>>>(s.cc, I.w_out + (size_t)l * D * D, s.h, S, D, D);
        nv::ln_res<<<S, 64, 0, stream>>>(xin, s.h, I.ln1g + l * D, I.ln1b + l * D, s.x1);
#endif
        nv::route<<<S, 64, 0, stream>>>(s.x1, I.rw, I.rb, s.eo, s.go);
        nv::moe<<<S, 256, 0, stream>>>(s.x1, s.eo, s.go, I.wg + (size_t)l * NE * D * FF, I.wu + (size_t)l * NE * D * FF, I.wd + (size_t)l * NE * FF * D, s.moe);
        nv::ln_res<<<S, 64, 0, stream>>>(s.x1, s.moe, I.ln2g + l * D, I.ln2b + l * D, xout);
    }
    for (int b = 0; b < NB; ++b) { float* xb = xcur + (size_t)b * S * D; nv::layer(I, 1, xb, xb, s, stream); }
#endif
}
```
